# Optimizing an MI355X kernel written in HIP

```python
import math
import jax, jax.numpy as jnp
from jax import lax
import numpy as np

D_MODEL = 1024
BATCH = 16
SEQ = 4096
DEPTH = 2

D_SSD = D_MODEL
SSD_HEADDIM = 64
SSD_HEADS = D_SSD // SSD_HEADDIM
SSD_GROUPS = 4
HEADS_PER_GROUP = SSD_HEADS // SSD_GROUPS
SSD_STATE = 128
CHUNK = 128
CONV_WIDTH = 3
CONV_XBC = D_SSD + 2 * SSD_GROUPS * SSD_STATE
D_SC = D_MODEL
SC_GROUPS = 16
D_MIX = D_SSD + D_SC
D_FF = ((8 * D_MODEL // 3 + 255) // 256) * 256
RMS_EPS = 1e-5
DT_MIN = 1e-3
DT_MAX = 1e-1
IN_COLS = D_SSD + CONV_XBC + 2 * SSD_HEADS + 3 * D_SC
SPLIT_POINTS = (D_SSD,
                D_SSD + CONV_XBC,
                D_SSD + CONV_XBC + SSD_HEADS,
                D_SSD + CONV_XBC + 2 * SSD_HEADS,
                D_SSD + CONV_XBC + 2 * SSD_HEADS + D_SC,
                D_SSD + CONV_XBC + 2 * SSD_HEADS + 2 * D_SC)

kernel_name = 'bidir_hybrid_ssd_shortconv_convffn'


def rms_norm(x, w):
    xf = x.astype(jnp.float32)
    y = xf * lax.rsqrt(jnp.mean(xf * xf, axis=-1, keepdims=True) + RMS_EPS)
    return (y * w.astype(jnp.float32)).astype(x.dtype)


def dwconv_centred(u, w, b=None):
    k = w.shape[0]
    half = k // 2
    length = u.shape[1]
    up = jnp.pad(u, ((0, 0), (half, half), (0, 0)))
    out = up[:, 0:length] * w[0]
    for i in range(1, k):
        out = out + up[:, i:i + length] * w[i]
    if b is not None:
        out = out + b
    return out


def ssd_chunked(xdt, a, bm, cm):
    bsz, length, g, r, p = xdt.shape
    n = bm.shape[-1]
    c = length // CHUNK
    xdt = xdt.reshape(bsz, c, CHUNK, g, r, p)
    a = a.reshape(bsz, c, CHUNK, g, r)
    bm = bm.reshape(bsz, c, CHUNK, g, n)
    cm = cm.reshape(bsz, c, CHUNK, g, n)
    a_cs = jnp.cumsum(a, axis=2)
    seg = a_cs[:, :, :, None] - a_cs[:, :, None, :]
    mask = jnp.tril(jnp.ones((CHUNK, CHUNK), dtype=bool))[:, :, None, None]
    decay_ls = jnp.exp(jnp.where(mask, seg, -jnp.inf))
    scores = jnp.einsum('bclgn,bcsgn->bclsg', cm, bm)
    y_diag = jnp.einsum('bclsgr,bcsgrp->bclgrp', scores[..., None] * decay_ls, xdt)
    decay_to_end = jnp.exp(a_cs[:, :, -1:] - a_cs)
    states = jnp.einsum('bclgn,bclgrp->bcgrpn', bm, xdt * decay_to_end[..., None])
    chunk_decay = jnp.exp(a_cs[:, :, -1])

    def step(hstate, inp):
        s_c, d_c = inp
        return hstate * d_c[..., None, None] + s_c, hstate

    h0 = jnp.zeros((bsz, g, r, p, n), dtype=xdt.dtype)
    _, h_prev = lax.scan(step, h0, (jnp.moveaxis(states, 1, 0), jnp.moveaxis(chunk_decay, 1, 0)))
    h_prev = jnp.moveaxis(h_prev, 0, 1)
    y_off = jnp.einsum('bclgn,bcgrpn->bclgrp', cm, h_prev) * jnp.exp(a_cs)[..., None]
    return (y_diag + y_off).reshape(bsz, length, g, r, p)


def ssd_branch(z, xbc, dt_f_raw, dt_b_raw, conv_w, conv_b, dt_bias_f, dt_bias_b,
               a_log_f, a_log_b, d_skip, norm_w):
    f32 = jnp.float32
    bsz, length, _ = z.shape
    xbc = jax.nn.silu(dwconv_centred(xbc, conv_w, conv_b))
    xs, bm, cm = jnp.split(xbc, [D_SSD, D_SSD + SSD_GROUPS * SSD_STATE], axis=-1)
    xs = xs.astype(f32).reshape(bsz, length, SSD_GROUPS, HEADS_PER_GROUP, SSD_HEADDIM)
    bm = bm.astype(f32).reshape(bsz, length, SSD_GROUPS, SSD_STATE)
    cm = cm.astype(f32).reshape(bsz, length, SSD_GROUPS, SSD_STATE)

    def discretise(dt_raw, dt_bias, a_log):
        dt = jax.nn.softplus(dt_raw.astype(f32) + dt_bias.astype(f32))
        dt = dt.reshape(bsz, length, SSD_GROUPS, HEADS_PER_GROUP)
        a = -jnp.exp(a_log.astype(f32)).reshape(SSD_GROUPS, HEADS_PER_GROUP) * dt
        return xs * dt[..., None], a

    xdt_f, a_f = discretise(dt_f_raw, dt_bias_f, a_log_f)
    xdt_b, a_b = discretise(dt_b_raw, dt_bias_b, a_log_b)
    flip = lambda t: jnp.flip(t, axis=1)
    y_f = ssd_chunked(xdt_f, a_f, bm, cm)
    y_b = flip(ssd_chunked(flip(xdt_b), flip(a_b), flip(bm), flip(cm)))
    y = y_f + y_b + xs * d_skip.astype(f32).reshape(SSD_GROUPS, HEADS_PER_GROUP)[..., None]
    y = y.reshape(bsz, length, D_SSD) * jax.nn.silu(z.astype(f32))
    yg = y.reshape(bsz, length, SSD_GROUPS, D_SSD // SSD_GROUPS)
    yg = yg * lax.rsqrt(jnp.mean(yg * yg, axis=-1, keepdims=True) + RMS_EPS)
    return (yg.reshape(bsz, length, D_SSD) * norm_w.astype(f32)).astype(z.dtype)


def short_conv_branch(sc_b, sc_c, sc_v, conv_w):
    return sc_b * dwconv_centred(sc_c * sc_v, conv_w)


def conv_ffn(n, w_up, conv_w, conv_b, w_down):
    u = jnp.einsum('bld,df->blf', n, w_up)
    u = dwconv_centred(u, conv_w, conv_b)
    gate, up = jnp.split(u, 2, axis=-1)
    return jnp.einsum('blf,fd->bld', jax.nn.silu(gate) * up, w_down)


def _dt_bias_init(k, shape):
    u = jax.random.uniform(k, shape, jnp.float32)
    dt = jnp.exp(u * (math.log(DT_MAX) - math.log(DT_MIN)) + math.log(DT_MIN))
    return dt + jnp.log(-jnp.expm1(-dt))


def setup_inputs(seed: int = 0) -> dict:
    key = jax.random.key(seed)
    ks = jax.random.split(key, 20)
    f32 = jnp.float32
    nrm = lambda k, shape, scale: jax.random.normal(k, shape, f32) * scale
    gain = lambda k, shape: 1.0 + 0.01 * jax.random.normal(k, shape, f32)
    return {
        'x': jax.random.normal(ks[0], (BATCH, SEQ, D_MODEL), f32),
        'w_in': nrm(ks[1], (DEPTH, D_MODEL, IN_COLS), D_MODEL ** -0.5),
        'conv_xbc_w': nrm(ks[2], (DEPTH, CONV_WIDTH, CONV_XBC), CONV_WIDTH ** -0.5),
        'conv_xbc_b': nrm(ks[3], (DEPTH, CONV_XBC), 0.01),
        'dt_bias_f': _dt_bias_init(ks[4], (DEPTH, SSD_HEADS)),
        'dt_bias_b': _dt_bias_init(ks[5], (DEPTH, SSD_HEADS)),
        'a_log_f': jnp.log(jax.random.uniform(ks[6], (DEPTH, SSD_HEADS), f32, 1.0, 16.0)),
        'a_log_b': jnp.log(jax.random.uniform(ks[7], (DEPTH, SSD_HEADS), f32, 1.0, 16.0)),
        'd_skip': gain(ks[8], (DEPTH, SSD_HEADS)),
        'ssd_norm_w': gain(ks[9], (DEPTH, D_SSD)),
        'sc_conv_w': nrm(ks[10], (DEPTH, CONV_WIDTH, D_SC), CONV_WIDTH ** -0.5),
        'w_out': nrm(ks[11], (DEPTH, D_MIX, D_MODEL), D_MIX ** -0.5),
        'norm1_w': gain(ks[12], (DEPTH, D_MODEL)),
        'norm2_w': gain(ks[13], (DEPTH, D_MODEL)),
        'w_ffn_up': nrm(ks[14], (DEPTH, D_MODEL, 2 * D_FF), D_MODEL ** -0.5),
        'ffn_conv_w': nrm(ks[15], (DEPTH, CONV_WIDTH, 2 * D_FF), CONV_WIDTH ** -0.5),
        'ffn_conv_b': nrm(ks[16], (DEPTH, 2 * D_FF), 0.01),
        'w_ffn_down': nrm(ks[17], (DEPTH, D_FF, D_MODEL), D_FF ** -0.5),
        'final_norm_w': gain(ks[18], (D_MODEL,)),
    }


def reference(x, w_in, conv_xbc_w, conv_xbc_b, dt_bias_f, dt_bias_b, a_log_f, a_log_b,
              d_skip, ssd_norm_w, sc_conv_w, w_out, norm1_w, norm2_w, w_ffn_up,
              ffn_conv_w, ffn_conv_b, w_ffn_down, final_norm_w):
    h = x
    for l in range(DEPTH):
        n = rms_norm(h, norm1_w[l])
        proj = jnp.einsum('bld,de->ble', n, w_in[l])
        z, xbc, dt_f, dt_b, sc_b, sc_c, sc_v = jnp.split(proj, SPLIT_POINTS, axis=-1)
        y_ssd = ssd_branch(z, xbc, dt_f, dt_b, conv_xbc_w[l], conv_xbc_b[l],
                           dt_bias_f[l], dt_bias_b[l], a_log_f[l], a_log_b[l],
                           d_skip[l], ssd_norm_w[l])
        y_sc = short_conv_branch(sc_b, sc_c, sc_v, sc_conv_w[l])
        mix = jnp.concatenate([y_ssd, y_sc], axis=-1)
        h = h + jnp.einsum('ble,ed->bld', mix, w_out[l])
        n = rms_norm(h, norm2_w[l])
        h = h + conv_ffn(n, w_ffn_up[l], ffn_conv_w[l], ffn_conv_b[l], w_ffn_down[l])
    return rms_norm(h, final_norm_w)
```

```cpp
#include <hip/hip_runtime.h>
#include <hip/hip_cooperative_groups.h>
#include <cstdio>
#include <type_traits>
namespace cg = cooperative_groups;
namespace pg8 {
#define PG8_LAS __attribute__((address_space(3)))
typedef unsigned short bf16_t;
typedef short bf16x8 __attribute__((ext_vector_type(8)));
typedef float f32x4 __attribute__((ext_vector_type(4)));
typedef unsigned u32x4 __attribute__((ext_vector_type(4)));
constexpr int BM = 256, BK = 64, HALF = 128, HTB = HALF * BK * 2  , STAGE_BYTES = 8 * HTB, NXCD = 8, WGM = 8;

__host__ __device__ __forceinline__ int lds_byte(int r, int c) { const int st = (r >> 4) * 2 + (c >> 5), rr = r & 15, cc = c & 31, ob = rr * 64 + cc * 2; return st * 1024 + (ob ^ (((ob >> 9) & 1) << 5)); }
__host__ __device__ __forceinline__ void stage_rc(int b, int& R, int& C) { const int st = b / 1024, sb = b % 1024, swz = sb ^ (((sb >> 9) & 1) << 5); R = (st >> 1) * 16 + swz / 64; C = (st & 1) * 32 + (swz % 64) / 2; }
__host__ __device__ __forceinline__ int perm32(int rho) { const int n = rho >> 4, i = rho & 15; return 8 * (i >> 2) + 4 * n + (i & 3); }

struct Unit { int pm, pn; };
struct Gemm { const bf16_t* A; const bf16_t* Bt; int M, N, K; int lda = 0; };
struct StaticOrder {
    int nM, nN, nwg, G, c;
    __host__ __device__ void init(int M, int N, int G_, int c_) { nM = M / BM; nN = N / BM; nwg = nM * nN; G = G_; c = c_; }
    __host__ __device__ bool next(int i, Unit& u) const {
        const long L = (long)i * G + c; if (L >= nwg) return false;
        int wgid = (int)L; { const int q = nwg / NXCD, r = nwg % NXCD, xcd = wgid % NXCD, off = wgid / NXCD; wgid = (xcd < r ? xcd * (q + 1) : r * (q + 1) + (xcd - r) * q) + off; }
        const int nig = WGM * nN, gid = wgid / nig, fm = gid * WGM, gsz = (nM - fm) < WGM ? (nM - fm) : WGM;
        u.pm = fm + ((wgid % nig) % gsz); u.pn = (wgid % nig) / gsz; return true;
    }
    __device__ __forceinline__ void a_ready(const Unit&) const {}
    __device__ __forceinline__ void done(const Unit&) const {}
};
__device__ __forceinline__ unsigned cvt_pk_bf16(float lo, float hi) { unsigned r; asm volatile("v_cvt_pk_bf16_f32 %0, %1, %2" : "=v"(r) : "v"(lo), "v"(hi)); return r; }
template <class Epi, class Sched, bool ALIGN_EPI = false, bool SP2 = false>
__device__ __forceinline__ void gemm_phase(PG8_LAS unsigned char* lds, const Gemm g, const Sched& S, const Epi& E) {
    int tid_ = threadIdx.x; asm volatile("" : "+v"(tid_));
    const int tid = tid_, wid = __builtin_amdgcn_readfirstlane(tid >> 6), lane = tid & 63, wr = wid >> 2, wc = wid & 3, fr = lane & 15, fq = lane >> 4;
    const int K = g.K, nt = K / BK, LDA = g.lda ? g.lda : g.K;
    unsigned voffA[2], voffB[2];
#pragma unroll
    for (int i = 0; i < 2; ++i) { int R, C; stage_rc(tid * 16 + i * 8192, R, C); const int Rb = Epi::PERM ? ((R & ~31) + perm32(R & 31)) : R;
        voffA[i] = (unsigned)(R * LDA + C) * 2u; voffB[i] = (unsigned)(Rb * K + C) * 2u; }
    const size_t kstep = (size_t)(BK * 2);
    const size_t hstep = (size_t)HALF * K * 2;
    const size_t tstep = 2 * hstep;
    const size_t hstepA = (size_t)HALF * LDA * 2, tstepA = 2 * hstepA;
    const unsigned ldsw = (unsigned)wid * 1024u;
    const int aoff = lds_byte(wr * 64 + fr, fq * 8), boff = lds_byte(wc * 32 + fr, fq * 8);
#define PG8_SA(b, h) (((b) * 2 + (h)) * HTB)
#define PG8_SB(b, h) ((4 + (b) * 2 + (h)) * HTB)
#define PG8_STAGE(bufoff, gbase, voff) do { _Pragma("unroll") for (int _i = 0; _i < 2; ++_i) \
        __builtin_amdgcn_global_load_lds((const unsigned*)((const char*)(gbase) + (voff)[_i]), (PG8_LAS unsigned*)(lds + (bufoff) + ldsw + _i * 8192), 16, 0, 0); } while (0)
#define PG8_LDA(dst, b, h) do { _Pragma("unroll") for (int m = 0; m < 4; ++m) _Pragma("unroll") for (int k = 0; k < 2; ++k) dst[m][k] = *(const PG8_LAS bf16x8*)(lds + PG8_SA(b, h) + aoff + m * 2048 + k * 1024); } while (0)
#define PG8_LDB(dst, b, h) do { _Pragma("unroll") for (int n = 0; n < 2; ++n) _Pragma("unroll") for (int k = 0; k < 2; ++k) dst[n][k] = *(const PG8_LAS bf16x8*)(lds + PG8_SB(b, h) + boff + n * 2048 + k * 1024); } while (0)
#define PG8_MMA(ai, bj, At, Bt) do { __builtin_amdgcn_s_setprio(1); _Pragma("unroll") for (int m = 0; m < 4; ++m) _Pragma("unroll") for (int n = 0; n < 2; ++n) _Pragma("unroll") for (int k = 0; k < 2; ++k) \
        acc[ai][bj][m][n] = __builtin_amdgcn_mfma_f32_16x16x32_bf16(Bt[n][k], At[m][k], acc[ai][bj][m][n], 0, 0, 0); __builtin_amdgcn_s_setprio(0); } while (0)
#define PG8_WAIT_V(n) asm volatile("s_waitcnt vmcnt(" #n ")" ::: "memory")
#define PG8_WAIT_L(n) asm volatile("s_waitcnt lgkmcnt(" #n ")" ::: "memory")
#define PG8_BAR __builtin_amdgcn_s_barrier()
#define PG8_SCHED __builtin_amdgcn_sched_barrier(0)
    Unit cur, nxt; int ui = 0;
    if (!S.next(0, cur)) return;
    f32x4 acc[2][2][4][2];
#pragma unroll
    for (int a = 0; a < 2; ++a)
#pragma unroll
        for (int b = 0; b < 2; ++b)
#pragma unroll
            for (int m = 0; m < 4; ++m)
#pragma unroll
                for (int n = 0; n < 2; ++n) acc[a][b][m][n] = (f32x4){0.f, 0.f, 0.f, 0.f};
    bf16x8 At[4][2], B0[2][2], B1[2][2];
    const char* cA = (const char*)g.A + (size_t)cur.pm * tstepA; const char* cB = (const char*)g.Bt + (size_t)cur.pn * tstep;
    S.a_ready(cur);
    if constexpr (SP2) {
        PG8_STAGE(PG8_SB(0, 0), cB, voffB); PG8_STAGE(PG8_SB(0, 1), cB + hstep, voffB); PG8_STAGE(PG8_SA(0, 0), cA, voffA); PG8_STAGE(PG8_SA(0, 1), cA + hstepA, voffA);
        if (wr == 1) PG8_BAR;
        PG8_WAIT_V(2); PG8_BAR;
        PG8_STAGE(PG8_SB(1, 0), cB + kstep, voffB); PG8_STAGE(PG8_SA(1, 0), cA + kstep, voffA); PG8_STAGE(PG8_SB(1, 1), cB + hstep + kstep, voffB);
        PG8_WAIT_V(6); PG8_BAR;
    } else {
        PG8_STAGE(PG8_SB(0, 0), cB, voffB); PG8_STAGE(PG8_SA(0, 0), cA, voffA); PG8_STAGE(PG8_SB(0, 1), cB + hstep, voffB); PG8_STAGE(PG8_SA(0, 1), cA + hstepA, voffA);
        if (wr == 1) PG8_BAR;
        PG8_WAIT_V(4); PG8_BAR;
        PG8_STAGE(PG8_SB(1, 0), cB + kstep, voffB); PG8_STAGE(PG8_SA(1, 0), cA + kstep, voffA); PG8_STAGE(PG8_SB(1, 1), cB + hstep + kstep, voffB);
        PG8_WAIT_V(6); PG8_BAR;
    }
    for (;;) {
        const bool has_next = S.next(ui + 1, nxt);
        const char* nA = has_next ? (const char*)g.A + (size_t)nxt.pm * tstepA : cA; const char* nB = has_next ? (const char*)g.Bt + (size_t)nxt.pn * tstep : cB;
        for (int t = 0; t < nt; t += 2) {
            const bool last = (t == nt - 2);
            const char* a1 = cA + (size_t)(t + 1) * kstep;
            const char* a2 = last ? nA : cA + (size_t)(t + 2) * kstep; const char* b2 = last ? nB : cB + (size_t)(t + 2) * kstep;
            const char* a3 = a2 + kstep; const char* b3 = b2 + kstep;
            if (last && has_next) S.a_ready(nxt);
            if constexpr (SP2) {
            PG8_LDB(B0, 0, 0); PG8_LDB(B1, 0, 1); PG8_SCHED; PG8_LDA(At, 0, 0); PG8_STAGE(PG8_SA(1, 1), a1 + hstepA, voffA);
            PG8_WAIT_V(8); PG8_WAIT_L(0); PG8_BAR; PG8_MMA(0, 0, At, B0); PG8_MMA(0, 1, At, B1); PG8_BAR; PG8_SCHED;
            PG8_LDA(At, 0, 1); PG8_STAGE(PG8_SB(0, 0), b2, voffB); PG8_STAGE(PG8_SB(0, 1), b2 + hstep, voffB); PG8_STAGE(PG8_SA(0, 0), a2, voffA);
            PG8_WAIT_V(8); PG8_WAIT_L(0); PG8_BAR; PG8_MMA(1, 0, At, B0); PG8_MMA(1, 1, At, B1); PG8_BAR; PG8_SCHED;
            PG8_LDB(B0, 1, 0); PG8_LDB(B1, 1, 1); PG8_SCHED; PG8_LDA(At, 1, 0); PG8_STAGE(PG8_SA(0, 1), a2 + hstepA, voffA);
            PG8_WAIT_V(8); PG8_WAIT_L(0); PG8_BAR; PG8_MMA(0, 0, At, B0); PG8_MMA(0, 1, At, B1); PG8_BAR; PG8_SCHED;
            PG8_LDA(At, 1, 1); PG8_STAGE(PG8_SB(1, 0), b3, voffB); PG8_STAGE(PG8_SB(1, 1), b3 + hstep, voffB); PG8_STAGE(PG8_SA(1, 0), a3, voffA);
            PG8_WAIT_V(8); PG8_WAIT_L(0); PG8_BAR; PG8_MMA(1, 0, At, B0); PG8_MMA(1, 1, At, B1); PG8_BAR; PG8_SCHED;
            } else {
            PG8_LDB(B0, 0, 0); PG8_SCHED; PG8_LDA(At, 0, 0); PG8_STAGE(PG8_SA(1, 1), a1 + hstepA, voffA);
            PG8_WAIT_L(8); PG8_BAR; PG8_WAIT_L(0); PG8_MMA(0, 0, At, B0); PG8_BAR; PG8_SCHED;
            PG8_LDB(B1, 0, 1); PG8_STAGE(PG8_SB(0, 0), b2, voffB);
            PG8_BAR; PG8_WAIT_L(0); PG8_MMA(0, 1, At, B1); PG8_BAR;
            PG8_LDA(At, 0, 1); PG8_STAGE(PG8_SA(0, 0), a2, voffA);
            PG8_BAR; PG8_WAIT_L(0); PG8_MMA(1, 0, At, B0); PG8_BAR; PG8_SCHED;
            PG8_STAGE(PG8_SB(0, 1), b2 + hstep, voffB);
            PG8_WAIT_V(6); PG8_BAR; PG8_MMA(1, 1, At, B1); PG8_BAR;
            PG8_LDB(B0, 1, 0); PG8_SCHED; PG8_LDA(At, 1, 0); PG8_STAGE(PG8_SA(0, 1), a2 + hstepA, voffA);
            PG8_WAIT_L(8); PG8_BAR; PG8_WAIT_L(0); PG8_MMA(0, 0, At, B0); PG8_BAR; PG8_SCHED;
            PG8_LDB(B1, 1, 1); PG8_STAGE(PG8_SB(1, 0), b3, voffB);
            PG8_BAR; PG8_WAIT_L(0); PG8_MMA(0, 1, At, B1); PG8_BAR;
            PG8_LDA(At, 1, 1); PG8_STAGE(PG8_SA(1, 0), a3, voffA);
            PG8_BAR; PG8_WAIT_L(0); PG8_MMA(1, 0, At, B0); PG8_BAR; PG8_SCHED;
            PG8_STAGE(PG8_SB(1, 1), b3 + hstep, voffB);
            PG8_WAIT_V(6); PG8_BAR; PG8_MMA(1, 1, At, B1); PG8_BAR;
            }
        }
        if constexpr (ALIGN_EPI) { if (wr == 0) PG8_BAR; }
        if constexpr (!Epi::AFTER_DRAIN) { E(acc, cur, wr, wc, fr, fq); S.done(cur); }
        if (!has_next) break;
#pragma unroll
        for (int a = 0; a < 2; ++a)
#pragma unroll
            for (int b = 0; b < 2; ++b)
#pragma unroll
                for (int m = 0; m < 4; ++m)
#pragma unroll
                    for (int n = 0; n < 2; ++n) acc[a][b][m][n] = (f32x4){0.f, 0.f, 0.f, 0.f};
        cur = nxt; cA = nA; cB = nB; ++ui;
        if constexpr (ALIGN_EPI) { if (wr == 1) PG8_BAR; }
    }
    PG8_WAIT_V(0);
    if constexpr (!ALIGN_EPI) { if (wr == 0) PG8_BAR; }
    PG8_BAR;
    if constexpr (Epi::AFTER_DRAIN) { E.fused(acc, cur, wr, wc, fr, fq, lds, wid, lane); S.done(cur); }
#undef PG8_SA
#undef PG8_SB
#undef PG8_STAGE
#undef PG8_LDA
#undef PG8_LDB
#undef PG8_MMA
#undef PG8_WAIT_V
#undef PG8_WAIT_L
#undef PG8_BAR
#undef PG8_SCHED
}
}

using pg8::bf16_t; using pg8::bf16x8; using pg8::f32x4; using pg8::u32x4; using pg8::Unit;
typedef unsigned u32x2 __attribute__((ext_vector_type(2)));
#ifndef NPART
#define NPART 2
#endif
constexpr int TH = 65536 / NPART;
constexpr int NBP = TH / 4096;
constexpr int SEQ = 4096, DM = 1024, NIN = 6144, LDP = 5120, DFF = 2816, NUP = 5632, DMIX = 2048;
constexpr int LSTR = 136;
constexpr float EPS = 1e-5f;
constexpr int PC_Z = 0, PC_SB = 1024, PC_X = 2048, PC_P = 4096;
constexpr int LDS_BYTES = 152 * 1024;
constexpr size_t WT_IN_B = (size_t)NIN * DM * 2, WT_OUT_B = (size_t)DM * DMIX * 2, WT_UP_B = (size_t)NUP * DM * 2, WT_DN_B = (size_t)DM * DFF * 2;
constexpr size_t WL_B = WT_IN_B + WT_OUT_B + WT_UP_B + WT_DN_B;
constexpr size_t OFF_ROWSS = 2 * WL_B;
constexpr size_t OFF_CHDEC = OFF_ROWSS + (size_t)NPART * 5 * TH * 16 * 4;
constexpr size_t OFF_PROJ = OFF_CHDEC + (size_t)NBP * 32 * 16 * 2 * 4;
constexpr size_t OFF_DT = OFF_PROJ + (size_t)TH * LDP * 2;
constexpr size_t OFF_ST = OFF_DT + (size_t)TH * 32 * 4;
constexpr size_t OFF_HB = OFF_ST + (size_t)NBP * 32 * 16 * 2 * 8192 * 2;
constexpr size_t WS_END = OFF_HB + (size_t)TH * DM * 2;
constexpr size_t OFF_BAR = WS_END;
constexpr size_t OFF_EDGER = OFF_BAR + 16384;
constexpr size_t OFF_EDGEP = OFF_EDGER + (size_t)(TH / 256) * 2 * NUP * 4;
constexpr size_t OFF_WDT = OFF_EDGEP + (size_t)(TH / 256) * 2 * NUP * 4;
constexpr size_t OFF_XEDGER = OFF_WDT + (size_t)2 * 32 * DM * 2;
constexpr size_t OFF_XEDGEP = OFF_XEDGER + (size_t)(TH / 256) * 2 * 2048 * 4;
constexpr size_t WS_NEED = OFF_XEDGEP + (size_t)(TH / 256) * 2 * 2048 * 4;
constexpr size_t OFF_ACT = OFF_PROJ;
static_assert((size_t)TH * DFF * 2 <= (size_t)TH * LDP * 2 && (size_t)TH * DM * 2 <= (size_t)NBP * 32 * 16 * 2 * 8192 * 2, "overlay sizes");
static_assert(OFF_HB % 256 == 0 && OFF_PROJ % 256 == 0 && OFF_ST % 256 == 0 && TH % 4096 == 0, "align");

struct Params {
    const float* in[19];
    float* out;
    unsigned char* ws;
    int ph_lo, ph_hi;
};
enum { I_X = 0, I_WIN, I_CXW, I_CXB, I_DTBF, I_DTBB, I_ALF, I_ALB, I_DSK, I_SNW, I_SCW, I_WOUT, I_N1, I_N2, I_WUP, I_FCW, I_FCB, I_WDN, I_FNW };

typedef __bf16 bf16x2_t __attribute__((ext_vector_type(2)));
typedef float f32x2_t __attribute__((ext_vector_type(2)));
__device__ __forceinline__ unsigned pk2(float lo, float hi) { const f32x2_t v = {lo, hi}; const bf16x2_t b = __builtin_convertvector(v, bf16x2_t); return __builtin_bit_cast(unsigned, b); }
__device__ __forceinline__ float bflo(unsigned w) { return __uint_as_float(w << 16); }
__device__ __forceinline__ float bfhi(unsigned w) { return __uint_as_float(w & 0xffff0000u); }
__device__ __forceinline__ float bf2f(bf16_t b) { return __uint_as_float(((unsigned)b) << 16); }
__device__ __forceinline__ float silu_f(float v) { return v * __builtin_amdgcn_rcpf(1.0f + __expf(-v)); }
__device__ __forceinline__ float softplus_f(float v) { return v > 20.0f ? v : log1pf(__expf(v)); }
__device__ __forceinline__ void unpack8(const u32x4 w, float (&f)[8]) { f[0] = bflo(w.x); f[1] = bfhi(w.x); f[2] = bflo(w.y); f[3] = bfhi(w.y); f[4] = bflo(w.z); f[5] = bfhi(w.z); f[6] = bflo(w.w); f[7] = bfhi(w.w); }
__device__ __forceinline__ u32x4 pack8(const float (&f)[8]) { u32x4 w; w.x = pk2(f[0], f[1]); w.y = pk2(f[2], f[3]); w.z = pk2(f[4], f[5]); w.w = pk2(f[6], f[7]); return w; }

__device__ __forceinline__ float row_rs(const float* rowss, int row) {
    const f32x4 a = *(const f32x4*)(rowss + (size_t)row * 16), b = *(const f32x4*)(rowss + (size_t)row * 16 + 4), c = *(const f32x4*)(rowss + (size_t)row * 16 + 8), d = *(const f32x4*)(rowss + (size_t)row * 16 + 12);
    const float s = (((a[0] + a[1]) + (a[2] + a[3])) + ((b[0] + b[1]) + (b[2] + b[3]))) + (((c[0] + c[1]) + (c[2] + c[3])) + ((d[0] + d[1]) + (d[2] + d[3])));
    return rsqrtf(s * (1.0f / 1024.0f) + EPS);
}
__device__ __forceinline__ void panel_rs(const float* rowss, int pm, int& cached_pm, float* rs_lds) {
    if (pm != cached_pm) {
        cached_pm = pm;
        int tid_ = threadIdx.x; asm volatile("" : "+v"(tid_));
        __syncthreads();
        if (tid_ < 256) rs_lds[tid_] = row_rs(rowss, pm * 256 + tid_);
        __syncthreads();
    }
}
struct EpiUp {
    static constexpr bool PERM = true, AFTER_DRAIN = false;
    bf16_t* U; const float* rowss; float* rs_lds; mutable int cached_pm;
    __device__ __forceinline__ void operator()(const f32x4 (&acc)[2][2][4][2], const Unit& u, int wr, int wc, int fr, int fq) const {
        const int row0 = u.pm * 256 + wr * 64 + fr;
        panel_rs(rowss, u.pm, cached_pm, rs_lds);
#pragma unroll
        for (int ai = 0; ai < 2; ++ai)
#pragma unroll
            for (int m = 0; m < 4; ++m) {
                const int row = row0 + ai * 128 + m * 16;
                const float rs = rs_lds[row & 255];
#pragma unroll
                for (int bj = 0; bj < 2; ++bj) { const f32x4 v0 = acc[ai][bj][m][0] * rs, v1 = acc[ai][bj][m][1] * rs; u32x4 w; w.x = pk2(v0[0], v0[1]); w.y = pk2(v0[2], v0[3]); w.z = pk2(v1[0], v1[1]); w.w = pk2(v1[2], v1[3]);
                    *(u32x4*)(U + (size_t)row * NUP + u.pn * 256 + bj * 128 + wc * 32 + 8 * fq) = w; }
            }
    }
};
struct EpiRes {
    static constexpr bool PERM = true, AFTER_DRAIN = false;
    bf16_t* HB; float* rowss_next;
    __device__ __forceinline__ void operator()(const f32x4 (&acc)[2][2][4][2], const Unit& u, int wr, int wc, int fr, int fq) const {
        const int row0 = u.pm * 256 + wr * 64 + fr, col0 = u.pn * 256 + wc * 32 + 8 * fq;
#pragma unroll
        for (int ai = 0; ai < 2; ++ai)
#pragma unroll
            for (int m = 0; m < 4; ++m) {
                const int row = row0 + ai * 128 + m * 16; float ss = 0.f;
#pragma unroll
                for (int bj = 0; bj < 2; ++bj) { const size_t off = (size_t)row * DM + col0 + bj * 128;
                    const u32x4 hb = *(const u32x4*)(HB + off);
                    f32x4 o0 = acc[ai][bj][m][0], o1 = acc[ai][bj][m][1];
                    o0[0] += bflo(hb.x); o0[1] += bfhi(hb.x); o0[2] += bflo(hb.y); o0[3] += bfhi(hb.y); o1[0] += bflo(hb.z); o1[1] += bfhi(hb.z); o1[2] += bflo(hb.w); o1[3] += bfhi(hb.w);
                    u32x4 w; w.x = pk2(o0[0], o0[1]); w.y = pk2(o0[2], o0[3]); w.z = pk2(o1[0], o1[1]); w.w = pk2(o1[2], o1[3]); *(u32x4*)(HB + off) = w;
                    ss += ((o0[0] * o0[0] + o0[1] * o0[1]) + (o0[2] * o0[2] + o0[3] * o0[3])) + ((o1[0] * o1[0] + o1[1] * o1[1]) + (o1[2] * o1[2] + o1[3] * o1[3])); }
                ss += __shfl_xor(ss, 16); ss += __shfl_xor(ss, 32);
                if (fq == 0) rowss_next[(size_t)row * 16 + u.pn * 4 + wc] = ss;
            }
    }
};


__device__ __forceinline__ float dpp_shr1(float old, float src) { return __builtin_bit_cast(float, __builtin_amdgcn_update_dpp(__builtin_bit_cast(int, old), __builtin_bit_cast(int, src), 0x111, 0xf, 0xf, false)); }
__device__ __forceinline__ float dpp_shl1(float old, float src) { return __builtin_bit_cast(float, __builtin_amdgcn_update_dpp(__builtin_bit_cast(int, old), __builtin_bit_cast(int, src), 0x101, 0xf, 0xf, false)); }
__device__ __forceinline__ float dpp_ror1(float src) { return __builtin_bit_cast(float, __builtin_amdgcn_update_dpp(0, __builtin_bit_cast(int, src), 0x121, 0xf, 0xf, false)); }
__device__ __forceinline__ float dpp_rol1(float src) { return __builtin_bit_cast(float, __builtin_amdgcn_update_dpp(0, __builtin_bit_cast(int, src), 0x12F, 0xf, 0xf, false)); }
struct EpiIn {
    static constexpr bool PERM = true, AFTER_DRAIN = false;
    bf16_t* P; const float* rowss; float* rs_lds; float* xch; const float* cxw; const float* cxb; float* XEDGER; float* XEDGEP; mutable int cached_pm;
    __device__ __forceinline__ void operator()(const f32x4 (&acc_)[2][2][4][2], const Unit& u, int wr, int wc, int fr_, int fq_) const {
        f32x4 (&acc)[2][2][4][2] = const_cast<f32x4 (&)[2][2][4][2]>(acc_);
        int fr = fr_, fq = fq_; asm volatile("" : "+v"(fr), "+v"(fq));
        const int row0 = u.pm * 256 + wr * 64 + fr; const int pn = u.pn;
        panel_rs(rowss, u.pm, cached_pm, rs_lds);
        if (pn >= 4 && pn < 12) {
#pragma unroll
            for (int ai = 0; ai < 2; ++ai)
#pragma unroll
                for (int m = 0; m < 4; ++m) { const float rs = rs_lds[ai * 128 + wr * 64 + m * 16 + fr];
#pragma unroll
                    for (int bj = 0; bj < 2; ++bj)
#pragma unroll
                        for (int n = 0; n < 2; ++n) acc[ai][bj][m][n] *= rs; }
#pragma unroll
            for (int ai = 0; ai < 2; ++ai) { const int seg = 2 * ai + wr;
                if (fr == 0) {
#pragma unroll
                    for (int bj = 0; bj < 2; ++bj)
#pragma unroll
                        for (int n = 0; n < 2; ++n) *(f32x4*)(xch + (((seg * 2 + 0) * 4 + wc) * 4 + fq) * 16 + bj * 8 + n * 4) = acc[ai][bj][0][n]; }
                if (fr == 15) {
#pragma unroll
                    for (int bj = 0; bj < 2; ++bj)
#pragma unroll
                        for (int n = 0; n < 2; ++n) *(f32x4*)(xch + (((seg * 2 + 1) * 4 + wc) * 4 + fq) * 16 + bj * 8 + n * 4) = acc[ai][bj][3][n]; } }
            __syncthreads();
            auto body = [&](auto BJ_, auto AI_) {
                constexpr int bj = decltype(BJ_)::value, ai = decltype(AI_)::value;
                const int ch = (pn - 4) * 256 + bj * 128 + wc * 32 + 8 * fq, seg = 2 * ai + wr;
                f32x4 w0[2], w1[2], w2[2], bb[2];
#pragma unroll
                for (int n = 0; n < 2; ++n) { w0[n] = *(const f32x4*)(cxw + ch + 4 * n); w1[n] = *(const f32x4*)(cxw + 2048 + ch + 4 * n); w2[n] = *(const f32x4*)(cxw + 4096 + ch + 4 * n); bb[n] = *(const f32x4*)(cxb + ch + 4 * n); }
#pragma unroll
                for (int m = 0; m < 4; ++m) {
                    f32x4 pr[2], pe[2], ne[2];
#pragma unroll
                    for (int n = 0; n < 2; ++n) { pe[n] = (f32x4){0.f, 0.f, 0.f, 0.f}; ne[n] = pe[n];
                        if (m == 0 && seg > 0) pe[n] = *(const f32x4*)(xch + ((((seg - 1) * 2 + 1) * 4 + wc) * 4 + fq) * 16 + bj * 8 + n * 4);
                        if (m == 3 && seg < 3) ne[n] = *(const f32x4*)(xch + ((((seg + 1) * 2 + 0) * 4 + wc) * 4 + fq) * 16 + bj * 8 + n * 4); }
#pragma unroll
                    for (int n = 0; n < 2; ++n)
#pragma unroll
                        for (int j = 0; j < 4; ++j) {
                            const float cur = acc[ai][bj][m][n][j];
                            const float ov = (m > 0) ? dpp_ror1(acc[ai][bj][m > 0 ? m - 1 : 0][n][j]) : pe[n][j];
                            const float nv = (m < 3) ? dpp_rol1(acc[ai][bj][m < 3 ? m + 1 : 3][n][j]) : ne[n][j];
                            const float prev = dpp_shr1(ov, cur), next = dpp_shl1(nv, cur);
                            pr[n][j] = w0[n][j] * prev + w1[n][j] * cur + w2[n][j] * next + bb[n][j]; }
                    const int row = u.pm * 256 + ai * 128 + wr * 64 + m * 16 + fr;
                    u32x4 w; w.x = pk2(silu_f(pr[0][0]), silu_f(pr[0][1])); w.y = pk2(silu_f(pr[0][2]), silu_f(pr[0][3])); w.z = pk2(silu_f(pr[1][0]), silu_f(pr[1][1])); w.w = pk2(silu_f(pr[1][2]), silu_f(pr[1][3]));
                    *(u32x4*)(P + (size_t)row * LDP + PC_X + ch) = w;
                    if ((m == 0 && seg == 0 && fr == 0) || (m == 3 && seg == 3 && fr == 15)) {
                        const size_t eb = ((size_t)u.pm * 2 + (m == 0 ? 0 : 1)) * 2048 + ch;
                        *(f32x4*)(XEDGER + eb) = acc[ai][bj][m][0]; *(f32x4*)(XEDGER + eb + 4) = acc[ai][bj][m][1];
                        *(f32x4*)(XEDGEP + eb) = pr[0];             *(f32x4*)(XEDGEP + eb + 4) = pr[1]; }
                }
                __builtin_amdgcn_sched_barrier(0);
            };
            body(std::integral_constant<int, 0>{}, std::integral_constant<int, 0>{}); body(std::integral_constant<int, 0>{}, std::integral_constant<int, 1>{});
            body(std::integral_constant<int, 1>{}, std::integral_constant<int, 0>{}); body(std::integral_constant<int, 1>{}, std::integral_constant<int, 1>{});
            return;
        }
#pragma unroll
        for (int ai = 0; ai < 2; ++ai)
#pragma unroll
            for (int m = 0; m < 4; ++m) {
                const int row = row0 + ai * 128 + m * 16;
                const float rs = rs_lds[row & 255];
                if (pn < 16) {
                    const int cbase = (pn < 4 ? PC_Z + pn * 256 : PC_SB + (pn - 12) * 256);
#pragma unroll
                    for (int bj = 0; bj < 2; ++bj) { const f32x4 v0 = acc[ai][bj][m][0] * rs, v1 = acc[ai][bj][m][1] * rs; u32x4 w; w.x = pk2(v0[0], v0[1]); w.y = pk2(v0[2], v0[3]); w.z = pk2(v1[0], v1[1]); w.w = pk2(v1[2], v1[3]);
                        *(u32x4*)(P + (size_t)row * LDP + cbase + bj * 128 + wc * 32 + 8 * fq) = w; }
                } else {
                    const float rs2 = rs * rs; const f32x4 v0 = acc[ai][0][m][0] * acc[ai][1][m][0] * rs2, v1 = acc[ai][0][m][1] * acc[ai][1][m][1] * rs2;
                    u32x4 w; w.x = pk2(v0[0], v0[1]); w.y = pk2(v0[2], v0[3]); w.z = pk2(v1[0], v1[1]); w.w = pk2(v1[2], v1[3]);
                    *(u32x4*)(P + (size_t)row * LDP + PC_P + (pn - 16) * 128 + wc * 32 + 8 * fq) = w;
                }
            }
    }
};
struct EpiAct {
    static constexpr bool PERM = true, AFTER_DRAIN = false;
    bf16_t* ACT; const float* rowss; float* rs_lds; float* xch; const float* cw; const float* cb; float* EDGER; float* EDGEP; mutable int cached_pm;
    __device__ __forceinline__ void operator()(const f32x4 (&acc_)[2][2][4][2], const Unit& u, int wr, int wc, int fr_, int fq_) const {
        int fr = fr_, fq = fq_; asm volatile("" : "+v"(fr), "+v"(fq));
        f32x4 (&acc)[2][2][4][2] = const_cast<f32x4 (&)[2][2][4][2]>(acc_);
        panel_rs(rowss, u.pm, cached_pm, rs_lds);
#pragma unroll
        for (int ai = 0; ai < 2; ++ai)
#pragma unroll
            for (int m = 0; m < 4; ++m) { const float rs = rs_lds[ai * 128 + wr * 64 + m * 16 + fr];
#pragma unroll
                for (int bj = 0; bj < 2; ++bj)
#pragma unroll
                    for (int n = 0; n < 2; ++n) acc[ai][bj][m][n] *= rs; }
#pragma unroll
        for (int ai = 0; ai < 2; ++ai) { const int seg = 2 * ai + wr;
            if (fr == 0) {
#pragma unroll
                for (int bj = 0; bj < 2; ++bj)
#pragma unroll
                    for (int n = 0; n < 2; ++n) *(f32x4*)(xch + (((seg * 2 + 0) * 4 + wc) * 4 + fq) * 16 + bj * 8 + n * 4) = acc[ai][bj][0][n]; }
            if (fr == 15) {
#pragma unroll
                for (int bj = 0; bj < 2; ++bj)
#pragma unroll
                    for (int n = 0; n < 2; ++n) *(f32x4*)(xch + (((seg * 2 + 1) * 4 + wc) * 4 + fq) * 16 + bj * 8 + n * 4) = acc[ai][bj][3][n]; } }
        const int f0 = u.pn * 128 + wc * 32 + 8 * fq;
        f32x4 w0v[8];
        { const int f = f0; w0v[0] = *(const f32x4*)(cw + f); w0v[1] = *(const f32x4*)(cw + NUP + f); w0v[2] = *(const f32x4*)(cw + 2 * NUP + f); w0v[3] = *(const f32x4*)(cb + f);
          w0v[4] = *(const f32x4*)(cw + DFF + f); w0v[5] = *(const f32x4*)(cw + NUP + DFF + f); w0v[6] = *(const f32x4*)(cw + 2 * NUP + DFF + f); w0v[7] = *(const f32x4*)(cb + DFF + f); }
        __syncthreads();
        auto body = [&](auto N_, auto AI_, const f32x4 (&wv)[8]) {
            constexpr int n = decltype(N_)::value, ai = decltype(AI_)::value;
            const int f = f0 + 4 * n, seg = 2 * ai + wr;
            const f32x4 wg0 = wv[0], wg1 = wv[1], wg2 = wv[2], bg = wv[3], wu0 = wv[4], wu1 = wv[5], wu2 = wv[6], bu = wv[7];
            f32x4 peg = (f32x4){0.f, 0.f, 0.f, 0.f}, peu = peg, neg = peg, neu = peg;
            if (seg > 0) { peg = *(const f32x4*)(xch + ((((seg - 1) * 2 + 1) * 4 + wc) * 4 + fq) * 16 + n * 4); peu = *(const f32x4*)(xch + ((((seg - 1) * 2 + 1) * 4 + wc) * 4 + fq) * 16 + 8 + n * 4); }
            if (seg < 3) { neg = *(const f32x4*)(xch + ((((seg + 1) * 2 + 0) * 4 + wc) * 4 + fq) * 16 + n * 4); neu = *(const f32x4*)(xch + ((((seg + 1) * 2 + 0) * 4 + wc) * 4 + fq) * 16 + 8 + n * 4); }
#pragma unroll
            for (int m = 0; m < 4; ++m) {
                const f32x4 sgm = acc[ai][0][m][n], sum_ = acc[ai][1][m][n];
                f32x4 pg, pu;
#pragma unroll
                for (int j = 0; j < 4; ++j) {
                    const float og = (m > 0) ? dpp_ror1(acc[ai][0][m > 0 ? m - 1 : 0][n][j]) : peg[j], ou = (m > 0) ? dpp_ror1(acc[ai][1][m > 0 ? m - 1 : 0][n][j]) : peu[j];
                    const float ng = (m < 3) ? dpp_rol1(acc[ai][0][m < 3 ? m + 1 : 3][n][j]) : neg[j], nu = (m < 3) ? dpp_rol1(acc[ai][1][m < 3 ? m + 1 : 3][n][j]) : neu[j];
                    const float gprev = dpp_shr1(og, sgm[j]), uprev = dpp_shr1(ou, sum_[j]);
                    const float gnext = dpp_shl1(ng, sgm[j]), unext = dpp_shl1(nu, sum_[j]);
                    pg[j] = wg0[j] * gprev + wg1[j] * sgm[j] + wg2[j] * gnext + bg[j];
                    pu[j] = wu0[j] * uprev + wu1[j] * sum_[j] + wu2[j] * unext + bu[j];
                }
                const int row = u.pm * 256 + ai * 128 + wr * 64 + m * 16 + fr;
                u32x2 w; w.x = pk2(silu_f(pg[0]) * pu[0], silu_f(pg[1]) * pu[1]); w.y = pk2(silu_f(pg[2]) * pu[2], silu_f(pg[3]) * pu[3]);
                *(u32x2*)(ACT + (size_t)row * DFF + f) = w;
                if ((m == 0 && seg == 0 && fr == 0) || (m == 3 && seg == 3 && fr == 15)) {
                    const size_t eb = ((size_t)u.pm * 2 + (m == 0 ? 0 : 1)) * NUP;
                    *(f32x4*)(EDGER + eb + f) = sgm; *(f32x4*)(EDGER + eb + DFF + f) = sum_;
                    *(f32x4*)(EDGEP + eb + f) = pg;  *(f32x4*)(EDGEP + eb + DFF + f) = pu; }
            }
        };
        body(std::integral_constant<int, 0>{}, std::integral_constant<int, 0>{}, w0v);
        f32x4 w1v[8];
        { const int f = f0 + 4; w1v[0] = *(const f32x4*)(cw + f); w1v[1] = *(const f32x4*)(cw + NUP + f); w1v[2] = *(const f32x4*)(cw + 2 * NUP + f); w1v[3] = *(const f32x4*)(cb + f);
          w1v[4] = *(const f32x4*)(cw + DFF + f); w1v[5] = *(const f32x4*)(cw + NUP + DFF + f); w1v[6] = *(const f32x4*)(cw + 2 * NUP + DFF + f); w1v[7] = *(const f32x4*)(cb + DFF + f); }
        __builtin_amdgcn_sched_barrier(0);
        body(std::integral_constant<int, 0>{}, std::integral_constant<int, 1>{}, w0v);
        __builtin_amdgcn_sched_barrier(0);
        body(std::integral_constant<int, 1>{}, std::integral_constant<int, 0>{}, w1v);
        __builtin_amdgcn_sched_barrier(0);
        body(std::integral_constant<int, 1>{}, std::integral_constant<int, 1>{}, w1v);
    }
};

__device__ __forceinline__ int src_in(int j) {
    if (j < 3072) return j;
    if (j < 4096) return j + 32;
    { const int t = (j - 4096) >> 8, r = (j - 4096) & 255; return r < 128 ? 4128 + t * 128 + r : 5152 + t * 128 + (r - 128); }
}
__device__ __forceinline__ void convert_weight(const float* W, int ldw, const float* scale, bf16_t* Wt, int K, int N, int kind, float* tile, int blk, int nblk) {
    int tid_ = threadIdx.x; asm volatile("" : "+v"(tid_));
    const int tid = tid_, nkt = K / 64, ntile = (N / 256) * nkt;
    for (int t = blk; t < ntile; t += nblk) {
        const int j0 = (t / nkt) * 256, k0 = (t % nkt) * 64;
        float v[32];
#pragma unroll
        for (int i = 0; i < 32; ++i) { const int kk = (tid >> 8) + 2 * i, jj = tid & 255; const int jx = j0 + jj; const int sj = kind == 1 ? src_in(jx) : (kind == 2 ? (((jx & 255) < 128) ? (jx >> 8) * 128 + (jx & 127) : DFF + (jx >> 8) * 128 + (jx & 127)) : jx);
            v[i] = W[(size_t)(k0 + kk) * ldw + (sj >= 0 ? sj : 0)]; if (sj < 0) v[i] = 0.f; }
        __syncthreads();
#pragma unroll
        for (int i = 0; i < 32; ++i) { const int kk = (tid >> 8) + 2 * i, jj = tid & 255; tile[kk * 257 + jj] = v[i]; }
        __syncthreads();
        const int kk = 2 * (tid & 31); const float s0 = scale ? scale[k0 + kk] : 1.0f, s1 = scale ? scale[k0 + kk + 1] : 1.0f;
#pragma unroll
        for (int i = 0; i < 16; ++i) { const int jj = (tid >> 5) + 16 * i;
            *(unsigned*)(Wt + (size_t)(j0 + jj) * K + k0 + kk) = pk2(tile[kk * 257 + jj] * s0, tile[(kk + 1) * 257 + jj] * s1); }
    }
}
__device__ __forceinline__ void phase_weights(const Params& p, float* tile) {
    const int G = gridDim.x; int cum = 0;
#define WBLK ((int)((blockIdx.x + (unsigned)G - (unsigned)(cum % G)) % (unsigned)G))
    for (int l = 0; l < 2; ++l) {
        unsigned char* wb = p.ws + (size_t)l * WL_B;
        convert_weight(p.in[I_WIN] + (size_t)l * DM * 6176, 6176, p.in[I_N1] + l * DM, (bf16_t*)wb, DM, NIN, 1, tile, WBLK, G); cum += (NIN / 256) * (DM / 64);
        convert_weight(p.in[I_WOUT] + (size_t)l * DMIX * DM, DM, nullptr, (bf16_t*)(wb + WT_IN_B), DMIX, DM, 0, tile, WBLK, G); cum += (DM / 256) * (DMIX / 64);
        convert_weight(p.in[I_WUP] + (size_t)l * DM * NUP, NUP, p.in[I_N2] + l * DM, (bf16_t*)(wb + WT_IN_B + WT_OUT_B), DM, NUP, 2, tile, WBLK, G); cum += (NUP / 256) * (DM / 64);
        convert_weight(p.in[I_WDN] + (size_t)l * DFF * DM, DM, nullptr, (bf16_t*)(wb + WT_IN_B + WT_OUT_B + WT_UP_B), DFF, DM, 0, tile, WBLK, G); cum += (DM / 256) * (DFF / 64);
    }
#undef WBLK
    {
        bf16_t* WDT = (bf16_t*)(p.ws + OFF_WDT); int tid_ = threadIdx.x; asm volatile("" : "+v"(tid_));
        for (int idx = blockIdx.x * 512 + tid_; idx < 2 * 32 * DM; idx += gridDim.x * 512) { const int l = idx >> 15, j = (idx >> 10) & 31, k = idx & 1023;
            const float v = p.in[I_WIN][((size_t)l * DM + k) * 6176 + 3072 + j] * p.in[I_N1][l * DM + k]; const unsigned w = pk2(v, v); WDT[idx] = (bf16_t)(w & 0xffffu); }
    }
}
__device__ __forceinline__ void phase_prep(const Params& p, int hf) {
    int tid_ = threadIdx.x; asm volatile("" : "+v"(tid_));
    const int tid = tid_, wid = tid >> 6, lane = tid & 63;
    float* rowss = (float*)(p.ws + OFF_ROWSS) + (size_t)hf * 5 * TH * 16;
    bf16_t* HB = (bf16_t*)(p.ws + OFF_HB);
    const float* x = p.in[I_X] + (size_t)hf * TH * DM;
#pragma unroll 4
    for (int row = blockIdx.x * 8 + wid; row < TH; row += gridDim.x * 8) {
        float ss = 0.f;
#pragma unroll
        for (int i = 0; i < 4; ++i) { const int c = i * 256 + lane * 4; const f32x4 v = *(const f32x4*)(x + (size_t)row * DM + c);
            ss += (v[0] * v[0] + v[1] * v[1]) + (v[2] * v[2] + v[3] * v[3]); u32x2 w; w.x = pk2(v[0], v[1]); w.y = pk2(v[2], v[3]); *(u32x2*)(HB + (size_t)row * DM + c) = w; }
#pragma unroll
        for (int o = 32; o >= 1; o >>= 1) ss += __shfl_xor(ss, o);
        if (lane < 16) rowss[(size_t)row * 16 + lane] = lane == 0 ? ss : 0.f;
    }
}
__device__ __forceinline__ void phase_final(const Params& p, int hf) {
    int tid_ = threadIdx.x; asm volatile("" : "+v"(tid_));
    const int tid = tid_, wid = tid >> 6, lane = tid & 63;
    const float* rowss = (const float*)(p.ws + OFF_ROWSS) + ((size_t)hf * 5 + 4) * TH * 16;
    float* h = p.out + (size_t)hf * TH * DM; const float* w = p.in[I_FNW]; const bf16_t* HB = (const bf16_t*)(p.ws + OFF_HB);
#pragma unroll 4
    for (int row = blockIdx.x * 8 + wid; row < TH; row += gridDim.x * 8) {
        const float rs = row_rs(rowss, row);
#pragma unroll
        for (int i = 0; i < 4; ++i) { const int c = i * 256 + lane * 4; const u32x2 hb = *(const u32x2*)(HB + (size_t)row * DM + c); const f32x4 g = *(const f32x4*)(w + c);
            f32x4 v; v[0] = bflo(hb.x); v[1] = bfhi(hb.x); v[2] = bflo(hb.y); v[3] = bfhi(hb.y);
            v = v * rs * g; *(f32x4*)(h + (size_t)row * DM + c) = v; }
    }
}
__device__ __forceinline__ void phase_edgefix(const Params& p, int l) {
    const float* EDGER = (const float*)(p.ws + OFF_EDGER); const float* EDGEP = (const float*)(p.ws + OFF_EDGEP); bf16_t* ACT = (bf16_t*)(p.ws + OFF_ACT);
    const float* cw = p.in[I_FCW] + (size_t)l * 3 * NUP;
    int tid_ = threadIdx.x; asm volatile("" : "+v"(tid_));
    for (int idx = blockIdx.x * 512 + tid_; idx < (TH / 256) * 2 * DFF; idx += gridDim.x * 512) {
        const int f = idx % DFF, pe = idx / DFF, e = pe & 1, pm = pe >> 1, t = 256 * pm + (e ? 255 : 0);
        const bool has = e ? (((t + 1) % SEQ) != 0) : ((t % SEQ) != 0);
        float ng = 0.f, nu = 0.f;
        if (has) { const size_t nb = ((size_t)(pm + (e ? 1 : -1)) * 2 + (e ? 0 : 1)) * NUP; ng = EDGER[nb + f]; nu = EDGER[nb + DFF + f]; }
        const int wk = e ? 2 : 0; const size_t eb = ((size_t)pm * 2 + e) * NUP;
        const float pg = EDGEP[eb + f] + cw[wk * NUP + f] * ng, pu = EDGEP[eb + DFF + f] + cw[wk * NUP + DFF + f] * nu;
        const float o = silu_f(pg) * pu; const unsigned w = pk2(o, o); ACT[(size_t)t * DFF + f] = (bf16_t)(w & 0xffffu);
    }
}
__device__ __forceinline__ void edgefix_panel(const Params& p, int l, int pm) {
    const float* EDGER = (const float*)(p.ws + OFF_EDGER); const float* EDGEP = (const float*)(p.ws + OFF_EDGEP); bf16_t* ACT = (bf16_t*)(p.ws + OFF_ACT);
    const float* cw = p.in[I_FCW] + (size_t)l * 3 * NUP;
    int tid_ = threadIdx.x; asm volatile("" : "+v"(tid_));
    for (int idx = tid_; idx < 2 * DFF; idx += 512) {
        const int e = idx >= DFF ? 1 : 0, f = idx - e * DFF, t = 256 * pm + (e ? 255 : 0);
        const bool has = e ? (((t + 1) % SEQ) != 0) : ((t % SEQ) != 0);
        float ng = 0.f, nu = 0.f;
        if (has) { const size_t nb = ((size_t)(pm + (e ? 1 : -1)) * 2 + (e ? 0 : 1)) * NUP; ng = EDGER[nb + f]; nu = EDGER[nb + DFF + f]; }
        const int wk = e ? 2 : 0; const size_t eb = ((size_t)pm * 2 + e) * NUP;
        const float pg = EDGEP[eb + f] + cw[wk * NUP + f] * ng, pu = EDGEP[eb + DFF + f] + cw[wk * NUP + DFF + f] * nu;
        const float o = silu_f(pg) * pu; const unsigned w = pk2(o, o); ACT[(size_t)t * DFF + f] = (bf16_t)(w & 0xffffu);
    }
}
__device__ __forceinline__ void phase_dt(const Params& p, int l, const float* rowss) {
    int tid_ = threadIdx.x; asm volatile("" : "+v"(tid_));
    const int wid = tid_ >> 6, lane = tid_ & 63, fr = lane & 15, fq = lane >> 4;
    const bf16_t* HB = (const bf16_t*)(p.ws + OFF_HB); const bf16_t* WDT = (const bf16_t*)(p.ws + OFF_WDT) + (size_t)l * 32 * DM; float* DT = (float*)(p.ws + OFF_DT);
    for (int tb = blockIdx.x; tb < TH / 128; tb += gridDim.x) {
        const int tok = tb * 128 + wid * 16 + fr;
        f32x4 a0 = (f32x4){0.f, 0.f, 0.f, 0.f}, a1 = a0;
#pragma unroll 1
        for (int k0 = 0; k0 < 32; k0 += 8) {
            bf16x8 hf[8], w0[8], w1[8];
#pragma unroll
            for (int i = 0; i < 8; ++i) { const int ko = 32 * (k0 + i) + 8 * fq;
                hf[i] = *(const bf16x8*)(HB + (size_t)tok * DM + ko); w0[i] = *(const bf16x8*)(WDT + (size_t)fr * DM + ko); w1[i] = *(const bf16x8*)(WDT + (size_t)(16 + fr) * DM + ko); }
#pragma unroll
            for (int i = 0; i < 8; ++i) { a0 = __builtin_amdgcn_mfma_f32_16x16x32_bf16(w0[i], hf[i], a0, 0, 0, 0); a1 = __builtin_amdgcn_mfma_f32_16x16x32_bf16(w1[i], hf[i], a1, 0, 0, 0); }
        }
        const float rs = row_rs(rowss, tok);
        *(f32x4*)(DT + (size_t)tok * 32 + 4 * fq) = a0 * rs; *(f32x4*)(DT + (size_t)tok * 32 + 16 + 4 * fq) = a1 * rs;
    }
}
__device__ __forceinline__ void phase_xedgefix(const Params& p, int l) {
    const float* XEDGER = (const float*)(p.ws + OFF_XEDGER); const float* XEDGEP = (const float*)(p.ws + OFF_XEDGEP); bf16_t* P = (bf16_t*)(p.ws + OFF_PROJ);
    const float* cxw = p.in[I_CXW] + (size_t)l * 3 * 2048;
    int tid_ = threadIdx.x; asm volatile("" : "+v"(tid_));
    for (int idx = blockIdx.x * 512 + tid_; idx < (TH / 256) * 2 * 2048; idx += gridDim.x * 512) {
        const int ch = idx & 2047, pe = idx >> 11, e = pe & 1, pm = pe >> 1, t = 256 * pm + (e ? 255 : 0);
        const bool has = e ? (((t + 1) % SEQ) != 0) : ((t % SEQ) != 0);
        float nb = 0.f;
        if (has) nb = XEDGER[((size_t)(pm + (e ? 1 : -1)) * 2 + (e ? 0 : 1)) * 2048 + ch];
        const float pre = XEDGEP[((size_t)pm * 2 + e) * 2048 + ch] + cxw[(e ? 2 : 0) * 2048 + ch] * nb;
        const float o = silu_f(pre); const unsigned w = pk2(o, o); P[(size_t)t * LDP + PC_X + ch] = (bf16_t)(w & 0xffffu);
    }
}
__device__ __forceinline__ void phase_shortconv(const Params& p, int l) {
    bf16_t* P = (bf16_t*)(p.ws + OFF_PROJ);
    const float* cw = p.in[I_SCW] + (size_t)l * 3 * 1024;
    int tid_ = threadIdx.x; asm volatile("" : "+v"(tid_));
    const int j0 = (tid_ & 127) * 8, sub = tid_ >> 7;
    float w[3][8];
#pragma unroll
    for (int k = 0; k < 3; ++k) { const f32x4 a0 = *(const f32x4*)(cw + k * 1024 + j0), a1 = *(const f32x4*)(cw + k * 1024 + j0 + 4);
#pragma unroll
        for (int j = 0; j < 4; ++j) { w[k][j] = a0[j]; w[k][4 + j] = a1[j]; } }
    for (int tb = blockIdx.x; tb < TH / 32; tb += gridDim.x) {
        const int t0 = tb * 32 + sub * 8, pos0 = t0 % SEQ;
        u32x4 rp[10], rb[8];
#pragma unroll
        for (int r = 0; r < 10; ++r) { const int pos = pos0 - 1 + r; const bool ok = pos >= 0 && pos < SEQ;
            rp[r] = *(const u32x4*)(P + (size_t)(ok ? t0 - 1 + r : t0) * LDP + PC_P + j0);
            if (!ok) rp[r] = (u32x4){0u, 0u, 0u, 0u}; }
#pragma unroll
        for (int r = 0; r < 8; ++r) rb[r] = *(const u32x4*)(P + (size_t)(t0 + r) * LDP + PC_SB + j0);
#pragma unroll
        for (int r = 0; r < 8; ++r) { float p0[8], p1[8], p2[8], sb[8], o[8]; unpack8(rp[r], p0); unpack8(rp[r + 1], p1); unpack8(rp[r + 2], p2); unpack8(rb[r], sb);
#pragma unroll
            for (int j = 0; j < 8; ++j) o[j] = sb[j] * (w[0][j] * p0[j] + w[1][j] * p1[j] + w[2][j] * p2[j]);
            *(u32x4*)(P + (size_t)(t0 + r) * LDP + PC_SB + j0) = pack8(o); }
    }
}

__device__ __forceinline__ int chperm(int t, int i) { return 32 * (t >> 1) + 8 * (i >> 2) + 4 * (t & 1) + (i & 3); }
__device__ __forceinline__ void ssd_dt_load(const float* DT, int t0, int g, int wid, int lane, float& r0, float& r1) {
    const int dir = wid >> 2, hh = wid & 3, h = 4 * g + hh;
    r0 = DT[(size_t)(t0 + lane) * 32 + dir * 16 + h]; r1 = DT[(size_t)(t0 + 64 + lane) * 32 + dir * 16 + h];
}
__device__ __forceinline__ float ssd_dt_scan(const Params& p, int l, float r0, float r1, int g, float* sm_dt, float* sm_cs, int wid, int lane) {
    const int dir = wid >> 2, hh = wid & 3, h = 4 * g + hh;
    const float bias = p.in[dir ? I_DTBB : I_DTBF][l * 16 + h]; const float A = -__expf(p.in[dir ? I_ALB : I_ALF][l * 16 + h]);
    const float d0 = softplus_f(r0 + bias), d1 = softplus_f(r1 + bias);
    const float a0 = A * d0, a1 = A * d1;
    float s0 = a0, s1 = a1;
#pragma unroll
    for (int o = 1; o < 64; o <<= 1) { const float u0 = __shfl_up(s0, o), u1 = __shfl_up(s1, o); if (lane >= o) { s0 += u0; s1 += u1; } }
    const float tot0 = __shfl(s0, 63); s1 += tot0; const float total = __shfl(s1, 63);
    float c0 = s0, c1 = s1;
    if (dir) { c0 = total - s0 + a0; c1 = total - s1 + a1; }
    const int b = (dir * 4 + hh) * 128;
    sm_dt[b + lane] = d0; sm_dt[b + 64 + lane] = d1; sm_cs[b + lane] = c0; sm_cs[b + 64 + lane] = c1;
    return total;
}
template <int NCH> struct ConvTr {
    static constexpr int NPAIR = NCH / 2, NT = NPAIR * 16 / 512;
    unsigned xr[NT][8];
    __device__ __forceinline__ void load(const bf16_t* P, int t0, int pos0, int col0, int tid) {
#pragma unroll
        for (int it = 0; it < NT; ++it) { const int task = tid + it * 512, cp = task % NPAIR, to = task / NPAIR, ch = 2 * cp;
#pragma unroll
            for (int r = 0; r < 8; ++r) xr[it][r] = *(const unsigned*)(P + (size_t)(t0 + 8 * to + r) * LDP + col0 + ch); }
    }
    __device__ __forceinline__ void compute(const float*, const float*, int, bf16_t* dst, int tid) const {
#pragma unroll
        for (int it = 0; it < NT; ++it) { const int task = tid + it * 512, cp = task % NPAIR, to = task / NPAIR, ch = 2 * cp;
            u32x4 lo, hi;
            lo.x = (xr[it][0] & 0xffffu) | (xr[it][1] << 16); lo.y = (xr[it][2] & 0xffffu) | (xr[it][3] << 16); lo.z = (xr[it][4] & 0xffffu) | (xr[it][5] << 16); lo.w = (xr[it][6] & 0xffffu) | (xr[it][7] << 16);
            hi.x = (xr[it][0] >> 16) | (xr[it][1] & 0xffff0000u); hi.y = (xr[it][2] >> 16) | (xr[it][3] & 0xffff0000u); hi.z = (xr[it][4] >> 16) | (xr[it][5] & 0xffff0000u); hi.w = (xr[it][6] >> 16) | (xr[it][7] & 0xffff0000u);
            *(u32x4*)(dst + (size_t)ch * LSTR + 8 * to) = lo;
            *(u32x4*)(dst + (size_t)(ch + 1) * LSTR + 8 * to) = hi; }
    }
};
template <int NCH> struct ConvNat {
    static constexpr int NG = NCH / 8, NT = NG * 128 / 512;
    u32x4 xr[NT];
    __device__ __forceinline__ void load(const bf16_t* P, int t0, int pos0, int col0, int tid) {
#pragma unroll
        for (int it = 0; it < NT; ++it) { const int task = tid + it * 512, cg8 = task % NG, l = task / NG; xr[it] = *(const u32x4*)(P + (size_t)(t0 + l) * LDP + col0 + 8 * cg8); }
    }
    __device__ __forceinline__ void compute(const float*, const float*, int, bf16_t* dst, int tid) const {
#pragma unroll
        for (int it = 0; it < NT; ++it) { const int task = tid + it * 512, cg8 = task % NG, l = task / NG; *(u32x4*)(dst + (size_t)l * LSTR + 8 * cg8) = xr[it]; }
    }
};

__device__ __forceinline__ void phase_ssd_states(const Params& p, int l, unsigned char* smem) {
    int tid_ = threadIdx.x; asm volatile("" : "+v"(tid_));
    const int tid = tid_, wid = tid >> 6, lane = tid & 63, fr = lane & 15, fq = lane >> 4;
    const bf16_t* P = (const bf16_t*)(p.ws + OFF_PROJ); const float* DT = (const float*)(p.ws + OFF_DT);
    bf16_t* ST = (bf16_t*)(p.ws + OFF_ST); float* CHDEC = (float*)(p.ws + OFF_CHDEC);
    const float* cw = p.in[I_CXW] + (size_t)l * 3 * 2048; const float* cb = p.in[I_CXB] + (size_t)l * 2048;
    bf16_t* XT = (bf16_t*)smem;
    bf16_t* BT = (bf16_t*)(smem + 256 * LSTR * 2);
    float* sm_dt = (float*)(smem + 384 * LSTR * 2);
    float* sm_cs = sm_dt + 1024;
    float* sm_w = sm_cs + 1024;
    for (int item = blockIdx.x; item < NBP * 128; item += gridDim.x) {
        const int g = item & 3, c = (item >> 2) & 31, b = item >> 7;
        const int t0 = b * SEQ + c * 128, pos0 = c * 128;
        __syncthreads();
        float r0, r1; ssd_dt_load(DT, t0, g, wid, lane, r0, r1);
        ConvTr<256> cx; ConvTr<128> cbt;
        cx.load(P, t0, pos0, PC_X + 256 * g, tid); cbt.load(P, t0, pos0, PC_X + 1024 + 128 * g, tid);
        const float total = ssd_dt_scan(p, l, r0, r1, g, sm_dt, sm_cs, wid, lane);
        cx.compute(cw, cb, 256 * g, XT, tid); cbt.compute(cw, cb, 1024 + 128 * g, BT, tid);
        const int dir = wid >> 2, hh = wid & 3, h = 4 * g + hh, sb = (dir * 4 + hh) * 128;
        {
            sm_w[sb + lane] = sm_dt[sb + lane] * __expf(total - sm_cs[sb + lane]);
            sm_w[sb + 64 + lane] = sm_dt[sb + 64 + lane] * __expf(total - sm_cs[sb + 64 + lane]);
            if (lane == 0) CHDEC[((b * 32 + c) * 16 + h) * 2 + dir] = __expf(total);
        }
        __syncthreads();
        f32x4 acc[4][8];
#pragma unroll
        for (int i = 0; i < 4; ++i)
#pragma unroll
            for (int j = 0; j < 8; ++j) acc[i][j] = (f32x4){0.f, 0.f, 0.f, 0.f};
#pragma unroll 1
        for (int ks = 0; ks < 4; ++ks) {
            const f32x4 w0 = *(const f32x4*)(sm_w + sb + 32 * ks + 8 * fq), w1 = *(const f32x4*)(sm_w + sb + 32 * ks + 8 * fq + 4);
            bf16x8 xf[4];
#pragma unroll
            for (int pi = 0; pi < 4; ++pi) { const u32x4 raw = *(const u32x4*)(XT + (size_t)(64 * hh + chperm(pi, fr)) * LSTR + 32 * ks + 8 * fq); float f[8]; unpack8(raw, f);
                f[0] *= w0[0]; f[1] *= w0[1]; f[2] *= w0[2]; f[3] *= w0[3]; f[4] *= w1[0]; f[5] *= w1[1]; f[6] *= w1[2]; f[7] *= w1[3];
                const u32x4 pk = pack8(f); xf[pi] = __builtin_bit_cast(bf16x8, pk); }
#pragma unroll
            for (int ni = 0; ni < 8; ++ni) { const bf16x8 bf = *(const bf16x8*)(BT + (size_t)chperm(ni, fr) * LSTR + 32 * ks + 8 * fq);
#pragma unroll
                for (int pi = 0; pi < 4; ++pi) acc[pi][ni] = __builtin_amdgcn_mfma_f32_16x16x32_bf16(bf, xf[pi], acc[pi][ni], 0, 0, 0); }
        }
        bf16_t* S = ST + ((size_t)((b * 32 + c) * 16 + h) * 2 + dir) * 8192;
#pragma unroll
        for (int pi = 0; pi < 4; ++pi)
#pragma unroll
            for (int q = 0; q < 4; ++q) { u32x4 w; w.x = pk2(acc[pi][2 * q][0], acc[pi][2 * q][1]); w.y = pk2(acc[pi][2 * q][2], acc[pi][2 * q][3]); w.z = pk2(acc[pi][2 * q + 1][0], acc[pi][2 * q + 1][1]); w.w = pk2(acc[pi][2 * q + 1][2], acc[pi][2 * q + 1][3]);
                *(u32x4*)(S + ((q * 4 + pi) * 16 + fr) * 32 + 8 * fq) = w; }
    }
}
__device__ __forceinline__ void phase_ssd_scan(const Params& p) {
    bf16_t* ST = (bf16_t*)(p.ws + OFF_ST); const float* CHDEC = (const float*)(p.ws + OFF_CHDEC);
    const int ntask = NBP * 16 * 2 * 1024;
    int tid_ = threadIdx.x; asm volatile("" : "+v"(tid_));
    for (int task = blockIdx.x * 512 + tid_; task < ntask; task += gridDim.x * 512) {
        const int e = task & 1023, dir = (task >> 10) & 1, h = (task >> 11) & 15, b = task >> 15;
        const int c0 = dir ? 31 : 0, cstep = dir ? -1 : 1;
        const size_t idx0 = (size_t)((b * 32 + c0) * 16 + h) * 2 + dir; const long istep = (long)cstep * 32;
        float run[8];
#pragma unroll
        for (int j = 0; j < 8; ++j) run[j] = 0.f;
#pragma unroll 1
        for (int i0 = 0; i0 < 32; i0 += 16) {
            u32x4 v[16]; float d[16];
#pragma unroll
            for (int i = 0; i < 16; ++i) { const size_t idx = idx0 + (long)(i0 + i) * istep; v[i] = *(const u32x4*)(ST + idx * 8192 + e * 8); d[i] = CHDEC[idx]; }
#pragma unroll
            for (int i = 0; i < 16; ++i) { const size_t idx = idx0 + (long)(i0 + i) * istep; float sv[8]; unpack8(v[i], sv);
                *(u32x4*)(ST + idx * 8192 + e * 8) = pack8(run);
#pragma unroll
                for (int j = 0; j < 8; ++j) run[j] = run[j] * d[i] + sv[j]; }
        }
    }
}
__device__ __forceinline__ void phase_ssd_out(const Params& p, int l, unsigned char* smem) {
    bf16_t* P = (bf16_t*)(p.ws + OFF_PROJ); const float* DT = (const float*)(p.ws + OFF_DT);
    const bf16_t* ST = (const bf16_t*)(p.ws + OFF_ST);
    const float* cw = p.in[I_CXW] + (size_t)l * 3 * 2048; const float* cb = p.in[I_CXB] + (size_t)l * 2048;
    const float* dsk = p.in[I_DSK] + l * 16; const float* nw = p.in[I_SNW] + l * 1024;
    bf16_t* XT = (bf16_t*)smem;
    bf16_t* CN = (bf16_t*)(smem + 256 * LSTR * 2);
    bf16_t* BN = (bf16_t*)(smem + 384 * LSTR * 2);
    float* sm_dt = (float*)(smem + 512 * LSTR * 2);
    float* sm_cs = sm_dt + 1024;
    float* sm_ss = sm_cs + 1024;
    for (int item = blockIdx.x; item < NBP * 128; item += gridDim.x) {
        int tid_ = threadIdx.x; asm volatile("" : "+v"(tid_));
        const int tid = tid_, wid = tid >> 6, lane = tid & 63, fr = lane & 15, fq = lane >> 4, hh = wid >> 1, lh = wid & 1;
        const int g = item & 3, c = (item >> 2) & 31, b = item >> 7;
        const int t0 = b * SEQ + c * 128, pos0 = c * 128, h = 4 * g + hh;
        __syncthreads();
        const bf16_t* Hf = ST + ((size_t)((b * 32 + c) * 16 + h) * 2 + 0) * 8192;
        bf16x8 hv[4][4];
        {
            float r0, r1; ssd_dt_load(DT, t0, g, wid, lane, r0, r1);
            ConvNat<128> cbn, ccn; ConvTr<256> cx;
            cbn.load(P, t0, pos0, PC_X + 1024 + 128 * g, tid); ccn.load(P, t0, pos0, PC_X + 1536 + 128 * g, tid); cx.load(P, t0, pos0, PC_X + 256 * g, tid);
            __builtin_amdgcn_sched_barrier(0);
            ssd_dt_scan(p, l, r0, r1, g, sm_dt, sm_cs, wid, lane);
            cbn.compute(cw, cb, 1024 + 128 * g, BN, tid);
            ccn.compute(cw, cb, 1536 + 128 * g, CN, tid);
            cx.compute(cw, cb, 256 * g, XT, tid);
        }
#pragma unroll
        for (int ks = 0; ks < 4; ++ks)
#pragma unroll
            for (int pt = 0; pt < 4; ++pt) hv[ks][pt] = *(const bf16x8*)(Hf + ((ks * 4 + pt) * 16 + fr) * 32 + 8 * fq);
        __syncthreads();
        {
            f32x4 cbacc[8];
#pragma unroll
            for (int st = 0; st < 8; ++st) cbacc[st] = (f32x4){0.f, 0.f, 0.f, 0.f};
#pragma unroll
            for (int ks = 0; ks < 4; ++ks) {
                const bf16x8 cf = *(const bf16x8*)(CN + (size_t)(16 * wid + fr) * LSTR + 32 * ks + 8 * fq);
#pragma unroll
                for (int st = 0; st < 8; ++st) { const bf16x8 bf = *(const bf16x8*)(BN + (size_t)(16 * st + fr) * LSTR + 32 * ks + 8 * fq);
                    cbacc[st] = __builtin_amdgcn_mfma_f32_16x16x32_bf16(bf, cf, cbacc[st], 0, 0, 0); }
            }
            __syncthreads();
#pragma unroll
            for (int st = 0; st < 8; ++st) { u32x2 w; w.x = pk2(cbacc[st][0], cbacc[st][1]); w.y = pk2(cbacc[st][2], cbacc[st][3]);
                *(u32x2*)(BN + (size_t)(16 * wid + fr) * LSTR + 16 * st + 4 * fq) = w; }
        }
        __syncthreads();
        const float* dtf = sm_dt + hh * 128; const float* dtb = sm_dt + (4 + hh) * 128; const float* acs = sm_cs + hh * 128; const float* rcs = sm_cs + (4 + hh) * 128;
        f32x4 acc[4][4];
#pragma unroll
        for (int dir = 0; dir < 2; ++dir) {
            const float* csd = dir ? rcs : acs;
            f32x4 acc2[4][4];
#pragma unroll
            for (int i = 0; i < 4; ++i)
#pragma unroll
                for (int j = 0; j < 4; ++j) acc2[i][j] = (f32x4){0.f, 0.f, 0.f, 0.f};
#pragma unroll
            for (int ks = 0; ks < 4; ++ks) {
                bf16x8 a[4];
#pragma unroll
                for (int lt = 0; lt < 4; ++lt) a[lt] = *(const bf16x8*)(CN + (size_t)(64 * lh + 16 * lt + fr) * LSTR + 32 * ks + 8 * fq);
#pragma unroll
                for (int lt = 0; lt < 4; ++lt)
#pragma unroll
                    for (int pt = 0; pt < 4; ++pt) acc2[lt][pt] = __builtin_amdgcn_mfma_f32_16x16x32_bf16(hv[ks][pt], a[lt], acc2[lt][pt], 0, 0, 0);
                if (dir == 0) {
#pragma unroll
                    for (int pt = 0; pt < 4; ++pt) hv[ks][pt] = *(const bf16x8*)(Hf + 8192 + ((ks * 4 + pt) * 16 + fr) * 32 + 8 * fq); }
                __builtin_amdgcn_sched_barrier(0);
            }
#pragma unroll
            for (int lt = 0; lt < 4; ++lt) { const float ev = __expf(csd[64 * lh + 16 * lt + fr]);
#pragma unroll
                for (int pt = 0; pt < 4; ++pt) acc[lt][pt] = dir ? acc[lt][pt] + acc2[lt][pt] * ev : acc2[lt][pt] * ev; }
        }
        u32x2 zr[4][4];
#pragma unroll
        for (int lt = 0; lt < 4; ++lt)
#pragma unroll
            for (int q = 0; q < 2; ++q) { const u32x4 zz = *(const u32x4*)(P + (size_t)(t0 + 64 * lh + 16 * lt + fr) * LDP + PC_Z + 256 * g + 64 * hh + 32 * q + 8 * fq);
                zr[lt][2 * q].x = zz.x; zr[lt][2 * q].y = zz.y; zr[lt][2 * q + 1].x = zz.z; zr[lt][2 * q + 1].y = zz.w; }
        const float dskip = dsk[h];
#pragma unroll 1
        for (int ks = 0; ks < 4; ++ks) {
            const int s0 = 32 * ks + 8 * fq;
            float as_[8], rs_[8], df_[8], db_[8];
            { const f32x4 t0_ = *(const f32x4*)(acs + s0), t1_ = *(const f32x4*)(acs + s0 + 4), u0_ = *(const f32x4*)(rcs + s0), u1_ = *(const f32x4*)(rcs + s0 + 4);
              const f32x4 v0_ = *(const f32x4*)(dtf + s0), v1_ = *(const f32x4*)(dtf + s0 + 4), x0_ = *(const f32x4*)(dtb + s0), x1_ = *(const f32x4*)(dtb + s0 + 4);
#pragma unroll
              for (int j = 0; j < 4; ++j) { as_[j] = t0_[j]; as_[4 + j] = t1_[j]; rs_[j] = u0_[j]; rs_[4 + j] = u1_[j]; df_[j] = v0_[j]; df_[4 + j] = v1_[j]; db_[j] = x0_[j]; db_[4 + j] = x1_[j]; } }
            bf16x8 bx[4];
#pragma unroll
            for (int pt = 0; pt < 4; ++pt) bx[pt] = *(const bf16x8*)(XT + (size_t)(64 * hh + chperm(pt, fr)) * LSTR + s0);
#pragma unroll
            for (int lt = 0; lt < 4; ++lt) {
                const int lrow = 64 * lh + 16 * lt + fr;
                const float al = acs[lrow], rl = rcs[lrow], dd = dtf[lrow] + dtb[lrow];
                float cbv[8]; unpack8(*(const u32x4*)(BN + (size_t)lrow * LSTR + s0), cbv);
#pragma unroll
                for (int j = 0; j < 8; ++j) { const int s = s0 + j; const bool fw = s < lrow;
                    const float d = fw ? al - as_[j] : rl - rs_[j]; float v = __expf(d) * (fw ? df_[j] : db_[j]); v = (s == lrow) ? dd : v; cbv[j] = cbv[j] * v + ((s == lrow) ? dskip : 0.f); }
                const u32x4 pk = pack8(cbv); const bf16x8 gfr = __builtin_bit_cast(bf16x8, pk);
#pragma unroll
                for (int pt = 0; pt < 4; ++pt) acc[lt][pt] = __builtin_amdgcn_mfma_f32_16x16x32_bf16(bx[pt], gfr, acc[lt][pt], 0, 0, 0);
                __builtin_amdgcn_sched_barrier(0);
            }
        }
#pragma unroll
        for (int lt = 0; lt < 4; ++lt) { float sq = 0.f;
#pragma unroll
            for (int pt = 0; pt < 4; ++pt) { const float z0 = bflo(zr[lt][pt].x), z1 = bfhi(zr[lt][pt].x), z2 = bflo(zr[lt][pt].y), z3 = bfhi(zr[lt][pt].y);
                f32x4 y = acc[lt][pt]; y[0] *= silu_f(z0); y[1] *= silu_f(z1); y[2] *= silu_f(z2); y[3] *= silu_f(z3); acc[lt][pt] = y;
                sq += (y[0] * y[0] + y[1] * y[1]) + (y[2] * y[2] + y[3] * y[3]); }
            sq += __shfl_xor(sq, 16); sq += __shfl_xor(sq, 32);
            if (fq == 0) sm_ss[(64 * lh + 16 * lt + fr) * 4 + hh] = sq; }
        __syncthreads();
        f32x4 nwv[4];
#pragma unroll
        for (int pt = 0; pt < 4; ++pt) nwv[pt] = *(const f32x4*)(nw + 256 * g + 64 * hh + 32 * (pt >> 1) + 8 * fq + 4 * (pt & 1));
#pragma unroll
        for (int lt = 0; lt < 4; ++lt) { const int lrow = 64 * lh + 16 * lt + fr; const f32x4 sv = *(const f32x4*)(sm_ss + lrow * 4);
            const float rs = rsqrtf(((sv[0] + sv[1]) + (sv[2] + sv[3])) * (1.0f / 256.0f) + EPS);
#pragma unroll
            for (int q = 0; q < 2; ++q) { const f32x4 y0 = acc[lt][2 * q] * rs * nwv[2 * q], y1 = acc[lt][2 * q + 1] * rs * nwv[2 * q + 1]; u32x4 w; w.x = pk2(y0[0], y0[1]); w.y = pk2(y0[2], y0[3]); w.z = pk2(y1[0], y1[1]); w.w = pk2(y1[2], y1[3]);
                *(u32x4*)(P + (size_t)(t0 + lrow) * LDP + PC_Z + 256 * g + 64 * hh + 32 * q + 8 * fq) = w; } }
    }
}

#define XB_TMO      128
#define XB_XCNT(j)  (256  + 64 * (j))
#define XB_XSUB(j)  (1280 + 64 * (j))
#define XB_XGEN(j)  (2304 + 64 * (j))
#define XB_TOP      3328
#define XB_TOPGEN   3392
#define XCD_BAR_WORDS 3456
#define XB_SPIN_CAP (1u << 20)
__device__ __forceinline__ unsigned xb_ld(unsigned* p)              { return __hip_atomic_load(p, __ATOMIC_RELAXED, __HIP_MEMORY_SCOPE_AGENT); }
__device__ __forceinline__ unsigned xb_add(unsigned* p, unsigned v) { return __hip_atomic_fetch_add(p, v, __ATOMIC_RELAXED, __HIP_MEMORY_SCOPE_AGENT); }
__device__ __forceinline__ unsigned xb_xcc_id() { return (unsigned)__builtin_amdgcn_s_getreg((3 << 11) | 20) & 0xFu; }
#define XB_SPIN(cond, bar) do { unsigned _sp = 0; while (cond) { __builtin_amdgcn_s_sleep(1); \
    if ((++_sp & 255u) == 0u) { if (xb_ld(&(bar)[XB_TMO])) break; if (_sp > XB_SPIN_CAP) { atomicAdd(&(bar)[XB_TMO], 1u); break; } } } } while (0)
struct XcdBarrier { unsigned* bar; unsigned x; volatile PG8_LAS unsigned* st; };
__device__ __forceinline__ XcdBarrier xcd_barrier_post(unsigned* bar, volatile PG8_LAS unsigned* st) {
    XcdBarrier b; b.bar = bar; b.x = xb_xcc_id(); b.st = st;
    if (threadIdx.x == 0) (void)xb_add(&bar[XB_XCNT(b.x)], 1u);
    return b;
}
__device__ __forceinline__ void xcd_barrier_complete(unsigned* bar, unsigned x, unsigned& nloc, unsigned& nx) {
    const unsigned G = gridDim.x * gridDim.y * gridDim.z;
    unsigned sum, cnt, mine, sp = 0u;
    for (;;) {
        sum = 0u; cnt = 0u; mine = 0u;
#pragma unroll
        for (unsigned j = 0; j < 16; ++j) { const unsigned c = xb_ld(&bar[XB_XCNT(j)]); sum += c; cnt += (c > 0u) ? 1u : 0u; mine = (j == x) ? c : mine; }
        if (sum == G) break;
        __builtin_amdgcn_s_sleep(1);
        if ((++sp & 255u) == 0u) { if (xb_ld(&bar[XB_TMO])) break; if (sp > XB_SPIN_CAP) { atomicAdd(&bar[XB_TMO], 1u); break; } }
    }
    nloc = mine > 0u ? mine : 1u; nx = cnt > 0u ? cnt : 1u;
}
__device__ __forceinline__ void xcd_barrier(const XcdBarrier& b) {
    asm volatile("s_waitcnt vmcnt(0)" ::: "memory");
    __syncthreads();
    if (threadIdx.x == 0) {
        unsigned* bar = b.bar;
        __builtin_amdgcn_s_waitcnt(0);
        unsigned nloc = b.st[0], nx = b.st[1];
        if (nloc == 0u) { xcd_barrier_complete(bar, b.x, nloc, nx); b.st[0] = nloc; b.st[1] = nx; }
        const unsigned old = xb_add(&bar[XB_XSUB(b.x)], 1u);
        const unsigned gen = old / nloc;
        if (old + 1u == (gen + 1u) * nloc) {
            __builtin_amdgcn_fence(__ATOMIC_RELEASE, "agent");
            asm volatile("s_waitcnt vmcnt(0)" ::: "memory");
            const unsigned og = xb_add(&bar[XB_TOP], 1u);
            const unsigned tg = og / nx;
            if (og + 1u == (tg + 1u) * nx) xb_add(&bar[XB_TOPGEN], 1u);
            else XB_SPIN(xb_ld(&bar[XB_TOPGEN]) == tg, bar);
            __builtin_amdgcn_fence(__ATOMIC_ACQUIRE, "agent");
            xb_add(&bar[XB_XGEN(b.x)], 1u);
            asm volatile("s_waitcnt vmcnt(0)" ::: "memory");
        } else {
            XB_SPIN(xb_ld(&bar[XB_XGEN(b.x)]) == gen, bar);
            __builtin_amdgcn_fence(__ATOMIC_ACQUIRE, "agent");
            asm volatile("s_waitcnt vmcnt(0)" ::: "memory");
        }
    }
    __syncthreads();
}

constexpr int PH_PER_HALF = 18, N_PHASES = NPART * PH_PER_HALF;
__global__ void __launch_bounds__(512, 2) mega(Params p0) {
    extern __shared__ __attribute__((aligned(16))) unsigned char smem[];
    cg::grid_group grid = cg::this_grid();
    volatile PG8_LAS unsigned* xst = (volatile PG8_LAS unsigned*)((PG8_LAS unsigned char*)smem + (LDS_BYTES - 16));
    if (threadIdx.x == 0) { xst[0] = 0u; xst[1] = 0u; }
    __syncthreads();
    const XcdBarrier xb = xcd_barrier_post((unsigned*)(p0.ws + OFF_BAR), xst);
    for (int ph = p0.ph_lo; ph < p0.ph_hi; ++ph) {
        const int hf = ph / PH_PER_HALF, lp = ph % PH_PER_HALF;
        if (hf >= 1 && lp == 0) continue;
        Params p = p0; asm volatile("" : "+s"(p.ws), "+s"(p.out));
        unsigned char* ws = p.ws;
        float* rowss = (float*)(ws + OFF_ROWSS) + (size_t)hf * 5 * TH * 16;
        bf16_t* HB = (bf16_t*)(ws + OFF_HB);
        if (lp == 0) {
#ifdef REP0
            for (int rep = 0; rep < 2; ++rep) {
#endif
            if (hf == 0) phase_weights(p, (float*)smem);
            phase_prep(p, hf);
#ifdef REP0
            }
#endif
        } else if (lp == 17) {
            phase_final(p, hf);
            if (hf + 1 < NPART) phase_prep(p, hf + 1);
        } else {
            const int l = (lp - 1) / 8, kk = (lp - 1) % 8, k = kk == 0 ? 0 : kk - 1;
#ifdef REPK
            for (int rep = 0; rep < ((REPK) ? 2 : 1); ++rep) {
#endif
            unsigned char* wb = ws + (size_t)l * WL_B;
            float* hout = p.out + (size_t)hf * TH * DM;
            if (kk == 1) {
                phase_xedgefix(p, l);
            } else if (k == 0) {
                pg8::Gemm g{HB, (const bf16_t*)wb, TH, NIN, DM}; pg8::StaticOrder S; S.init(TH, NIN, gridDim.x, blockIdx.x);
                EpiIn E{(bf16_t*)(ws + OFF_PROJ), rowss + (size_t)(2 * l) * TH * 16, (float*)(smem + 131072), (float*)(smem + 132096), p.in[I_CXW] + (size_t)l * 3 * 2048, p.in[I_CXB] + (size_t)l * 2048,
                        (float*)(ws + OFF_XEDGER), (float*)(ws + OFF_XEDGEP), -1};
                phase_dt(p, l, rowss + (size_t)(2 * l) * TH * 16);
                pg8::gemm_phase<EpiIn, pg8::StaticOrder, true, true>((PG8_LAS unsigned char*)smem, g, S, E);
            } else if (k == 1) {
#ifndef NO_STATES
                phase_ssd_states(p, l, smem);
#endif
            } else if (k == 2) {
                phase_ssd_scan(p);
            } else if (k == 3) {
#ifndef NO_OUT
                phase_ssd_out(p, l, smem);
#endif
                phase_shortconv(p, l);
            } else if (k == 4) {
                pg8::Gemm g{(const bf16_t*)(ws + OFF_PROJ), (const bf16_t*)(wb + WT_IN_B), TH, DM, DMIX, LDP}; pg8::StaticOrder S; S.init(TH, DM, gridDim.x, blockIdx.x);
                EpiRes E{HB, rowss + (size_t)(2 * l + 1) * TH * 16};
                pg8::gemm_phase<EpiRes, pg8::StaticOrder, true, true>((PG8_LAS unsigned char*)smem, g, S, E);
#ifdef REP4
                if (l == 0) pg8::gemm_phase<EpiRes, pg8::StaticOrder, true, true>((PG8_LAS unsigned char*)smem, g, S, E);
#endif
            } else if (k == 5) {
                pg8::Gemm g{HB, (const bf16_t*)(wb + WT_IN_B + WT_OUT_B), TH, NUP, DM}; pg8::StaticOrder S; S.init(TH, NUP, gridDim.x, blockIdx.x);
                EpiAct E{(bf16_t*)(ws + OFF_ACT), rowss + (size_t)(2 * l + 1) * TH * 16, (float*)(smem + 131072), (float*)(smem + 132096), p.in[I_FCW] + (size_t)l * 3 * NUP, p.in[I_FCB] + (size_t)l * NUP,
                         (float*)(ws + OFF_EDGER), (float*)(ws + OFF_EDGEP), -1};
                pg8::gemm_phase<EpiAct, pg8::StaticOrder, true, true>((PG8_LAS unsigned char*)smem, g, S, E);
            } else {
                pg8::Gemm g{(const bf16_t*)(ws + OFF_ACT), (const bf16_t*)(wb + WT_IN_B + WT_OUT_B + WT_UP_B), TH, DM, DFF}; pg8::StaticOrder S; S.init(TH, DM, gridDim.x, blockIdx.x);
                {
                    pg8::Unit uu; int last_pm = -1;
                    for (int i = 0; S.next(i, uu); ++i) if (uu.pm != last_pm) { last_pm = uu.pm; edgefix_panel(p, l, uu.pm); }
                    asm volatile("s_waitcnt vmcnt(0)" ::: "memory"); __syncthreads();
                }
                EpiRes E{HB, rowss + (size_t)(2 * l + 2) * TH * 16};
                pg8::gemm_phase<EpiRes, pg8::StaticOrder, true, true>((PG8_LAS unsigned char*)smem, g, S, E);
            }
#ifdef REPK
            }
#endif
        }
        if (ph + 1 < p0.ph_hi) { if (ph == 0) grid.sync(); else xcd_barrier(xb); }
    }
}


#ifndef MULTI_LAUNCH
#define MULTI_LAUNCH 0
#endif
extern "C" void kernel_launch(void* const* d_in, const int* in_sizes, int n_in, void* d_out, int out_size, void* d_ws, size_t ws_size, hipStream_t stream) {
    static int grid = 0;
    if (grid == 0) {
        if (n_in != 19 || ws_size < WS_NEED) { fprintf(stderr, "kernel_launch: unexpected n_in %d / ws_size %zu (need %zu)\n", n_in, ws_size, (size_t)WS_NEED); grid = -1; return; }
        int dev = 0, cus = 0, per_cu = 0;
        hipGetDevice(&dev); hipDeviceGetAttribute(&cus, hipDeviceAttributeMultiprocessorCount, dev);
        if (hipFuncSetAttribute((const void*)mega, hipFuncAttributeMaxDynamicSharedMemorySize, LDS_BYTES) != hipSuccess) { fprintf(stderr, "kernel_launch: hipFuncSetAttribute failed\n"); grid = -1; return; }
        if (hipOccupancyMaxActiveBlocksPerMultiprocessor(&per_cu, (const void*)mega, 512, LDS_BYTES) != hipSuccess || per_cu < 1) { fprintf(stderr, "kernel_launch: occupancy query says %d\n", per_cu); per_cu = 1; }
        (void)hipGetLastError();
        grid = cus * 1;
        fprintf(stderr, "kernel_launch: grid %d (cus %d, per_cu %d), ws %zu\n", grid, cus, per_cu, ws_size);
    }
    if (grid < 0) return;
#ifdef DBG_MEMSET
    (void)hipMemsetAsync(d_ws, 0, WS_END, stream); (void)hipMemsetAsync(d_out, 0, (size_t)out_size * 4, stream);
#endif
    (void)hipMemsetAsync((unsigned char*)d_ws + OFF_BAR, 0, 16384, stream);
    Params p{};
    for (int i = 0; i < 19; ++i) p.in[i] = (const float*)d_in[i];
    p.out = (float*)d_out; p.ws = (unsigned char*)d_ws;
#if MULTI_LAUNCH
    for (int ph = 0; ph < N_PHASES; ++ph) { p.ph_lo = ph; p.ph_hi = ph + 1; hipLaunchKernelGGL(mega, dim3(grid), dim3(512), LDS_BYTES, stream, p); }
#else
    p.ph_lo = 0; p.ph_hi = N_PHASES;
    void* args[] = {&p};
    hipError_t e = hipLaunchCooperativeKernel((const void*)mega, dim3(grid), dim3(512), args, LDS_BYTES, stream);
    if (e != hipSuccess) fprintf(stderr, "cooperative launch failed: %s (grid %d)\n", hipGetErrorString(e), grid);
#endif
}
```

```cpp
#include <hip/hip_runtime.h>
#include <hip/hip_cooperative_groups.h>
#include <cstdio>
#include <type_traits>
namespace cg = cooperative_groups;
namespace pg8 {
#define PG8_LAS __attribute__((address_space(3)))
typedef unsigned short bf16_t;
typedef short bf16x8 __attribute__((ext_vector_type(8)));
typedef float f32x4 __attribute__((ext_vector_type(4)));
typedef unsigned u32x4 __attribute__((ext_vector_type(4)));
constexpr int BM = 256, BK = 64, HALF = 128, HTB = HALF * BK * 2  , STAGE_BYTES = 8 * HTB, NXCD = 8, WGM = 8;

__host__ __device__ __forceinline__ int lds_byte(int r, int c) { const int st = (r >> 4) * 2 + (c >> 5), rr = r & 15, cc = c & 31, ob = rr * 64 + cc * 2; return st * 1024 + (ob ^ (((ob >> 9) & 1) << 5)); }
__host__ __device__ __forceinline__ void stage_rc(int b, int& R, int& C) { const int st = b / 1024, sb = b % 1024, swz = sb ^ (((sb >> 9) & 1) << 5); R = (st >> 1) * 16 + swz / 64; C = (st & 1) * 32 + (swz % 64) / 2; }
__host__ __device__ __forceinline__ int perm32(int rho) { const int n = rho >> 4, i = rho & 15; return 8 * (i >> 2) + 4 * n + (i & 3); }

struct Unit { int pm, pn; };
struct Gemm { const bf16_t* A; const bf16_t* Bt; int M, N, K; int lda = 0; };
struct StaticOrder {
    int nM, nN, nwg, G, c;
    __host__ __device__ void init(int M, int N, int G_, int c_) { nM = M / BM; nN = N / BM; nwg = nM * nN; G = G_; c = c_; }
    __host__ __device__ bool next(int i, Unit& u) const {
        const long L = (long)i * G + c; if (L >= nwg) return false;
        int wgid = (int)L; { const int q = nwg / NXCD, r = nwg % NXCD, xcd = wgid % NXCD, off = wgid / NXCD; wgid = (xcd < r ? xcd * (q + 1) : r * (q + 1) + (xcd - r) * q) + off; }
        const int nig = WGM * nN, gid = wgid / nig, fm = gid * WGM, gsz = (nM - fm) < WGM ? (nM - fm) : WGM;
        u.pm = fm + ((wgid % nig) % gsz); u.pn = (wgid % nig) / gsz; return true;
    }
    __device__ __forceinline__ void a_ready(const Unit&) const {}
    __device__ __forceinline__ void done(const Unit&) const {}
};
__device__ __forceinline__ unsigned cvt_pk_bf16(float lo, float hi) { unsigned r; asm volatile("v_cvt_pk_bf16_f32 %0, %1, %2" : "=v"(r) : "v"(lo), "v"(hi)); return r; }
template <class Epi, class Sched, bool ALIGN_EPI = false, bool SP2 = false>
__device__ __forceinline__ void gemm_phase(PG8_LAS unsigned char* lds, const Gemm g, const Sched& S, const Epi& E) {
    int tid_ = threadIdx.x; asm volatile("" : "+v"(tid_));
    const int tid = tid_, wid = __builtin_amdgcn_readfirstlane(tid >> 6), lane = tid & 63, wr = wid >> 2, wc = wid & 3, fr = lane & 15, fq = lane >> 4;
    const int K = g.K, nt = K / BK, LDA = g.lda ? g.lda : g.K;
    unsigned voffA[2], voffB[2];
#pragma unroll
    for (int i = 0; i < 2; ++i) { int R, C; stage_rc(tid * 16 + i * 8192, R, C); const int Rb = Epi::PERM ? ((R & ~31) + perm32(R & 31)) : R;
        voffA[i] = (unsigned)(R * LDA + C) * 2u; voffB[i] = (unsigned)(Rb * K + C) * 2u; }
    const size_t kstep = (size_t)(BK * 2);
    const size_t hstep = (size_t)HALF * K * 2;
    const size_t tstep = 2 * hstep;
    const size_t hstepA = (size_t)HALF * LDA * 2, tstepA = 2 * hstepA;
    const unsigned ldsw = (unsigned)wid * 1024u;
    const int aoff = lds_byte(wr * 64 + fr, fq * 8), boff = lds_byte(wc * 32 + fr, fq * 8);
#define PG8_SA(b, h) (((b) * 2 + (h)) * HTB)
#define PG8_SB(b, h) ((4 + (b) * 2 + (h)) * HTB)
#define PG8_STAGE(bufoff, gbase, voff) do { _Pragma("unroll") for (int _i = 0; _i < 2; ++_i) \
        __builtin_amdgcn_global_load_lds((const unsigned*)((const char*)(gbase) + (voff)[_i]), (PG8_LAS unsigned*)(lds + (bufoff) + ldsw + _i * 8192), 16, 0, 0); } while (0)
#define PG8_LDA(dst, b, h) do { _Pragma("unroll") for (int m = 0; m < 4; ++m) _Pragma("unroll") for (int k = 0; k < 2; ++k) dst[m][k] = *(const PG8_LAS bf16x8*)(lds + PG8_SA(b, h) + aoff + m * 2048 + k * 1024); } while (0)
#define PG8_LDB(dst, b, h) do { _Pragma("unroll") for (int n = 0; n < 2; ++n) _Pragma("unroll") for (int k = 0; k < 2; ++k) dst[n][k] = *(const PG8_LAS bf16x8*)(lds + PG8_SB(b, h) + boff + n * 2048 + k * 1024); } while (0)
#define PG8_MMA(ai, bj, At, Bt) do { __builtin_amdgcn_s_setprio(1); _Pragma("unroll") for (int m = 0; m < 4; ++m) _Pragma("unroll") for (int n = 0; n < 2; ++n) _Pragma("unroll") for (int k = 0; k < 2; ++k) \
        acc[ai][bj][m][n] = __builtin_amdgcn_mfma_f32_16x16x32_bf16(Bt[n][k], At[m][k], acc[ai][bj][m][n], 0, 0, 0); __builtin_amdgcn_s_setprio(0); } while (0)
#define PG8_WAIT_V(n) asm volatile("s_waitcnt vmcnt(" #n ")" ::: "memory")
#define PG8_WAIT_L(n) asm volatile("s_waitcnt lgkmcnt(" #n ")" ::: "memory")
#define PG8_BAR __builtin_amdgcn_s_barrier()
#define PG8_SCHED __builtin_amdgcn_sched_barrier(0)
    Unit cur, nxt; int ui = 0;
    if (!S.next(0, cur)) return;
    f32x4 acc[2][2][4][2];
#pragma unroll
    for (int a = 0; a < 2; ++a)
#pragma unroll
        for (int b = 0; b < 2; ++b)
#pragma unroll
            for (int m = 0; m < 4; ++m)
#pragma unroll
                for (int n = 0; n < 2; ++n) acc[a][b][m][n] = (f32x4){0.f, 0.f, 0.f, 0.f};
    bf16x8 At[4][2], B0[2][2], B1[2][2];
    const char* cA = (const char*)g.A + (size_t)cur.pm * tstepA; const char* cB = (const char*)g.Bt + (size_t)cur.pn * tstep;
    S.a_ready(cur);
    if constexpr (SP2) {
        PG8_STAGE(PG8_SB(0, 0), cB, voffB); PG8_STAGE(PG8_SB(0, 1), cB + hstep, voffB); PG8_STAGE(PG8_SA(0, 0), cA, voffA); PG8_STAGE(PG8_SA(0, 1), cA + hstepA, voffA);
        if (wr == 1) PG8_BAR;
        PG8_WAIT_V(2); PG8_BAR;
        PG8_STAGE(PG8_SB(1, 0), cB + kstep, voffB); PG8_STAGE(PG8_SA(1, 0), cA + kstep, voffA); PG8_STAGE(PG8_SB(1, 1), cB + hstep + kstep, voffB);
        PG8_WAIT_V(6); PG8_BAR;
    } else {
        PG8_STAGE(PG8_SB(0, 0), cB, voffB); PG8_STAGE(PG8_SA(0, 0), cA, voffA); PG8_STAGE(PG8_SB(0, 1), cB + hstep, voffB); PG8_STAGE(PG8_SA(0, 1), cA + hstepA, voffA);
        if (wr == 1) PG8_BAR;
        PG8_WAIT_V(4); PG8_BAR;
        PG8_STAGE(PG8_SB(1, 0), cB + kstep, voffB); PG8_STAGE(PG8_SA(1, 0), cA + kstep, voffA); PG8_STAGE(PG8_SB(1, 1), cB + hstep + kstep, voffB);
        PG8_WAIT_V(6); PG8_BAR;
    }
    for (;;) {
        const bool has_next = S.next(ui + 1, nxt);
        const char* nA = has_next ? (const char*)g.A + (size_t)nxt.pm * tstepA : cA; const char* nB = has_next ? (const char*)g.Bt + (size_t)nxt.pn * tstep : cB;
        for (int t = 0; t < nt; t += 2) {
            const bool last = (t == nt - 2);
            const char* a1 = cA + (size_t)(t + 1) * kstep;
            const char* a2 = last ? nA : cA + (size_t)(t + 2) * kstep; const char* b2 = last ? nB : cB + (size_t)(t + 2) * kstep;
            const char* a3 = a2 + kstep; const char* b3 = b2 + kstep;
            if (last && has_next) S.a_ready(nxt);
            if constexpr (SP2) {
            PG8_LDB(B0, 0, 0); PG8_LDB(B1, 0, 1); PG8_SCHED; PG8_LDA(At, 0, 0); PG8_STAGE(PG8_SA(1, 1), a1 + hstepA, voffA);
            PG8_WAIT_V(8); PG8_WAIT_L(0); PG8_BAR; PG8_MMA(0, 0, At, B0); PG8_MMA(0, 1, At, B1); PG8_BAR; PG8_SCHED;
            PG8_LDA(At, 0, 1); PG8_STAGE(PG8_SB(0, 0), b2, voffB); PG8_STAGE(PG8_SB(0, 1), b2 + hstep, voffB); PG8_STAGE(PG8_SA(0, 0), a2, voffA);
            PG8_WAIT_V(8); PG8_WAIT_L(0); PG8_BAR; PG8_MMA(1, 0, At, B0); PG8_MMA(1, 1, At, B1); PG8_BAR; PG8_SCHED;
            PG8_LDB(B0, 1, 0); PG8_LDB(B1, 1, 1); PG8_SCHED; PG8_LDA(At, 1, 0); PG8_STAGE(PG8_SA(0, 1), a2 + hstepA, voffA);
            PG8_WAIT_V(8); PG8_WAIT_L(0); PG8_BAR; PG8_MMA(0, 0, At, B0); PG8_MMA(0, 1, At, B1); PG8_BAR; PG8_SCHED;
            PG8_LDA(At, 1, 1); PG8_STAGE(PG8_SB(1, 0), b3, voffB); PG8_STAGE(PG8_SB(1, 1), b3 + hstep, voffB); PG8_STAGE(PG8_SA(1, 0), a3, voffA);
            PG8_WAIT_V(8); PG8_WAIT_L(0); PG8_BAR; PG8_MMA(1, 0, At, B0); PG8_MMA(1, 1, At, B1); PG8_BAR; PG8_SCHED;
            } else {
            PG8_LDB(B0, 0, 0); PG8_SCHED; PG8_LDA(At, 0, 0); PG8_STAGE(PG8_SA(1, 1), a1 + hstepA, voffA);
            PG8_WAIT_L(8); PG8_BAR; PG8_WAIT_L(0); PG8_MMA(0, 0, At, B0); PG8_BAR; PG8_SCHED;
            PG8_LDB(B1, 0, 1); PG8_STAGE(PG8_SB(0, 0), b2, voffB);
            PG8_BAR; PG8_WAIT_L(0); PG8_MMA(0, 1, At, B1); PG8_BAR;
            PG8_LDA(At, 0, 1); PG8_STAGE(PG8_SA(0, 0), a2, voffA);
            PG8_BAR; PG8_WAIT_L(0); PG8_MMA(1, 0, At, B0); PG8_BAR; PG8_SCHED;
            PG8_STAGE(PG8_SB(0, 1), b2 + hstep, voffB);
            PG8_WAIT_V(6); PG8_BAR; PG8_MMA(1, 1, At, B1); PG8_BAR;
            PG8_LDB(B0, 1, 0); PG8_SCHED; PG8_LDA(At, 1, 0); PG8_STAGE(PG8_SA(0, 1), a2 + hstepA, voffA);
            PG8_WAIT_L(8); PG8_BAR; PG8_WAIT_L(0); PG8_MMA(0, 0, At, B0); PG8_BAR; PG8_SCHED;
            PG8_LDB(B1, 1, 1); PG8_STAGE(PG8_SB(1, 0), b3, voffB);
            PG8_BAR; PG8_WAIT_L(0); PG8_MMA(0, 1, At, B1); PG8_BAR;
            PG8_LDA(At, 1, 1); PG8_STAGE(PG8_SA(1, 0), a3, voffA);
            PG8_BAR; PG8_WAIT_L(0); PG8_MMA(1, 0, At, B0); PG8_BAR; PG8_SCHED;
            PG8_STAGE(PG8_SB(1, 1), b3 + hstep, voffB);
            PG8_WAIT_V(6); PG8_BAR; PG8_MMA(1, 1, At, B1); PG8_BAR;
            }
        }
        if constexpr (ALIGN_EPI) { if (wr == 0) PG8_BAR; }
        if constexpr (!Epi::AFTER_DRAIN) { E(acc, cur, wr, wc, fr, fq); S.done(cur); }
        if (!has_next) break;
#pragma unroll
        for (int a = 0; a < 2; ++a)
#pragma unroll
            for (int b = 0; b < 2; ++b)
#pragma unroll
                for (int m = 0; m < 4; ++m)
#pragma unroll
                    for (int n = 0; n < 2; ++n) acc[a][b][m][n] = (f32x4){0.f, 0.f, 0.f, 0.f};
        cur = nxt; cA = nA; cB = nB; ++ui;
        if constexpr (ALIGN_EPI) { if (wr == 1) PG8_BAR; }
    }
    PG8_WAIT_V(0);
    if constexpr (!ALIGN_EPI) { if (wr == 0) PG8_BAR; }
    PG8_BAR;
    if constexpr (Epi::AFTER_DRAIN) { E.fused(acc, cur, wr, wc, fr, fq, lds, wid, lane); S.done(cur); }
#undef PG8_SA
#undef PG8_SB
#undef PG8_STAGE
#undef PG8_LDA
#undef PG8_LDB
#undef PG8_MMA
#undef PG8_WAIT_V
#undef PG8_WAIT_L
#undef PG8_BAR
#undef PG8_SCHED
}
}

using pg8::bf16_t; using pg8::bf16x8; using pg8::f32x4; using pg8::u32x4; using pg8::Unit;
typedef unsigned u32x2 __attribute__((ext_vector_type(2)));
#ifndef NPART
#define NPART 2
#endif
constexpr int TH = 65536 / NPART;
constexpr int NBP = TH / 4096;
constexpr int SEQ = 4096, DM = 1024, NIN = 6144, LDP = 5120, DFF = 2816, NUP = 5632, DMIX = 2048;
constexpr int LSTR = 136;
constexpr float EPS = 1e-5f;
constexpr int PC_Z = 0, PC_SB = 1024, PC_X = 2048, PC_P = 4096;
constexpr int LDS_BYTES = 152 * 1024;
constexpr size_t WT_IN_B = (size_t)NIN * DM * 2, WT_OUT_B = (size_t)DM * DMIX * 2, WT_UP_B = (size_t)NUP * DM * 2, WT_DN_B = (size_t)DM * DFF * 2;
constexpr size_t WL_B = WT_IN_B + WT_OUT_B + WT_UP_B + WT_DN_B;
constexpr size_t OFF_ROWSS = 2 * WL_B;
constexpr size_t OFF_CHDEC = OFF_ROWSS + (size_t)NPART * 5 * TH * 16 * 4;
constexpr size_t OFF_PROJ = OFF_CHDEC + (size_t)NBP * 32 * 16 * 2 * 4;
constexpr size_t OFF_DT = OFF_PROJ + (size_t)TH * LDP * 2;
constexpr size_t OFF_ST = OFF_DT + (size_t)TH * 32 * 4;
constexpr size_t OFF_HB = OFF_ST + (size_t)NBP * 32 * 16 * 2 * 8192 * 2;
constexpr size_t WS_END = OFF_HB + (size_t)TH * DM * 2;
constexpr size_t OFF_BAR = WS_END;
constexpr size_t OFF_EDGER = OFF_BAR + 16384;
constexpr size_t OFF_EDGEP = OFF_EDGER + (size_t)(TH / 256) * 2 * NUP * 4;
constexpr size_t OFF_WDT = OFF_EDGEP + (size_t)(TH / 256) * 2 * NUP * 4;
constexpr size_t OFF_XEDGER = OFF_WDT + (size_t)2 * 32 * DM * 2;
constexpr size_t OFF_XEDGEP = OFF_XEDGER + (size_t)(TH / 256) * 2 * 2048 * 4;
constexpr size_t WS_NEED = OFF_XEDGEP + (size_t)(TH / 256) * 2 * 2048 * 4;
constexpr size_t OFF_ACT = OFF_PROJ;
static_assert((size_t)TH * DFF * 2 <= (size_t)TH * LDP * 2 && (size_t)TH * DM * 2 <= (size_t)NBP * 32 * 16 * 2 * 8192 * 2, "overlay sizes");
static_assert(OFF_HB % 256 == 0 && OFF_PROJ % 256 == 0 && OFF_ST % 256 == 0 && TH % 4096 == 0, "align");

struct Params {
    const float* in[19];
    float* out;
    unsigned char* ws;
    int ph_lo, ph_hi;
};
enum { I_X = 0, I_WIN, I_CXW, I_CXB, I_DTBF, I_DTBB, I_ALF, I_ALB, I_DSK, I_SNW, I_SCW, I_WOUT, I_N1, I_N2, I_WUP, I_FCW, I_FCB, I_WDN, I_FNW };

typedef __bf16 bf16x2_t __attribute__((ext_vector_type(2)));
typedef float f32x2_t __attribute__((ext_vector_type(2)));
__device__ __forceinline__ unsigned pk2(float lo, float hi) { const f32x2_t v = {lo, hi}; const bf16x2_t b = __builtin_convertvector(v, bf16x2_t); return __builtin_bit_cast(unsigned, b); }
__device__ __forceinline__ float bflo(unsigned w) { return __uint_as_float(w << 16); }
__device__ __forceinline__ float bfhi(unsigned w) { return __uint_as_float(w & 0xffff0000u); }
__device__ __forceinline__ float bf2f(bf16_t b) { return __uint_as_float(((unsigned)b) << 16); }
__device__ __forceinline__ float silu_f(float v) { return v * __builtin_amdgcn_rcpf(1.0f + __expf(-v)); }
__device__ __forceinline__ float softplus_f(float v) { return v > 20.0f ? v : log1pf(__expf(v)); }
__device__ __forceinline__ void unpack8(const u32x4 w, float (&f)[8]) { f[0] = bflo(w.x); f[1] = bfhi(w.x); f[2] = bflo(w.y); f[3] = bfhi(w.y); f[4] = bflo(w.z); f[5] = bfhi(w.z); f[6] = bflo(w.w); f[7] = bfhi(w.w); }
__device__ __forceinline__ u32x4 pack8(const float (&f)[8]) { u32x4 w; w.x = pk2(f[0], f[1]); w.y = pk2(f[2], f[3]); w.z = pk2(f[4], f[5]); w.w = pk2(f[6], f[7]); return w; }

__device__ __forceinline__ float row_rs(const float* rowss, int row) {
    const f32x4 a = *(const f32x4*)(rowss + (size_t)row * 16), b = *(const f32x4*)(rowss + (size_t)row * 16 + 4), c = *(const f32x4*)(rowss + (size_t)row * 16 + 8), d = *(const f32x4*)(rowss + (size_t)row * 16 + 12);
    const float s = (((a[0] + a[1]) + (a[2] + a[3])) + ((b[0] + b[1]) + (b[2] + b[3]))) + (((c[0] + c[1]) + (c[2] + c[3])) + ((d[0] + d[1]) + (d[2] + d[3])));
    return rsqrtf(s * (1.0f / 1024.0f) + EPS);
}
__device__ __forceinline__ void panel_rs(const float* rowss, int pm, int& cached_pm, float* rs_lds) {
    if (pm != cached_pm) {
        cached_pm = pm;
        int tid_ = threadIdx.x; asm volatile("" : "+v"(tid_));
        __syncthreads();
        if (tid_ < 256) rs_lds[tid_] = row_rs(rowss, pm * 256 + tid_);
        __syncthreads();
    }
}
struct EpiUp {
    static constexpr bool PERM = true, AFTER_DRAIN = false;
    bf16_t* U; const float* rowss; float* rs_lds; mutable int cached_pm;
    __device__ __forceinline__ void operator()(const f32x4 (&acc)[2][2][4][2], const Unit& u, int wr, int wc, int fr, int fq) const {
        const int row0 = u.pm * 256 + wr * 64 + fr;
        panel_rs(rowss, u.pm, cached_pm, rs_lds);
#pragma unroll
        for (int ai = 0; ai < 2; ++ai)
#pragma unroll
            for (int m = 0; m < 4; ++m) {
                const int row = row0 + ai * 128 + m * 16;
                const float rs = rs_lds[row & 255];
#pragma unroll
                for (int bj = 0; bj < 2; ++bj) { const f32x4 v0 = acc[ai][bj][m][0] * rs, v1 = acc[ai][bj][m][1] * rs; u32x4 w; w.x = pk2(v0[0], v0[1]); w.y = pk2(v0[2], v0[3]); w.z = pk2(v1[0], v1[1]); w.w = pk2(v1[2], v1[3]);
                    *(u32x4*)(U + (size_t)row * NUP + u.pn * 256 + bj * 128 + wc * 32 + 8 * fq) = w; }
            }
    }
};
struct EpiRes {
    static constexpr bool PERM = true, AFTER_DRAIN = false;
    bf16_t* HB; float* rowss_next;
    __device__ __forceinline__ void operator()(const f32x4 (&acc)[2][2][4][2], const Unit& u, int wr, int wc, int fr, int fq) const {
        const int row0 = u.pm * 256 + wr * 64 + fr, col0 = u.pn * 256 + wc * 32 + 8 * fq;
#pragma unroll
        for (int ai = 0; ai < 2; ++ai)
#pragma unroll
            for (int m = 0; m < 4; ++m) {
                const int row = row0 + ai * 128 + m * 16; float ss = 0.f;
#pragma unroll
                for (int bj = 0; bj < 2; ++bj) { const size_t off = (size_t)row * DM + col0 + bj * 128;
                    const u32x4 hb = *(const u32x4*)(HB + off);
                    f32x4 o0 = acc[ai][bj][m][0], o1 = acc[ai][bj][m][1];
                    o0[0] += bflo(hb.x); o0[1] += bfhi(hb.x); o0[2] += bflo(hb.y); o0[3] += bfhi(hb.y); o1[0] += bflo(hb.z); o1[1] += bfhi(hb.z); o1[2] += bflo(hb.w); o1[3] += bfhi(hb.w);
                    u32x4 w; w.x = pk2(o0[0], o0[1]); w.y = pk2(o0[2], o0[3]); w.z = pk2(o1[0], o1[1]); w.w = pk2(o1[2], o1[3]); *(u32x4*)(HB + off) = w;
                    ss += ((o0[0] * o0[0] + o0[1] * o0[1]) + (o0[2] * o0[2] + o0[3] * o0[3])) + ((o1[0] * o1[0] + o1[1] * o1[1]) + (o1[2] * o1[2] + o1[3] * o1[3])); }
                ss += __shfl_xor(ss, 16); ss += __shfl_xor(ss, 32);
                if (fq == 0) rowss_next[(size_t)row * 16 + u.pn * 4 + wc] = ss;
            }
    }
};


__device__ __forceinline__ float dpp_shr1(float old, float src) { return __builtin_bit_cast(float, __builtin_amdgcn_update_dpp(__builtin_bit_cast(int, old), __builtin_bit_cast(int, src), 0x111, 0xf, 0xf, false)); }
__device__ __forceinline__ float dpp_shl1(float old, float src) { return __builtin_bit_cast(float, __builtin_amdgcn_update_dpp(__builtin_bit_cast(int, old), __builtin_bit_cast(int, src), 0x101, 0xf, 0xf, false)); }
__device__ __forceinline__ float dpp_ror1(float src) { return __builtin_bit_cast(float, __builtin_amdgcn_update_dpp(0, __builtin_bit_cast(int, src), 0x121, 0xf, 0xf, false)); }
__device__ __forceinline__ float dpp_rol1(float src) { return __builtin_bit_cast(float, __builtin_amdgcn_update_dpp(0, __builtin_bit_cast(int, src), 0x12F, 0xf, 0xf, false)); }
struct EpiIn {
    static constexpr bool PERM = true, AFTER_DRAIN = false;
    bf16_t* P; const float* rowss; float* rs_lds; float* xch; const float* cxw; const float* cxb; float* XEDGER; float* XEDGEP; mutable int cached_pm;
    __device__ __forceinline__ void operator()(const f32x4 (&acc_)[2][2][4][2], const Unit& u, int wr, int wc, int fr_, int fq_) const {
        f32x4 (&acc)[2][2][4][2] = const_cast<f32x4 (&)[2][2][4][2]>(acc_);
        int fr = fr_, fq = fq_; asm volatile("" : "+v"(fr), "+v"(fq));
        const int row0 = u.pm * 256 + wr * 64 + fr; const int pn = u.pn;
        panel_rs(rowss, u.pm, cached_pm, rs_lds);
        if (pn >= 4 && pn < 12) {
#pragma unroll
            for (int ai = 0; ai < 2; ++ai)
#pragma unroll
                for (int m = 0; m < 4; ++m) { const float rs = rs_lds[ai * 128 + wr * 64 + m * 16 + fr];
#pragma unroll
                    for (int bj = 0; bj < 2; ++bj)
#pragma unroll
                        for (int n = 0; n < 2; ++n) acc[ai][bj][m][n] *= rs; }
#pragma unroll
            for (int ai = 0; ai < 2; ++ai) { const int seg = 2 * ai + wr;
                if (fr == 0) {
#pragma unroll
                    for (int bj = 0; bj < 2; ++bj)
#pragma unroll
                        for (int n = 0; n < 2; ++n) *(f32x4*)(xch + (((seg * 2 + 0) * 4 + wc) * 4 + fq) * 16 + bj * 8 + n * 4) = acc[ai][bj][0][n]; }
                if (fr == 15) {
#pragma unroll
                    for (int bj = 0; bj < 2; ++bj)
#pragma unroll
                        for (int n = 0; n < 2; ++n) *(f32x4*)(xch + (((seg * 2 + 1) * 4 + wc) * 4 + fq) * 16 + bj * 8 + n * 4) = acc[ai][bj][3][n]; } }
            __syncthreads();
            auto body = [&](auto BJ_, auto AI_) {
                constexpr int bj = decltype(BJ_)::value, ai = decltype(AI_)::value;
                const int ch = (pn - 4) * 256 + bj * 128 + wc * 32 + 8 * fq, seg = 2 * ai + wr;
                f32x4 w0[2], w1[2], w2[2], bb[2];
#pragma unroll
                for (int n = 0; n < 2; ++n) { w0[n] = *(const f32x4*)(cxw + ch + 4 * n); w1[n] = *(const f32x4*)(cxw + 2048 + ch + 4 * n); w2[n] = *(const f32x4*)(cxw + 4096 + ch + 4 * n); bb[n] = *(const f32x4*)(cxb + ch + 4 * n); }
#pragma unroll
                for (int m = 0; m < 4; ++m) {
                    f32x4 pr[2], pe[2], ne[2];
#pragma unroll
                    for (int n = 0; n < 2; ++n) { pe[n] = (f32x4){0.f, 0.f, 0.f, 0.f}; ne[n] = pe[n];
                        if (m == 0 && seg > 0) pe[n] = *(const f32x4*)(xch + ((((seg - 1) * 2 + 1) * 4 + wc) * 4 + fq) * 16 + bj * 8 + n * 4);
                        if (m == 3 && seg < 3) ne[n] = *(const f32x4*)(xch + ((((seg + 1) * 2 + 0) * 4 + wc) * 4 + fq) * 16 + bj * 8 + n * 4); }
#pragma unroll
                    for (int n = 0; n < 2; ++n)
#pragma unroll
                        for (int j = 0; j < 4; ++j) {
                            const float cur = acc[ai][bj][m][n][j];
                            const float ov = (m > 0) ? dpp_ror1(acc[ai][bj][m > 0 ? m - 1 : 0][n][j]) : pe[n][j];
                            const float nv = (m < 3) ? dpp_rol1(acc[ai][bj][m < 3 ? m + 1 : 3][n][j]) : ne[n][j];
                            const float prev = dpp_shr1(ov, cur), next = dpp_shl1(nv, cur);
                            pr[n][j] = w0[n][j] * prev + w1[n][j] * cur + w2[n][j] * next + bb[n][j]; }
                    const int row = u.pm * 256 + ai * 128 + wr * 64 + m * 16 + fr;
                    u32x4 w; w.x = pk2(silu_f(pr[0][0]), silu_f(pr[0][1])); w.y = pk2(silu_f(pr[0][2]), silu_f(pr[0][3])); w.z = pk2(silu_f(pr[1][0]), silu_f(pr[1][1])); w.w = pk2(silu_f(pr[1][2]), silu_f(pr[1][3]));
                    *(u32x4*)(P + (size_t)row * LDP + PC_X + ch) = w;
                    if ((m == 0 && seg == 0 && fr == 0) || (m == 3 && seg == 3 && fr == 15)) {
                        const size_t eb = ((size_t)u.pm * 2 + (m == 0 ? 0 : 1)) * 2048 + ch;
                        *(f32x4*)(XEDGER + eb) = acc[ai][bj][m][0]; *(f32x4*)(XEDGER + eb + 4) = acc[ai][bj][m][1];
                        *(f32x4*)(XEDGEP + eb) = pr[0];             *(f32x4*)(XEDGEP + eb + 4) = pr[1]; }
                }
                __builtin_amdgcn_sched_barrier(0);
            };
            body(std::integral_constant<int, 0>{}, std::integral_constant<int, 0>{}); body(std::integral_constant<int, 0>{}, std::integral_constant<int, 1>{});
            body(std::integral_constant<int, 1>{}, std::integral_constant<int, 0>{}); body(std::integral_constant<int, 1>{}, std::integral_constant<int, 1>{});
            return;
        }
#pragma unroll
        for (int ai = 0; ai < 2; ++ai)
#pragma unroll
            for (int m = 0; m < 4; ++m) {
                const int row = row0 + ai * 128 + m * 16;
                const float rs = rs_lds[row & 255];
                if (pn < 16) {
                    const int cbase = (pn < 4 ? PC_Z + pn * 256 : PC_SB + (pn - 12) * 256);
#pragma unroll
                    for (int bj = 0; bj < 2; ++bj) { const f32x4 v0 = acc[ai][bj][m][0] * rs, v1 = acc[ai][bj][m][1] * rs; u32x4 w; w.x = pk2(v0[0], v0[1]); w.y = pk2(v0[2], v0[3]); w.z = pk2(v1[0], v1[1]); w.w = pk2(v1[2], v1[3]);
                        *(u32x4*)(P + (size_t)row * LDP + cbase + bj * 128 + wc * 32 + 8 * fq) = w; }
                } else {
                    const float rs2 = rs * rs; const f32x4 v0 = acc[ai][0][m][0] * acc[ai][1][m][0] * rs2, v1 = acc[ai][0][m][1] * acc[ai][1][m][1] * rs2;
                    u32x4 w; w.x = pk2(v0[0], v0[1]); w.y = pk2(v0[2], v0[3]); w.z = pk2(v1[0], v1[1]); w.w = pk2(v1[2], v1[3]);
                    *(u32x4*)(P + (size_t)row * LDP + PC_P + (pn - 16) * 128 + wc * 32 + 8 * fq) = w;
                }
            }
    }
};
struct EpiAct {
    static constexpr bool PERM = true, AFTER_DRAIN = false;
    bf16_t* ACT; const float* rowss; float* rs_lds; float* xch; const float* cw; const float* cb; float* EDGER; float* EDGEP; mutable int cached_pm;
    __device__ __forceinline__ void operator()(const f32x4 (&acc_)[2][2][4][2], const Unit& u, int wr, int wc, int fr_, int fq_) const {
        int fr = fr_, fq = fq_; asm volatile("" : "+v"(fr), "+v"(fq));
        f32x4 (&acc)[2][2][4][2] = const_cast<f32x4 (&)[2][2][4][2]>(acc_);
        panel_rs(rowss, u.pm, cached_pm, rs_lds);
#pragma unroll
        for (int ai = 0; ai < 2; ++ai)
#pragma unroll
            for (int m = 0; m < 4; ++m) { const float rs = rs_lds[ai * 128 + wr * 64 + m * 16 + fr];
#pragma unroll
                for (int bj = 0; bj < 2; ++bj)
#pragma unroll
                    for (int n = 0; n < 2; ++n) acc[ai][bj][m][n] *= rs; }
#pragma unroll
        for (int ai = 0; ai < 2; ++ai) { const int seg = 2 * ai + wr;
            if (fr == 0) {
#pragma unroll
                for (int bj = 0; bj < 2; ++bj)
#pragma unroll
                    for (int n = 0; n < 2; ++n) *(f32x4*)(xch + (((seg * 2 + 0) * 4 + wc) * 4 + fq) * 16 + bj * 8 + n * 4) = acc[ai][bj][0][n]; }
            if (fr == 15) {
#pragma unroll
                for (int bj = 0; bj < 2; ++bj)
#pragma unroll
                    for (int n = 0; n < 2; ++n) *(f32x4*)(xch + (((seg * 2 + 1) * 4 + wc) * 4 + fq) * 16 + bj * 8 + n * 4) = acc[ai][bj][3][n]; } }
        const int f0 = u.pn * 128 + wc * 32 + 8 * fq;
        f32x4 w0v[8];
        { const int f = f0; w0v[0] = *(const f32x4*)(cw + f); w0v[1] = *(const f32x4*)(cw + NUP + f); w0v[2] = *(const f32x4*)(cw + 2 * NUP + f); w0v[3] = *(const f32x4*)(cb + f);
          w0v[4] = *(const f32x4*)(cw + DFF + f); w0v[5] = *(const f32x4*)(cw + NUP + DFF + f); w0v[6] = *(const f32x4*)(cw + 2 * NUP + DFF + f); w0v[7] = *(const f32x4*)(cb + DFF + f); }
        __syncthreads();
        auto body = [&](auto N_, auto AI_, const f32x4 (&wv)[8]) {
            constexpr int n = decltype(N_)::value, ai = decltype(AI_)::value;
            const int f = f0 + 4 * n, seg = 2 * ai + wr;
            const f32x4 wg0 = wv[0], wg1 = wv[1], wg2 = wv[2], bg = wv[3], wu0 = wv[4], wu1 = wv[5], wu2 = wv[6], bu = wv[7];
            f32x4 peg = (f32x4){0.f, 0.f, 0.f, 0.f}, peu = peg, neg = peg, neu = peg;
            if (seg > 0) { peg = *(const f32x4*)(xch + ((((seg - 1) * 2 + 1) * 4 + wc) * 4 + fq) * 16 + n * 4); peu = *(const f32x4*)(xch + ((((seg - 1) * 2 + 1) * 4 + wc) * 4 + fq) * 16 + 8 + n * 4); }
            if (seg < 3) { neg = *(const f32x4*)(xch + ((((seg + 1) * 2 + 0) * 4 + wc) * 4 + fq) * 16 + n * 4); neu = *(const f32x4*)(xch + ((((seg + 1) * 2 + 0) * 4 + wc) * 4 + fq) * 16 + 8 + n * 4); }
#pragma unroll
            for (int m = 0; m < 4; ++m) {
                const f32x4 sgm = acc[ai][0][m][n], sum_ = acc[ai][1][m][n];
                f32x4 pg, pu;
#pragma unroll
                for (int j = 0; j < 4; ++j) {
                    const float og = (m > 0) ? dpp_ror1(acc[ai][0][m > 0 ? m - 1 : 0][n][j]) : peg[j], ou = (m > 0) ? dpp_ror1(acc[ai][1][m > 0 ? m - 1 : 0][n][j]) : peu[j];
                    const float ng = (m < 3) ? dpp_rol1(acc[ai][0][m < 3 ? m + 1 : 3][n][j]) : neg[j], nu = (m < 3) ? dpp_rol1(acc[ai][1][m < 3 ? m + 1 : 3][n][j]) : neu[j];
                    const float gprev = dpp_shr1(og, sgm[j]), uprev = dpp_shr1(ou, sum_[j]);
                    const float gnext = dpp_shl1(ng, sgm[j]), unext = dpp_shl1(nu, sum_[j]);
                    pg[j] = wg0[j] * gprev + wg1[j] * sgm[j] + wg2[j] * gnext + bg[j];
                    pu[j] = wu0[j] * uprev + wu1[j] * sum_[j] + wu2[j] * unext + bu[j];
                }
                const int row = u.pm * 256 + ai * 128 + wr * 64 + m * 16 + fr;
                u32x2 w; w.x = pk2(silu_f(pg[0]) * pu[0], silu_f(pg[1]) * pu[1]); w.y = pk2(silu_f(pg[2]) * pu[2], silu_f(pg[3]) * pu[3]);
                *(u32x2*)(ACT + (size_t)row * DFF + f) = w;
                if ((m == 0 && seg == 0 && fr == 0) || (m == 3 && seg == 3 && fr == 15)) {
                    const size_t eb = ((size_t)u.pm * 2 + (m == 0 ? 0 : 1)) * NUP;
                    *(f32x4*)(EDGER + eb + f) = sgm; *(f32x4*)(EDGER + eb + DFF + f) = sum_;
                    *(f32x4*)(EDGEP + eb + f) = pg;  *(f32x4*)(EDGEP + eb + DFF + f) = pu; }
            }
        };
        body(std::integral_constant<int, 0>{}, std::integral_constant<int, 0>{}, w0v);
        f32x4 w1v[8];
        { const int f = f0 + 4; w1v[0] = *(const f32x4*)(cw + f); w1v[1] = *(const f32x4*)(cw + NUP + f); w1v[2] = *(const f32x4*)(cw + 2 * NUP + f); w1v[3] = *(const f32x4*)(cb + f);
          w1v[4] = *(const f32x4*)(cw + DFF + f); w1v[5] = *(const f32x4*)(cw + NUP + DFF + f); w1v[6] = *(const f32x4*)(cw + 2 * NUP + DFF + f); w1v[7] = *(const f32x4*)(cb + DFF + f); }
        __builtin_amdgcn_sched_barrier(0);
        body(std::integral_constant<int, 0>{}, std::integral_constant<int, 1>{}, w0v);
        __builtin_amdgcn_sched_barrier(0);
        body(std::integral_constant<int, 1>{}, std::integral_constant<int, 0>{}, w1v);
        __builtin_amdgcn_sched_barrier(0);
        body(std::integral_constant<int, 1>{}, std::integral_constant<int, 1>{}, w1v);
    }
};

__device__ __forceinline__ int src_in(int j) {
    if (j < 3072) return j;
    if (j < 4096) return j + 32;
    { const int t = (j - 4096) >> 8, r = (j - 4096) & 255; return r < 128 ? 4128 + t * 128 + r : 5152 + t * 128 + (r - 128); }
}
__device__ __forceinline__ void convert_weight(const float* W, int ldw, const float* scale, bf16_t* Wt, int K, int N, int kind, float* tile, int blk, int nblk) {
    int tid_ = threadIdx.x; asm volatile("" : "+v"(tid_));
    const int tid = tid_, nkt = K / 64, ntile = (N / 256) * nkt;
    for (int t = blk; t < ntile; t += nblk) {
        const int j0 = (t / nkt) * 256, k0 = (t % nkt) * 64;
        float v[32];
#pragma unroll
        for (int i = 0; i < 32; ++i) { const int kk = (tid >> 8) + 2 * i, jj = tid & 255; const int jx = j0 + jj; const int sj = kind == 1 ? src_in(jx) : (kind == 2 ? (((jx & 255) < 128) ? (jx >> 8) * 128 + (jx & 127) : DFF + (jx >> 8) * 128 + (jx & 127)) : jx);
            v[i] = W[(size_t)(k0 + kk) * ldw + (sj >= 0 ? sj : 0)]; if (sj < 0) v[i] = 0.f; }
        __syncthreads();
#pragma unroll
        for (int i = 0; i < 32; ++i) { const int kk = (tid >> 8) + 2 * i, jj = tid & 255; tile[kk * 257 + jj] = v[i]; }
        __syncthreads();
        const int kk = 2 * (tid & 31); const float s0 = scale ? scale[k0 + kk] : 1.0f, s1 = scale ? scale[k0 + kk + 1] : 1.0f;
#pragma unroll
        for (int i = 0; i < 16; ++i) { const int jj = (tid >> 5) + 16 * i;
            *(unsigned*)(Wt + (size_t)(j0 + jj) * K + k0 + kk) = pk2(tile[kk * 257 + jj] * s0, tile[(kk + 1) * 257 + jj] * s1); }
    }
}
__device__ __forceinline__ void phase_weights(const Params& p, float* tile) {
    const int G = gridDim.x; int cum = 0;
#define WBLK ((int)((blockIdx.x + (unsigned)G - (unsigned)(cum % G)) % (unsigned)G))
    for (int l = 0; l < 2; ++l) {
        unsigned char* wb = p.ws + (size_t)l * WL_B;
        convert_weight(p.in[I_WIN] + (size_t)l * DM * 6176, 6176, p.in[I_N1] + l * DM, (bf16_t*)wb, DM, NIN, 1, tile, WBLK, G); cum += (NIN / 256) * (DM / 64);
        convert_weight(p.in[I_WOUT] + (size_t)l * DMIX * DM, DM, nullptr, (bf16_t*)(wb + WT_IN_B), DMIX, DM, 0, tile, WBLK, G); cum += (DM / 256) * (DMIX / 64);
        convert_weight(p.in[I_WUP] + (size_t)l * DM * NUP, NUP, p.in[I_N2] + l * DM, (bf16_t*)(wb + WT_IN_B + WT_OUT_B), DM, NUP, 2, tile, WBLK, G); cum += (NUP / 256) * (DM / 64);
        convert_weight(p.in[I_WDN] + (size_t)l * DFF * DM, DM, nullptr, (bf16_t*)(wb + WT_IN_B + WT_OUT_B + WT_UP_B), DFF, DM, 0, tile, WBLK, G); cum += (DM / 256) * (DFF / 64);
    }
#undef WBLK
    {
        bf16_t* WDT = (bf16_t*)(p.ws + OFF_WDT); int tid_ = threadIdx.x; asm volatile("" : "+v"(tid_));
        for (int idx = blockIdx.x * 512 + tid_; idx < 2 * 32 * DM; idx += gridDim.x * 512) { const int l = idx >> 15, j = (idx >> 10) & 31, k = idx & 1023;
            const float v = p.in[I_WIN][((size_t)l * DM + k) * 6176 + 3072 + j] * p.in[I_N1][l * DM + k]; const unsigned w = pk2(v, v); WDT[idx] = (bf16_t)(w & 0xffffu); }
    }
}
__device__ __forceinline__ void phase_prep(const Params& p, int hf) {
    int tid_ = threadIdx.x; asm volatile("" : "+v"(tid_));
    const int tid = tid_, wid = tid >> 6, lane = tid & 63;
    float* rowss = (float*)(p.ws + OFF_ROWSS) + (size_t)hf * 5 * TH * 16;
    bf16_t* HB = (bf16_t*)(p.ws + OFF_HB);
    const float* x = p.in[I_X] + (size_t)hf * TH * DM;
#pragma unroll 4
    for (int row = blockIdx.x * 8 + wid; row < TH; row += gridDim.x * 8) {
        float ss = 0.f;
#pragma unroll
        for (int i = 0; i < 4; ++i) { const int c = i * 256 + lane * 4; const f32x4 v = *(const f32x4*)(x + (size_t)row * DM + c);
            ss += (v[0] * v[0] + v[1] * v[1]) + (v[2] * v[2] + v[3] * v[3]); u32x2 w; w.x = pk2(v[0], v[1]); w.y = pk2(v[2], v[3]); *(u32x2*)(HB + (size_t)row * DM + c) = w; }
#pragma unroll
        for (int o = 32; o >= 1; o >>= 1) ss += __shfl_xor(ss, o);
        if (lane < 16) rowss[(size_t)row * 16 + lane] = lane == 0 ? ss : 0.f;
    }
}
__device__ __forceinline__ void phase_final(const Params& p, int hf) {
    int tid_ = threadIdx.x; asm volatile("" : "+v"(tid_));
    const int tid = tid_, wid = tid >> 6, lane = tid & 63;
    const float* rowss = (const float*)(p.ws + OFF_ROWSS) + ((size_t)hf * 5 + 4) * TH * 16;
    float* h = p.out + (size_t)hf * TH * DM; const float* w = p.in[I_FNW]; const bf16_t* HB = (const bf16_t*)(p.ws + OFF_HB);
#pragma unroll 4
    for (int row = blockIdx.x * 8 + wid; row < TH; row += gridDim.x * 8) {
        const float rs = row_rs(rowss, row);
#pragma unroll
        for (int i = 0; i < 4; ++i) { const int c = i * 256 + lane * 4; const u32x2 hb = *(const u32x2*)(HB + (size_t)row * DM + c); const f32x4 g = *(const f32x4*)(w + c);
            f32x4 v; v[0] = bflo(hb.x); v[1] = bfhi(hb.x); v[2] = bflo(hb.y); v[3] = bfhi(hb.y);
            v = v * rs * g; *(f32x4*)(h + (size_t)row * DM + c) = v; }
    }
}
__device__ __forceinline__ void phase_edgefix(const Params& p, int l) {
    const float* EDGER = (const float*)(p.ws + OFF_EDGER); const float* EDGEP = (const float*)(p.ws + OFF_EDGEP); bf16_t* ACT = (bf16_t*)(p.ws + OFF_ACT);
    const float* cw = p.in[I_FCW] + (size_t)l * 3 * NUP;
    int tid_ = threadIdx.x; asm volatile("" : "+v"(tid_));
    for (int idx = blockIdx.x * 512 + tid_; idx < (TH / 256) * 2 * DFF; idx += gridDim.x * 512) {
        const int f = idx % DFF, pe = idx / DFF, e = pe & 1, pm = pe >> 1, t = 256 * pm + (e ? 255 : 0);
        const bool has = e ? (((t + 1) % SEQ) != 0) : ((t % SEQ) != 0);
        float ng = 0.f, nu = 0.f;
        if (has) { const size_t nb = ((size_t)(pm + (e ? 1 : -1)) * 2 + (e ? 0 : 1)) * NUP; ng = EDGER[nb + f]; nu = EDGER[nb + DFF + f]; }
        const int wk = e ? 2 : 0; const size_t eb = ((size_t)pm * 2 + e) * NUP;
        const float pg = EDGEP[eb + f] + cw[wk * NUP + f] * ng, pu = EDGEP[eb + DFF + f] + cw[wk * NUP + DFF + f] * nu;
        const float o = silu_f(pg) * pu; const unsigned w = pk2(o, o); ACT[(size_t)t * DFF + f] = (bf16_t)(w & 0xffffu);
    }
}
__device__ __forceinline__ void edgefix_panel(const Params& p, int l, int pm) {
    const float* EDGER = (const float*)(p.ws + OFF_EDGER); const float* EDGEP = (const float*)(p.ws + OFF_EDGEP); bf16_t* ACT = (bf16_t*)(p.ws + OFF_ACT);
    const float* cw = p.in[I_FCW] + (size_t)l * 3 * NUP;
    int tid_ = threadIdx.x; asm volatile("" : "+v"(tid_));
    for (int idx = tid_; idx < 2 * DFF; idx += 512) {
        const int e = idx >= DFF ? 1 : 0, f = idx - e * DFF, t = 256 * pm + (e ? 255 : 0);
        const bool has = e ? (((t + 1) % SEQ) != 0) : ((t % SEQ) != 0);
        float ng = 0.f, nu = 0.f;
        if (has) { const size_t nb = ((size_t)(pm + (e ? 1 : -1)) * 2 + (e ? 0 : 1)) * NUP; ng = EDGER[nb + f]; nu = EDGER[nb + DFF + f]; }
        const int wk = e ? 2 : 0; const size_t eb = ((size_t)pm * 2 + e) * NUP;
        const float pg = EDGEP[eb + f] + cw[wk * NUP + f] * ng, pu = EDGEP[eb + DFF + f] + cw[wk * NUP + DFF + f] * nu;
        const float o = silu_f(pg) * pu; const unsigned w = pk2(o, o); ACT[(size_t)t * DFF + f] = (bf16_t)(w & 0xffffu);
    }
}
__device__ __forceinline__ void phase_dt(const Params& p, int l, const float* rowss) {
    int tid_ = threadIdx.x; asm volatile("" : "+v"(tid_));
    const int wid = tid_ >> 6, lane = tid_ & 63, fr = lane & 15, fq = lane >> 4;
    const bf16_t* HB = (const bf16_t*)(p.ws + OFF_HB); const bf16_t* WDT = (const bf16_t*)(p.ws + OFF_WDT) + (size_t)l * 32 * DM; float* DT = (float*)(p.ws + OFF_DT);
    for (int tb = blockIdx.x; tb < TH / 128; tb += gridDim.x) {
        const int tok = tb * 128 + wid * 16 + fr;
        f32x4 a0 = (f32x4){0.f, 0.f, 0.f, 0.f}, a1 = a0;
#pragma unroll 1
        for (int k0 = 0; k0 < 32; k0 += 8) {
            bf16x8 hf[8], w0[8], w1[8];
#pragma unroll
            for (int i = 0; i < 8; ++i) { const int ko = 32 * (k0 + i) + 8 * fq;
                hf[i] = *(const bf16x8*)(HB + (size_t)tok * DM + ko); w0[i] = *(const bf16x8*)(WDT + (size_t)fr * DM + ko); w1[i] = *(const bf16x8*)(WDT + (size_t)(16 + fr) * DM + ko); }
#pragma unroll
            for (int i = 0; i < 8; ++i) { a0 = __builtin_amdgcn_mfma_f32_16x16x32_bf16(w0[i], hf[i], a0, 0, 0, 0); a1 = __builtin_amdgcn_mfma_f32_16x16x32_bf16(w1[i], hf[i], a1, 0, 0, 0); }
        }
        const float rs = row_rs(rowss, tok);
        *(f32x4*)(DT + (size_t)tok * 32 + 4 * fq) = a0 * rs; *(f32x4*)(DT + (size_t)tok * 32 + 16 + 4 * fq) = a1 * rs;
    }
}
__device__ __forceinline__ void phase_xedgefix(const Params& p, int l) {
    const float* XEDGER = (const float*)(p.ws + OFF_XEDGER); const float* XEDGEP = (const float*)(p.ws + OFF_XEDGEP); bf16_t* P = (bf16_t*)(p.ws + OFF_PROJ);
    const float* cxw = p.in[I_CXW] + (size_t)l * 3 * 2048;
    int tid_ = threadIdx.x; asm volatile("" : "+v"(tid_));
    for (int idx = blockIdx.x * 512 + tid_; idx < (TH / 256) * 2 * 2048; idx += gridDim.x * 512) {
        const int ch = idx & 2047, pe = idx >> 11, e = pe & 1, pm = pe >> 1, t = 256 * pm + (e ? 255 : 0);
        const bool has = e ? (((t + 1) % SEQ) != 0) : ((t % SEQ) != 0);
        float nb = 0.f;
        if (has) nb = XEDGER[((size_t)(pm + (e ? 1 : -1)) * 2 + (e ? 0 : 1)) * 2048 + ch];
        const float pre = XEDGEP[((size_t)pm * 2 + e) * 2048 + ch] + cxw[(e ? 2 : 0) * 2048 + ch] * nb;
        const float o = silu_f(pre); const unsigned w = pk2(o, o); P[(size_t)t * LDP + PC_X + ch] = (bf16_t)(w & 0xffffu);
    }
}
__device__ __forceinline__ void phase_shortconv(const Params& p, int l) {
    bf16_t* P = (bf16_t*)(p.ws + OFF_PROJ);
    const float* cw = p.in[I_SCW] + (size_t)l * 3 * 1024;
    int tid_ = threadIdx.x; asm volatile("" : "+v"(tid_));
    const int j0 = (tid_ & 127) * 8, sub = tid_ >> 7;
    float w[3][8];
#pragma unroll
    for (int k = 0; k < 3; ++k) { const f32x4 a0 = *(const f32x4*)(cw + k * 1024 + j0), a1 = *(const f32x4*)(cw + k * 1024 + j0 + 4);
#pragma unroll
        for (int j = 0; j < 4; ++j) { w[k][j] = a0[j]; w[k][4 + j] = a1[j]; } }
    for (int tb = blockIdx.x; tb < TH / 32; tb += gridDim.x) {
        const int t0 = tb * 32 + sub * 8, pos0 = t0 % SEQ;
        u32x4 rp[10], rb[8];
#pragma unroll
        for (int r = 0; r < 10; ++r) { const int pos = pos0 - 1 + r; const bool ok = pos >= 0 && pos < SEQ;
            rp[r] = *(const u32x4*)(P + (size_t)(ok ? t0 - 1 + r : t0) * LDP + PC_P + j0);
            if (!ok) rp[r] = (u32x4){0u, 0u, 0u, 0u}; }
#pragma unroll
        for (int r = 0; r < 8; ++r) rb[r] = *(const u32x4*)(P + (size_t)(t0 + r) * LDP + PC_SB + j0);
#pragma unroll
        for (int r = 0; r < 8; ++r) { float p0[8], p1[8], p2[8], sb[8], o[8]; unpack8(rp[r], p0); unpack8(rp[r + 1], p1); unpack8(rp[r + 2], p2); unpack8(rb[r], sb);
#pragma unroll
            for (int j = 0; j < 8; ++j) o[j] = sb[j] * (w[0][j] * p0[j] + w[1][j] * p1[j] + w[2][j] * p2[j]);
            *(u32x4*)(P + (size_t)(t0 + r) * LDP + PC_SB + j0) = pack8(o); }
    }
}

__device__ __forceinline__ int chperm(int t, int i) { return 32 * (t >> 1) + 8 * (i >> 2) + 4 * (t & 1) + (i & 3); }
__device__ __forceinline__ void ssd_dt_load(const float* DT, int t0, int g, int wid, int lane, float& r0, float& r1) {
    const int dir = wid >> 2, hh = wid & 3, h = 4 * g + hh;
    r0 = DT[(size_t)(t0 + lane) * 32 + dir * 16 + h]; r1 = DT[(size_t)(t0 + 64 + lane) * 32 + dir * 16 + h];
}
__device__ __forceinline__ float ssd_dt_scan(const Params& p, int l, float r0, float r1, int g, float* sm_dt, float* sm_cs, int wid, int lane) {
    const int dir = wid >> 2, hh = wid & 3, h = 4 * g + hh;
    const float bias = p.in[dir ? I_DTBB : I_DTBF][l * 16 + h]; const float A = -__expf(p.in[dir ? I_ALB : I_ALF][l * 16 + h]);
    const float d0 = softplus_f(r0 + bias), d1 = softplus_f(r1 + bias);
    const float a0 = A * d0, a1 = A * d1;
    float s0 = a0, s1 = a1;
#pragma unroll
    for (int o = 1; o < 64; o <<= 1) { const float u0 = __shfl_up(s0, o), u1 = __shfl_up(s1, o); if (lane >= o) { s0 += u0; s1 += u1; } }
    const float tot0 = __shfl(s0, 63); s1 += tot0; const float total = __shfl(s1, 63);
    float c0 = s0, c1 = s1;
    if (dir) { c0 = total - s0 + a0; c1 = total - s1 + a1; }
    const int b = (dir * 4 + hh) * 128;
    sm_dt[b + lane] = d0; sm_dt[b + 64 + lane] = d1; sm_cs[b + lane] = c0; sm_cs[b + 64 + lane] = c1;
    return total;
}
template <int NCH> struct ConvTr {
    static constexpr int NPAIR = NCH / 2, NT = NPAIR * 16 / 512;
    unsigned xr[NT][8];
    __device__ __forceinline__ void load(const bf16_t* P, int t0, int pos0, int col0, int tid) {
#pragma unroll
        for (int it = 0; it < NT; ++it) { const int task = tid + it * 512, cp = task % NPAIR, to = task / NPAIR, ch = 2 * cp;
#pragma unroll
            for (int r = 0; r < 8; ++r) xr[it][r] = *(const unsigned*)(P + (size_t)(t0 + 8 * to + r) * LDP + col0 + ch); }
    }
    __device__ __forceinline__ void compute(const float*, const float*, int, bf16_t* dst, int tid) const {
#pragma unroll
        for (int it = 0; it < NT; ++it) { const int task = tid + it * 512, cp = task % NPAIR, to = task / NPAIR, ch = 2 * cp;
            u32x4 lo, hi;
            lo.x = (xr[it][0] & 0xffffu) | (xr[it][1] << 16); lo.y = (xr[it][2] & 0xffffu) | (xr[it][3] << 16); lo.z = (xr[it][4] & 0xffffu) | (xr[it][5] << 16); lo.w = (xr[it][6] & 0xffffu) | (xr[it][7] << 16);
            hi.x = (xr[it][0] >> 16) | (xr[it][1] & 0xffff0000u); hi.y = (xr[it][2] >> 16) | (xr[it][3] & 0xffff0000u); hi.z = (xr[it][4] >> 16) | (xr[it][5] & 0xffff0000u); hi.w = (xr[it][6] >> 16) | (xr[it][7] & 0xffff0000u);
            *(u32x4*)(dst + (size_t)ch * LSTR + 8 * to) = lo;
            *(u32x4*)(dst + (size_t)(ch + 1) * LSTR + 8 * to) = hi; }
    }
};
template <int NCH> struct ConvNat {
    static constexpr int NG = NCH / 8, NT = NG * 128 / 512;
    u32x4 xr[NT];
    __device__ __forceinline__ void load(const bf16_t* P, int t0, int pos0, int col0, int tid) {
#pragma unroll
        for (int it = 0; it < NT; ++it) { const int task = tid + it * 512, cg8 = task % NG, l = task / NG; xr[it] = *(const u32x4*)(P + (size_t)(t0 + l) * LDP + col0 + 8 * cg8); }
    }
    __device__ __forceinline__ void compute(const float*, const float*, int, bf16_t* dst, int tid) const {
#pragma unroll
        for (int it = 0; it < NT; ++it) { const int task = tid + it * 512, cg8 = task % NG, l = task / NG; *(u32x4*)(dst + (size_t)l * LSTR + 8 * cg8) = xr[it]; }
    }
};

__device__ __forceinline__ void phase_ssd_states(const Params& p, int l, unsigned char* smem) {
    int tid_ = threadIdx.x; asm volatile("" : "+v"(tid_));
    const int tid = tid_, wid = tid >> 6, lane = tid & 63, fr = lane & 15, fq = lane >> 4;
    const bf16_t* P = (const bf16_t*)(p.ws + OFF_PROJ); const float* DT = (const float*)(p.ws + OFF_DT);
    bf16_t* ST = (bf16_t*)(p.ws + OFF_ST); float* CHDEC = (float*)(p.ws + OFF_CHDEC);
    const float* cw = p.in[I_CXW] + (size_t)l * 3 * 2048; const float* cb = p.in[I_CXB] + (size_t)l * 2048;
    bf16_t* XT = (bf16_t*)smem;
    bf16_t* BT = (bf16_t*)(smem + 256 * LSTR * 2);
    float* sm_dt = (float*)(smem + 384 * LSTR * 2);
    float* sm_cs = sm_dt + 1024;
    float* sm_w = sm_cs + 1024;
    {
        const float* XEDGER = (const float*)(p.ws + OFF_XEDGER); const float* XEDGEP = (const float*)(p.ws + OFF_XEDGEP); bf16_t* Pw = (bf16_t*)(p.ws + OFF_PROJ);
        const float* cxw = p.in[I_CXW] + (size_t)l * 3 * 2048;
        for (int item = blockIdx.x; item < NBP * 128; item += gridDim.x) {
            const int g = item & 3, c = (item >> 2) & 31, b = item >> 7, e = c & 1, pm = b * 16 + (c >> 1), t = b * SEQ + c * 128 + (e ? 127 : 0);
            const int ch = tid < 256 ? 256 * g + tid : (tid < 384 ? 1024 + 128 * g + (tid - 256) : 1536 + 128 * g + (tid - 384));
            const bool has = e ? (c != 31) : (c != 0);
            float nb = 0.f;
            if (has) nb = XEDGER[((size_t)(pm + (e ? 1 : -1)) * 2 + (e ? 0 : 1)) * 2048 + ch];
            const float pre = XEDGEP[((size_t)pm * 2 + e) * 2048 + ch] + cxw[(e ? 2 : 0) * 2048 + ch] * nb;
            const float o = silu_f(pre); const unsigned w = pk2(o, o); Pw[(size_t)t * LDP + PC_X + ch] = (bf16_t)(w & 0xffffu);
        }
        asm volatile("s_waitcnt vmcnt(0)" ::: "memory"); __syncthreads();
    }
    for (int item = blockIdx.x; item < NBP * 128; item += gridDim.x) {
        const int g = item & 3, c = (item >> 2) & 31, b = item >> 7;
        const int t0 = b * SEQ + c * 128, pos0 = c * 128;
        __syncthreads();
        float r0, r1; ssd_dt_load(DT, t0, g, wid, lane, r0, r1);
        ConvTr<256> cx; ConvTr<128> cbt;
        cx.load(P, t0, pos0, PC_X + 256 * g, tid); cbt.load(P, t0, pos0, PC_X + 1024 + 128 * g, tid);
        const float total = ssd_dt_scan(p, l, r0, r1, g, sm_dt, sm_cs, wid, lane);
        cx.compute(cw, cb, 256 * g, XT, tid); cbt.compute(cw, cb, 1024 + 128 * g, BT, tid);
        const int dir = wid >> 2, hh = wid & 3, h = 4 * g + hh, sb = (dir * 4 + hh) * 128;
        {
            sm_w[sb + lane] = sm_dt[sb + lane] * __expf(total - sm_cs[sb + lane]);
            sm_w[sb + 64 + lane] = sm_dt[sb + 64 + lane] * __expf(total - sm_cs[sb + 64 + lane]);
            if (lane == 0) CHDEC[((b * 32 + c) * 16 + h) * 2 + dir] = __expf(total);
        }
        __syncthreads();
        f32x4 acc[4][8];
#pragma unroll
        for (int i = 0; i < 4; ++i)
#pragma unroll
            for (int j = 0; j < 8; ++j) acc[i][j] = (f32x4){0.f, 0.f, 0.f, 0.f};
#pragma unroll 1
        for (int ks = 0; ks < 4; ++ks) {
            const f32x4 w0 = *(const f32x4*)(sm_w + sb + 32 * ks + 8 * fq), w1 = *(const f32x4*)(sm_w + sb + 32 * ks + 8 * fq + 4);
            bf16x8 xf[4];
#pragma unroll
            for (int pi = 0; pi < 4; ++pi) { const u32x4 raw = *(const u32x4*)(XT + (size_t)(64 * hh + chperm(pi, fr)) * LSTR + 32 * ks + 8 * fq); float f[8]; unpack8(raw, f);
                f[0] *= w0[0]; f[1] *= w0[1]; f[2] *= w0[2]; f[3] *= w0[3]; f[4] *= w1[0]; f[5] *= w1[1]; f[6] *= w1[2]; f[7] *= w1[3];
                const u32x4 pk = pack8(f); xf[pi] = __builtin_bit_cast(bf16x8, pk); }
#pragma unroll
            for (int ni = 0; ni < 8; ++ni) { const bf16x8 bf = *(const bf16x8*)(BT + (size_t)chperm(ni, fr) * LSTR + 32 * ks + 8 * fq);
#pragma unroll
                for (int pi = 0; pi < 4; ++pi) acc[pi][ni] = __builtin_amdgcn_mfma_f32_16x16x32_bf16(bf, xf[pi], acc[pi][ni], 0, 0, 0); }
        }
        bf16_t* S = ST + ((size_t)((b * 32 + c) * 16 + h) * 2 + dir) * 8192;
#pragma unroll
        for (int pi = 0; pi < 4; ++pi)
#pragma unroll
            for (int q = 0; q < 4; ++q) { u32x4 w; w.x = pk2(acc[pi][2 * q][0], acc[pi][2 * q][1]); w.y = pk2(acc[pi][2 * q][2], acc[pi][2 * q][3]); w.z = pk2(acc[pi][2 * q + 1][0], acc[pi][2 * q + 1][1]); w.w = pk2(acc[pi][2 * q + 1][2], acc[pi][2 * q + 1][3]);
                *(u32x4*)(S + ((q * 4 + pi) * 16 + fr) * 32 + 8 * fq) = w; }
    }
}
__device__ __forceinline__ void phase_ssd_scan(const Params& p) {
    bf16_t* ST = (bf16_t*)(p.ws + OFF_ST); const float* CHDEC = (const float*)(p.ws + OFF_CHDEC);
    const int ntask = NBP * 16 * 2 * 1024;
    int tid_ = threadIdx.x; asm volatile("" : "+v"(tid_));
    for (int task = blockIdx.x * 512 + tid_; task < ntask; task += gridDim.x * 512) {
        const int e = task & 1023, dir = (task >> 10) & 1, h = (task >> 11) & 15, b = task >> 15;
        const int c0 = dir ? 31 : 0, cstep = dir ? -1 : 1;
        const size_t idx0 = (size_t)((b * 32 + c0) * 16 + h) * 2 + dir; const long istep = (long)cstep * 32;
        float run[8];
#pragma unroll
        for (int j = 0; j < 8; ++j) run[j] = 0.f;
#pragma unroll 1
        for (int i0 = 0; i0 < 32; i0 += 16) {
            u32x4 v[16]; float d[16];
#pragma unroll
            for (int i = 0; i < 16; ++i) { const size_t idx = idx0 + (long)(i0 + i) * istep; v[i] = *(const u32x4*)(ST + idx * 8192 + e * 8); d[i] = CHDEC[idx]; }
#pragma unroll
            for (int i = 0; i < 16; ++i) { const size_t idx = idx0 + (long)(i0 + i) * istep; float sv[8]; unpack8(v[i], sv);
                *(u32x4*)(ST + idx * 8192 + e * 8) = pack8(run);
#pragma unroll
                for (int j = 0; j < 8; ++j) run[j] = run[j] * d[i] + sv[j]; }
        }
    }
}
__device__ __forceinline__ void phase_ssd_out(const Params& p, int l, unsigned char* smem) {
    bf16_t* P = (bf16_t*)(p.ws + OFF_PROJ); const float* DT = (const float*)(p.ws + OFF_DT);
    const bf16_t* ST = (const bf16_t*)(p.ws + OFF_ST);
    const float* cw = p.in[I_CXW] + (size_t)l * 3 * 2048; const float* cb = p.in[I_CXB] + (size_t)l * 2048;
    const float* dsk = p.in[I_DSK] + l * 16; const float* nw = p.in[I_SNW] + l * 1024;
    bf16_t* XT = (bf16_t*)smem;
    bf16_t* CN = (bf16_t*)(smem + 256 * LSTR * 2);
    bf16_t* BN = (bf16_t*)(smem + 384 * LSTR * 2);
    float* sm_dt = (float*)(smem + 512 * LSTR * 2);
    float* sm_cs = sm_dt + 1024;
    float* sm_ss = sm_cs + 1024;
    for (int item = blockIdx.x; item < NBP * 128; item += gridDim.x) {
        int tid_ = threadIdx.x; asm volatile("" : "+v"(tid_));
        const int tid = tid_, wid = tid >> 6, lane = tid & 63, fr = lane & 15, fq = lane >> 4, hh = wid >> 1, lh = wid & 1;
        const int g = item & 3, c = (item >> 2) & 31, b = item >> 7;
        const int t0 = b * SEQ + c * 128, pos0 = c * 128, h = 4 * g + hh;
        __syncthreads();
        const bf16_t* Hf = ST + ((size_t)((b * 32 + c) * 16 + h) * 2 + 0) * 8192;
        bf16x8 hv[4][4];
        {
            float r0, r1; ssd_dt_load(DT, t0, g, wid, lane, r0, r1);
            ConvNat<128> cbn, ccn; ConvTr<256> cx;
            cbn.load(P, t0, pos0, PC_X + 1024 + 128 * g, tid); ccn.load(P, t0, pos0, PC_X + 1536 + 128 * g, tid); cx.load(P, t0, pos0, PC_X + 256 * g, tid);
            __builtin_amdgcn_sched_barrier(0);
            ssd_dt_scan(p, l, r0, r1, g, sm_dt, sm_cs, wid, lane);
            cbn.compute(cw, cb, 1024 + 128 * g, BN, tid);
            ccn.compute(cw, cb, 1536 + 128 * g, CN, tid);
            cx.compute(cw, cb, 256 * g, XT, tid);
        }
#pragma unroll
        for (int ks = 0; ks < 4; ++ks)
#pragma unroll
            for (int pt = 0; pt < 4; ++pt) hv[ks][pt] = *(const bf16x8*)(Hf + ((ks * 4 + pt) * 16 + fr) * 32 + 8 * fq);
        __syncthreads();
        {
            f32x4 cbacc[8];
#pragma unroll
            for (int st = 0; st < 8; ++st) cbacc[st] = (f32x4){0.f, 0.f, 0.f, 0.f};
#pragma unroll
            for (int ks = 0; ks < 4; ++ks) {
                const bf16x8 cf = *(const bf16x8*)(CN + (size_t)(16 * wid + fr) * LSTR + 32 * ks + 8 * fq);
#pragma unroll
                for (int st = 0; st < 8; ++st) { const bf16x8 bf = *(const bf16x8*)(BN + (size_t)(16 * st + fr) * LSTR + 32 * ks + 8 * fq);
                    cbacc[st] = __builtin_amdgcn_mfma_f32_16x16x32_bf16(bf, cf, cbacc[st], 0, 0, 0); }
            }
            __syncthreads();
#pragma unroll
            for (int st = 0; st < 8; ++st) { u32x2 w; w.x = pk2(cbacc[st][0], cbacc[st][1]); w.y = pk2(cbacc[st][2], cbacc[st][3]);
                *(u32x2*)(BN + (size_t)(16 * wid + fr) * LSTR + 16 * st + 4 * fq) = w; }
        }
        __syncthreads();
        const float* dtf = sm_dt + hh * 128; const float* dtb = sm_dt + (4 + hh) * 128; const float* acs = sm_cs + hh * 128; const float* rcs = sm_cs + (4 + hh) * 128;
        f32x4 acc[4][4];
#pragma unroll
        for (int dir = 0; dir < 2; ++dir) {
            const float* csd = dir ? rcs : acs;
            f32x4 acc2[4][4];
#pragma unroll
            for (int i = 0; i < 4; ++i)
#pragma unroll
                for (int j = 0; j < 4; ++j) acc2[i][j] = (f32x4){0.f, 0.f, 0.f, 0.f};
#pragma unroll
            for (int ks = 0; ks < 4; ++ks) {
                bf16x8 a[4];
#pragma unroll
                for (int lt = 0; lt < 4; ++lt) a[lt] = *(const bf16x8*)(CN + (size_t)(64 * lh + 16 * lt + fr) * LSTR + 32 * ks + 8 * fq);
#pragma unroll
                for (int lt = 0; lt < 4; ++lt)
#pragma unroll
                    for (int pt = 0; pt < 4; ++pt) acc2[lt][pt] = __builtin_amdgcn_mfma_f32_16x16x32_bf16(hv[ks][pt], a[lt], acc2[lt][pt], 0, 0, 0);
                if (dir == 0) {
#pragma unroll
                    for (int pt = 0; pt < 4; ++pt) hv[ks][pt] = *(const bf16x8*)(Hf + 8192 + ((ks * 4 + pt) * 16 + fr) * 32 + 8 * fq); }
                __builtin_amdgcn_sched_barrier(0);
            }
#pragma unroll
            for (int lt = 0; lt < 4; ++lt) { const float ev = __expf(csd[64 * lh + 16 * lt + fr]);
#pragma unroll
                for (int pt = 0; pt < 4; ++pt) acc[lt][pt] = dir ? acc[lt][pt] + acc2[lt][pt] * ev : acc2[lt][pt] * ev; }
        }
        u32x2 zr[4][4];
#pragma unroll
        for (int lt = 0; lt < 4; ++lt)
#pragma unroll
            for (int q = 0; q < 2; ++q) { const u32x4 zz = *(const u32x4*)(P + (size_t)(t0 + 64 * lh + 16 * lt + fr) * LDP + PC_Z + 256 * g + 64 * hh + 32 * q + 8 * fq);
                zr[lt][2 * q].x = zz.x; zr[lt][2 * q].y = zz.y; zr[lt][2 * q + 1].x = zz.z; zr[lt][2 * q + 1].y = zz.w; }
        const float dskip = dsk[h];
#pragma unroll 1
        for (int ks = 0; ks < 4; ++ks) {
            const int s0 = 32 * ks + 8 * fq;
            float as_[8], rs_[8], df_[8], db_[8];
            { const f32x4 t0_ = *(const f32x4*)(acs + s0), t1_ = *(const f32x4*)(acs + s0 + 4), u0_ = *(const f32x4*)(rcs + s0), u1_ = *(const f32x4*)(rcs + s0 + 4);
              const f32x4 v0_ = *(const f32x4*)(dtf + s0), v1_ = *(const f32x4*)(dtf + s0 + 4), x0_ = *(const f32x4*)(dtb + s0), x1_ = *(const f32x4*)(dtb + s0 + 4);
#pragma unroll
              for (int j = 0; j < 4; ++j) { as_[j] = t0_[j]; as_[4 + j] = t1_[j]; rs_[j] = u0_[j]; rs_[4 + j] = u1_[j]; df_[j] = v0_[j]; df_[4 + j] = v1_[j]; db_[j] = x0_[j]; db_[4 + j] = x1_[j]; } }
            bf16x8 bx[4];
#pragma unroll
            for (int pt = 0; pt < 4; ++pt) bx[pt] = *(const bf16x8*)(XT + (size_t)(64 * hh + chperm(pt, fr)) * LSTR + s0);
#pragma unroll
            for (int lt = 0; lt < 4; ++lt) {
                const int lrow = 64 * lh + 16 * lt + fr;
                const float al = acs[lrow], rl = rcs[lrow], dd = dtf[lrow] + dtb[lrow];
                float cbv[8]; unpack8(*(const u32x4*)(BN + (size_t)lrow * LSTR + s0), cbv);
#pragma unroll
                for (int j = 0; j < 8; ++j) { const int s = s0 + j; const bool fw = s < lrow;
                    const float d = fw ? al - as_[j] : rl - rs_[j]; float v = __expf(d) * (fw ? df_[j] : db_[j]); v = (s == lrow) ? dd : v; cbv[j] = cbv[j] * v + ((s == lrow) ? dskip : 0.f); }
                const u32x4 pk = pack8(cbv); const bf16x8 gfr = __builtin_bit_cast(bf16x8, pk);
#pragma unroll
                for (int pt = 0; pt < 4; ++pt) acc[lt][pt] = __builtin_amdgcn_mfma_f32_16x16x32_bf16(bx[pt], gfr, acc[lt][pt], 0, 0, 0);
                __builtin_amdgcn_sched_barrier(0);
            }
        }
#pragma unroll
        for (int lt = 0; lt < 4; ++lt) { float sq = 0.f;
#pragma unroll
            for (int pt = 0; pt < 4; ++pt) { const float z0 = bflo(zr[lt][pt].x), z1 = bfhi(zr[lt][pt].x), z2 = bflo(zr[lt][pt].y), z3 = bfhi(zr[lt][pt].y);
                f32x4 y = acc[lt][pt]; y[0] *= silu_f(z0); y[1] *= silu_f(z1); y[2] *= silu_f(z2); y[3] *= silu_f(z3); acc[lt][pt] = y;
                sq += (y[0] * y[0] + y[1] * y[1]) + (y[2] * y[2] + y[3] * y[3]); }
            sq += __shfl_xor(sq, 16); sq += __shfl_xor(sq, 32);
            if (fq == 0) sm_ss[(64 * lh + 16 * lt + fr) * 4 + hh] = sq; }
        __syncthreads();
        f32x4 nwv[4];
#pragma unroll
        for (int pt = 0; pt < 4; ++pt) nwv[pt] = *(const f32x4*)(nw + 256 * g + 64 * hh + 32 * (pt >> 1) + 8 * fq + 4 * (pt & 1));
#pragma unroll
        for (int lt = 0; lt < 4; ++lt) { const int lrow = 64 * lh + 16 * lt + fr; const f32x4 sv = *(const f32x4*)(sm_ss + lrow * 4);
            const float rs = rsqrtf(((sv[0] + sv[1]) + (sv[2] + sv[3])) * (1.0f / 256.0f) + EPS);
#pragma unroll
            for (int q = 0; q < 2; ++q) { const f32x4 y0 = acc[lt][2 * q] * rs * nwv[2 * q], y1 = acc[lt][2 * q + 1] * rs * nwv[2 * q + 1]; u32x4 w; w.x = pk2(y0[0], y0[1]); w.y = pk2(y0[2], y0[3]); w.z = pk2(y1[0], y1[1]); w.w = pk2(y1[2], y1[3]);
                *(u32x4*)(P + (size_t)(t0 + lrow) * LDP + PC_Z + 256 * g + 64 * hh + 32 * q + 8 * fq) = w; } }
    }
}

#define XB_TMO      128
#define XB_XCNT(j)  (256  + 64 * (j))
#define XB_XSUB(j)  (1280 + 64 * (j))
#define XB_XGEN(j)  (2304 + 64 * (j))
#define XB_TOP      3328
#define XB_TOPGEN   3392
#define XCD_BAR_WORDS 3456
#define XB_SPIN_CAP (1u << 20)
__device__ __forceinline__ unsigned xb_ld(unsigned* p)              { return __hip_atomic_load(p, __ATOMIC_RELAXED, __HIP_MEMORY_SCOPE_AGENT); }
__device__ __forceinline__ unsigned xb_add(unsigned* p, unsigned v) { return __hip_atomic_fetch_add(p, v, __ATOMIC_RELAXED, __HIP_MEMORY_SCOPE_AGENT); }
__device__ __forceinline__ unsigned xb_xcc_id() { return (unsigned)__builtin_amdgcn_s_getreg((3 << 11) | 20) & 0xFu; }
#define XB_SPIN(cond, bar) do { unsigned _sp = 0; while (cond) { __builtin_amdgcn_s_sleep(1); \
    if ((++_sp & 255u) == 0u) { if (xb_ld(&(bar)[XB_TMO])) break; if (_sp > XB_SPIN_CAP) { atomicAdd(&(bar)[XB_TMO], 1u); break; } } } } while (0)
struct XcdBarrier { unsigned* bar; unsigned x; volatile PG8_LAS unsigned* st; };
__device__ __forceinline__ XcdBarrier xcd_barrier_post(unsigned* bar, volatile PG8_LAS unsigned* st) {
    XcdBarrier b; b.bar = bar; b.x = xb_xcc_id(); b.st = st;
    if (threadIdx.x == 0) (void)xb_add(&bar[XB_XCNT(b.x)], 1u);
    return b;
}
__device__ __forceinline__ void xcd_barrier_complete(unsigned* bar, unsigned x, unsigned& nloc, unsigned& nx) {
    const unsigned G = gridDim.x * gridDim.y * gridDim.z;
    unsigned sum, cnt, mine, sp = 0u;
    for (;;) {
        sum = 0u; cnt = 0u; mine = 0u;
#pragma unroll
        for (unsigned j = 0; j < 16; ++j) { const unsigned c = xb_ld(&bar[XB_XCNT(j)]); sum += c; cnt += (c > 0u) ? 1u : 0u; mine = (j == x) ? c : mine; }
        if (sum == G) break;
        __builtin_amdgcn_s_sleep(1);
        if ((++sp & 255u) == 0u) { if (xb_ld(&bar[XB_TMO])) break; if (sp > XB_SPIN_CAP) { atomicAdd(&bar[XB_TMO], 1u); break; } }
    }
    nloc = mine > 0u ? mine : 1u; nx = cnt > 0u ? cnt : 1u;
}
__device__ __forceinline__ void xcd_barrier(const XcdBarrier& b) {
    asm volatile("s_waitcnt vmcnt(0)" ::: "memory");
    __syncthreads();
    if (threadIdx.x == 0) {
        unsigned* bar = b.bar;
        __builtin_amdgcn_s_waitcnt(0);
        unsigned nloc = b.st[0], nx = b.st[1];
        if (nloc == 0u) { xcd_barrier_complete(bar, b.x, nloc, nx); b.st[0] = nloc; b.st[1] = nx; }
        const unsigned old = xb_add(&bar[XB_XSUB(b.x)], 1u);
        const unsigned gen = old / nloc;
        if (old + 1u == (gen + 1u) * nloc) {
            __builtin_amdgcn_fence(__ATOMIC_RELEASE, "agent");
            asm volatile("s_waitcnt vmcnt(0)" ::: "memory");
            const unsigned og = xb_add(&bar[XB_TOP], 1u);
            const unsigned tg = og / nx;
            if (og + 1u == (tg + 1u) * nx) xb_add(&bar[XB_TOPGEN], 1u);
            else XB_SPIN(xb_ld(&bar[XB_TOPGEN]) == tg, bar);
            __builtin_amdgcn_fence(__ATOMIC_ACQUIRE, "agent");
            xb_add(&bar[XB_XGEN(b.x)], 1u);
            asm volatile("s_waitcnt vmcnt(0)" ::: "memory");
        } else {
            XB_SPIN(xb_ld(&bar[XB_XGEN(b.x)]) == gen, bar);
            __builtin_amdgcn_fence(__ATOMIC_ACQUIRE, "agent");
            asm volatile("s_waitcnt vmcnt(0)" ::: "memory");
        }
    }
    __syncthreads();
}

constexpr int PH_PER_HALF = 16, N_PHASES = NPART * PH_PER_HALF;
__global__ void __launch_bounds__(512, 2) mega(Params p0) {
    extern __shared__ __attribute__((aligned(16))) unsigned char smem[];
    cg::grid_group grid = cg::this_grid();
    volatile PG8_LAS unsigned* xst = (volatile PG8_LAS unsigned*)((PG8_LAS unsigned char*)smem + (LDS_BYTES - 16));
    if (threadIdx.x == 0) { xst[0] = 0u; xst[1] = 0u; }
    __syncthreads();
    const XcdBarrier xb = xcd_barrier_post((unsigned*)(p0.ws + OFF_BAR), xst);
    for (int ph = p0.ph_lo; ph < p0.ph_hi; ++ph) {
        const int hf = ph / PH_PER_HALF, lp = ph % PH_PER_HALF;
        if (hf >= 1 && lp == 0) continue;
        Params p = p0; asm volatile("" : "+s"(p.ws), "+s"(p.out));
        unsigned char* ws = p.ws;
        float* rowss = (float*)(ws + OFF_ROWSS) + (size_t)hf * 5 * TH * 16;
        bf16_t* HB = (bf16_t*)(ws + OFF_HB);
        if (lp == 0) {
#ifdef REP0
            for (int rep = 0; rep < 2; ++rep) {
#endif
            if (hf == 0) phase_weights(p, (float*)smem);
            phase_prep(p, hf);
#ifdef REP0
            }
#endif
        } else if (lp == 15) {
            phase_final(p, hf);
            if (hf + 1 < NPART) phase_prep(p, hf + 1);
        } else {
            const int l = (lp - 1) / 7, k = (lp - 1) % 7;
#ifdef REPK
            for (int rep = 0; rep < ((REPK) ? 2 : 1); ++rep) {
#endif
            unsigned char* wb = ws + (size_t)l * WL_B;
            float* hout = p.out + (size_t)hf * TH * DM;
            if (k == 0) {
                pg8::Gemm g{HB, (const bf16_t*)wb, TH, NIN, DM}; pg8::StaticOrder S; S.init(TH, NIN, gridDim.x, blockIdx.x);
                EpiIn E{(bf16_t*)(ws + OFF_PROJ), rowss + (size_t)(2 * l) * TH * 16, (float*)(smem + 131072), (float*)(smem + 132096), p.in[I_CXW] + (size_t)l * 3 * 2048, p.in[I_CXB] + (size_t)l * 2048,
                        (float*)(ws + OFF_XEDGER), (float*)(ws + OFF_XEDGEP), -1};
                phase_dt(p, l, rowss + (size_t)(2 * l) * TH * 16);
                pg8::gemm_phase<EpiIn, pg8::StaticOrder, true, true>((PG8_LAS unsigned char*)smem, g, S, E);
            } else if (k == 1) {
#ifndef NO_STATES
                phase_ssd_states(p, l, smem);
#endif
            } else if (k == 2) {
                phase_ssd_scan(p);
            } else if (k == 3) {
#ifndef NO_OUT
                phase_ssd_out(p, l, smem);
#endif
                phase_shortconv(p, l);
            } else if (k == 4) {
                pg8::Gemm g{(const bf16_t*)(ws + OFF_PROJ), (const bf16_t*)(wb + WT_IN_B), TH, DM, DMIX, LDP}; pg8::StaticOrder S; S.init(TH, DM, gridDim.x, blockIdx.x);
                EpiRes E{HB, rowss + (size_t)(2 * l + 1) * TH * 16};
                pg8::gemm_phase<EpiRes, pg8::StaticOrder, true, true>((PG8_LAS unsigned char*)smem, g, S, E);
#ifdef REP4
                if (l == 0) pg8::gemm_phase<EpiRes, pg8::StaticOrder, true, true>((PG8_LAS unsigned char*)smem, g, S, E);
#endif
            } else if (k == 5) {
                pg8::Gemm g{HB, (const bf16_t*)(wb + WT_IN_B + WT_OUT_B), TH, NUP, DM}; pg8::StaticOrder S; S.init(TH, NUP, gridDim.x, blockIdx.x);
                EpiAct E{(bf16_t*)(ws + OFF_ACT), rowss + (size_t)(2 * l + 1) * TH * 16, (float*)(smem + 131072), (float*)(smem + 132096), p.in[I_FCW] + (size_t)l * 3 * NUP, p.in[I_FCB] + (size_t)l * NUP,
                         (float*)(ws + OFF_EDGER), (float*)(ws + OFF_EDGEP), -1};
                pg8::gemm_phase<EpiAct, pg8::StaticOrder, true, true>((PG8_LAS unsigned char*)smem, g, S, E);
            } else {
                pg8::Gemm g{(const bf16_t*)(ws + OFF_ACT), (const bf16_t*)(wb + WT_IN_B + WT_OUT_B + WT_UP_B), TH, DM, DFF}; pg8::StaticOrder S; S.init(TH, DM, gridDim.x, blockIdx.x);
                {
                    pg8::Unit uu; int last_pm = -1;
                    for (int i = 0; S.next(i, uu); ++i) if (uu.pm != last_pm) { last_pm = uu.pm; edgefix_panel(p, l, uu.pm); }
                    asm volatile("s_waitcnt vmcnt(0)" ::: "memory"); __syncthreads();
                }
                EpiRes E{HB, rowss + (size_t)(2 * l + 2) * TH * 16};
                pg8::gemm_phase<EpiRes, pg8::StaticOrder, true, true>((PG8_LAS unsigned char*)smem, g, S, E);
            }
#ifdef REPK
            }
#endif
        }
        if (ph + 1 < p0.ph_hi) { if (ph == 0) grid.sync(); else xcd_barrier(xb); }
    }
}


#ifndef MULTI_LAUNCH
#define MULTI_LAUNCH 0
#endif
extern "C" void kernel_launch(void* const* d_in, const int* in_sizes, int n_in, void* d_out, int out_size, void* d_ws, size_t ws_size, hipStream_t stream) {
    static int grid = 0;
    if (grid == 0) {
        if (n_in != 19 || ws_size < WS_NEED) { fprintf(stderr, "kernel_launch: unexpected n_in %d / ws_size %zu (need %zu)\n", n_in, ws_size, (size_t)WS_NEED); grid = -1; return; }
        int dev = 0, cus = 0, per_cu = 0;
        hipGetDevice(&dev); hipDeviceGetAttribute(&cus, hipDeviceAttributeMultiprocessorCount, dev);
        if (hipFuncSetAttribute((const void*)mega, hipFuncAttributeMaxDynamicSharedMemorySize, LDS_BYTES) != hipSuccess) { fprintf(stderr, "kernel_launch: hipFuncSetAttribute failed\n"); grid = -1; return; }
        if (hipOccupancyMaxActiveBlocksPerMultiprocessor(&per_cu, (const void*)mega, 512, LDS_BYTES) != hipSuccess || per_cu < 1) { fprintf(stderr, "kernel_launch: occupancy query says %d\n", per_cu); per_cu = 1; }
        (void)hipGetLastError();
        grid = cus * 1;
        fprintf(stderr, "kernel_launch: grid %d (cus %d, per_cu %d), ws %zu\n", grid, cus, per_cu, ws_size);
    }
    if (grid < 0) return;
#ifdef DBG_MEMSET
    (void)hipMemsetAsync(d_ws, 0, WS_END, stream); (void)hipMemsetAsync(d_out, 0, (size_t)out_size * 4, stream);
#endif
    (void)hipMemsetAsync((unsigned char*)d_ws + OFF_BAR, 0, 16384, stream);
    Params p{};
    for (int i = 0; i < 19; ++i) p.in[i] = (const float*)d_in[i];
    p.out = (float*)d_out; p.ws = (unsigned char*)d_ws;
#if MULTI_LAUNCH
    for (int ph = 0; ph < N_PHASES; ++ph) { p.ph_lo = ph; p.ph_hi = ph + 1; hipLaunchKernelGGL(mega, dim3(grid), dim3(512), LDS_BYTES, stream, p); }
#else
    p.ph_lo = 0; p.ph_hi = N_PHASES;
    void* args[] = {&p};
    hipError_t e = hipLaunchCooperativeKernel((const void*)mega, dim3(grid), dim3(512), args, LDS_BYTES, stream);
    if (e != hipSuccess) fprintf(stderr, "cooperative launch failed: %s (grid %d)\n", hipGetErrorString(e), grid);
#endif
}
```

```cpp
#include <hip/hip_runtime.h>
#include <hip/hip_cooperative_groups.h>
#include <cstdio>
#include <type_traits>
namespace cg = cooperative_groups;
namespace pg8 {
#define PG8_LAS __attribute__((address_space(3)))
typedef unsigned short bf16_t;
typedef short bf16x8 __attribute__((ext_vector_type(8)));
typedef float f32x4 __attribute__((ext_vector_type(4)));
typedef unsigned u32x4 __attribute__((ext_vector_type(4)));
constexpr int BM = 256, BK = 64, HALF = 128, HTB = HALF * BK * 2  , STAGE_BYTES = 8 * HTB, NXCD = 8, WGM = 8;

__host__ __device__ __forceinline__ int lds_byte(int r, int c) { const int st = (r >> 4) * 2 + (c >> 5), rr = r & 15, cc = c & 31, ob = rr * 64 + cc * 2; return st * 1024 + (ob ^ (((ob >> 9) & 1) << 5)); }
__host__ __device__ __forceinline__ void stage_rc(int b, int& R, int& C) { const int st = b / 1024, sb = b % 1024, swz = sb ^ (((sb >> 9) & 1) << 5); R = (st >> 1) * 16 + swz / 64; C = (st & 1) * 32 + (swz % 64) / 2; }
__host__ __device__ __forceinline__ int perm32(int rho) { const int n = rho >> 4, i = rho & 15; return 8 * (i >> 2) + 4 * n + (i & 3); }

struct Unit { int pm, pn; };
struct Gemm { const bf16_t* A; const bf16_t* Bt; int M, N, K; int lda = 0; };
struct StaticOrder {
    int nM, nN, nwg, G, c;
    __host__ __device__ void init(int M, int N, int G_, int c_) { nM = M / BM; nN = N / BM; nwg = nM * nN; G = G_; c = c_; }
    __host__ __device__ bool next(int i, Unit& u) const {
        const long L = (long)i * G + c; if (L >= nwg) return false;
        int wgid = (int)L; { const int q = nwg / NXCD, r = nwg % NXCD, xcd = wgid % NXCD, off = wgid / NXCD; wgid = (xcd < r ? xcd * (q + 1) : r * (q + 1) + (xcd - r) * q) + off; }
        const int nig = WGM * nN, gid = wgid / nig, fm = gid * WGM, gsz = (nM - fm) < WGM ? (nM - fm) : WGM;
        u.pm = fm + ((wgid % nig) % gsz); u.pn = (wgid % nig) / gsz; return true;
    }
    __device__ __forceinline__ void a_ready(const Unit&) const {}
    __device__ __forceinline__ void done(const Unit&) const {}
};
__device__ __forceinline__ unsigned cvt_pk_bf16(float lo, float hi) { unsigned r; asm volatile("v_cvt_pk_bf16_f32 %0, %1, %2" : "=v"(r) : "v"(lo), "v"(hi)); return r; }
template <class Epi, class Sched, bool ALIGN_EPI = false, bool SP2 = false>
__device__ __forceinline__ void gemm_phase(PG8_LAS unsigned char* lds, const Gemm g, const Sched& S, const Epi& E) {
    int tid_ = threadIdx.x; asm volatile("" : "+v"(tid_));
    const int tid = tid_, wid = __builtin_amdgcn_readfirstlane(tid >> 6), lane = tid & 63, wr = wid >> 2, wc = wid & 3, fr = lane & 15, fq = lane >> 4;
    const int K = g.K, nt = K / BK, LDA = g.lda ? g.lda : g.K;
    unsigned voffA[2], voffB[2];
#pragma unroll
    for (int i = 0; i < 2; ++i) { int R, C; stage_rc(tid * 16 + i * 8192, R, C); const int Rb = Epi::PERM ? ((R & ~31) + perm32(R & 31)) : R;
        voffA[i] = (unsigned)(R * LDA + C) * 2u; voffB[i] = (unsigned)(Rb * K + C) * 2u; }
    const size_t kstep = (size_t)(BK * 2);
    const size_t hstep = (size_t)HALF * K * 2;
    const size_t tstep = 2 * hstep;
    const size_t hstepA = (size_t)HALF * LDA * 2, tstepA = 2 * hstepA;
    const unsigned ldsw = (unsigned)wid * 1024u;
    const int aoff = lds_byte(wr * 64 + fr, fq * 8), boff = lds_byte(wc * 32 + fr, fq * 8);
#define PG8_SA(b, h) (((b) * 2 + (h)) * HTB)
#define PG8_SB(b, h) ((4 + (b) * 2 + (h)) * HTB)
#define PG8_STAGE(bufoff, gbase, voff) do { _Pragma("unroll") for (int _i = 0; _i < 2; ++_i) \
        __builtin_amdgcn_global_load_lds((const unsigned*)((const char*)(gbase) + (voff)[_i]), (PG8_LAS unsigned*)(lds + (bufoff) + ldsw + _i * 8192), 16, 0, 0); } while (0)
#define PG8_LDA(dst, b, h) do { _Pragma("unroll") for (int m = 0; m < 4; ++m) _Pragma("unroll") for (int k = 0; k < 2; ++k) dst[m][k] = *(const PG8_LAS bf16x8*)(lds + PG8_SA(b, h) + aoff + m * 2048 + k * 1024); } while (0)
#define PG8_LDB(dst, b, h) do { _Pragma("unroll") for (int n = 0; n < 2; ++n) _Pragma("unroll") for (int k = 0; k < 2; ++k) dst[n][k] = *(const PG8_LAS bf16x8*)(lds + PG8_SB(b, h) + boff + n * 2048 + k * 1024); } while (0)
#define PG8_MMA(ai, bj, At, Bt) do { __builtin_amdgcn_s_setprio(1); _Pragma("unroll") for (int m = 0; m < 4; ++m) _Pragma("unroll") for (int n = 0; n < 2; ++n) _Pragma("unroll") for (int k = 0; k < 2; ++k) \
        acc[ai][bj][m][n] = __builtin_amdgcn_mfma_f32_16x16x32_bf16(Bt[n][k], At[m][k], acc[ai][bj][m][n], 0, 0, 0); __builtin_amdgcn_s_setprio(0); } while (0)
#define PG8_WAIT_V(n) asm volatile("s_waitcnt vmcnt(" #n ")" ::: "memory")
#define PG8_WAIT_L(n) asm volatile("s_waitcnt lgkmcnt(" #n ")" ::: "memory")
#define PG8_BAR __builtin_amdgcn_s_barrier()
#define PG8_SCHED __builtin_amdgcn_sched_barrier(0)
    Unit cur, nxt; int ui = 0;
    if (!S.next(0, cur)) return;
    f32x4 acc[2][2][4][2];
#pragma unroll
    for (int a = 0; a < 2; ++a)
#pragma unroll
        for (int b = 0; b < 2; ++b)
#pragma unroll
            for (int m = 0; m < 4; ++m)
#pragma unroll
                for (int n = 0; n < 2; ++n) acc[a][b][m][n] = (f32x4){0.f, 0.f, 0.f, 0.f};
    bf16x8 At[4][2], B0[2][2], B1[2][2];
    const char* cA = (const char*)g.A + (size_t)cur.pm * tstepA; const char* cB = (const char*)g.Bt + (size_t)cur.pn * tstep;
    S.a_ready(cur);
    if constexpr (SP2) {
        PG8_STAGE(PG8_SB(0, 0), cB, voffB); PG8_STAGE(PG8_SB(0, 1), cB + hstep, voffB); PG8_STAGE(PG8_SA(0, 0), cA, voffA); PG8_STAGE(PG8_SA(0, 1), cA + hstepA, voffA);
        if (wr == 1) PG8_BAR;
        PG8_WAIT_V(2); PG8_BAR;
        PG8_STAGE(PG8_SB(1, 0), cB + kstep, voffB); PG8_STAGE(PG8_SA(1, 0), cA + kstep, voffA); PG8_STAGE(PG8_SB(1, 1), cB + hstep + kstep, voffB);
        PG8_WAIT_V(6); PG8_BAR;
    } else {
        PG8_STAGE(PG8_SB(0, 0), cB, voffB); PG8_STAGE(PG8_SA(0, 0), cA, voffA); PG8_STAGE(PG8_SB(0, 1), cB + hstep, voffB); PG8_STAGE(PG8_SA(0, 1), cA + hstepA, voffA);
        if (wr == 1) PG8_BAR;
        PG8_WAIT_V(4); PG8_BAR;
        PG8_STAGE(PG8_SB(1, 0), cB + kstep, voffB); PG8_STAGE(PG8_SA(1, 0), cA + kstep, voffA); PG8_STAGE(PG8_SB(1, 1), cB + hstep + kstep, voffB);
        PG8_WAIT_V(6); PG8_BAR;
    }
    for (;;) {
        const bool has_next = S.next(ui + 1, nxt);
        const char* nA = has_next ? (const char*)g.A + (size_t)nxt.pm * tstepA : cA; const char* nB = has_next ? (const char*)g.Bt + (size_t)nxt.pn * tstep : cB;
        for (int t = 0; t < nt; t += 2) {
            const bool last = (t == nt - 2);
            const char* a1 = cA + (size_t)(t + 1) * kstep;
            const char* a2 = last ? nA : cA + (size_t)(t + 2) * kstep; const char* b2 = last ? nB : cB + (size_t)(t + 2) * kstep;
            const char* a3 = a2 + kstep; const char* b3 = b2 + kstep;
            if (last && has_next) S.a_ready(nxt);
            if constexpr (SP2) {
            PG8_LDB(B0, 0, 0); PG8_LDB(B1, 0, 1); PG8_SCHED; PG8_LDA(At, 0, 0); PG8_STAGE(PG8_SA(1, 1), a1 + hstepA, voffA);
            PG8_WAIT_V(8); PG8_WAIT_L(0); PG8_BAR; PG8_MMA(0, 0, At, B0); PG8_MMA(0, 1, At, B1); PG8_BAR; PG8_SCHED;
            PG8_LDA(At, 0, 1); PG8_STAGE(PG8_SB(0, 0), b2, voffB); PG8_STAGE(PG8_SB(0, 1), b2 + hstep, voffB); PG8_STAGE(PG8_SA(0, 0), a2, voffA);
            PG8_WAIT_V(8); PG8_WAIT_L(0); PG8_BAR; PG8_MMA(1, 0, At, B0); PG8_MMA(1, 1, At, B1); PG8_BAR; PG8_SCHED;
            PG8_LDB(B0, 1, 0); PG8_LDB(B1, 1, 1); PG8_SCHED; PG8_LDA(At, 1, 0); PG8_STAGE(PG8_SA(0, 1), a2 + hstepA, voffA);
            PG8_WAIT_V(8); PG8_WAIT_L(0); PG8_BAR; PG8_MMA(0, 0, At, B0); PG8_MMA(0, 1, At, B1); PG8_BAR; PG8_SCHED;
            PG8_LDA(At, 1, 1); PG8_STAGE(PG8_SB(1, 0), b3, voffB); PG8_STAGE(PG8_SB(1, 1), b3 + hstep, voffB); PG8_STAGE(PG8_SA(1, 0), a3, voffA);
            PG8_WAIT_V(8); PG8_WAIT_L(0); PG8_BAR; PG8_MMA(1, 0, At, B0); PG8_MMA(1, 1, At, B1); PG8_BAR; PG8_SCHED;
            } else {
            PG8_LDB(B0, 0, 0); PG8_SCHED; PG8_LDA(At, 0, 0); PG8_STAGE(PG8_SA(1, 1), a1 + hstepA, voffA);
            PG8_WAIT_L(8); PG8_BAR; PG8_WAIT_L(0); PG8_MMA(0, 0, At, B0); PG8_BAR; PG8_SCHED;
            PG8_LDB(B1, 0, 1); PG8_STAGE(PG8_SB(0, 0), b2, voffB);
            PG8_BAR; PG8_WAIT_L(0); PG8_MMA(0, 1, At, B1); PG8_BAR;
            PG8_LDA(At, 0, 1); PG8_STAGE(PG8_SA(0, 0), a2, voffA);
            PG8_BAR; PG8_WAIT_L(0); PG8_MMA(1, 0, At, B0); PG8_BAR; PG8_SCHED;
            PG8_STAGE(PG8_SB(0, 1), b2 + hstep, voffB);
            PG8_WAIT_V(6); PG8_BAR; PG8_MMA(1, 1, At, B1); PG8_BAR;
            PG8_LDB(B0, 1, 0); PG8_SCHED; PG8_LDA(At, 1, 0); PG8_STAGE(PG8_SA(0, 1), a2 + hstepA, voffA);
            PG8_WAIT_L(8); PG8_BAR; PG8_WAIT_L(0); PG8_MMA(0, 0, At, B0); PG8_BAR; PG8_SCHED;
            PG8_LDB(B1, 1, 1); PG8_STAGE(PG8_SB(1, 0), b3, voffB);
            PG8_BAR; PG8_WAIT_L(0); PG8_MMA(0, 1, At, B1); PG8_BAR;
            PG8_LDA(At, 1, 1); PG8_STAGE(PG8_SA(1, 0), a3, voffA);
            PG8_BAR; PG8_WAIT_L(0); PG8_MMA(1, 0, At, B0); PG8_BAR; PG8_SCHED;
            PG8_STAGE(PG8_SB(1, 1), b3 + hstep, voffB);
            PG8_WAIT_V(6); PG8_BAR; PG8_MMA(1, 1, At, B1); PG8_BAR;
            }
        }
        if constexpr (ALIGN_EPI) { if (wr == 0) PG8_BAR; }
        if constexpr (!Epi::AFTER_DRAIN) { E(acc, cur, wr, wc, fr, fq); S.done(cur); }
        if (!has_next) break;
#pragma unroll
        for (int a = 0; a < 2; ++a)
#pragma unroll
            for (int b = 0; b < 2; ++b)
#pragma unroll
                for (int m = 0; m < 4; ++m)
#pragma unroll
                    for (int n = 0; n < 2; ++n) acc[a][b][m][n] = (f32x4){0.f, 0.f, 0.f, 0.f};
        cur = nxt; cA = nA; cB = nB; ++ui;
        if constexpr (ALIGN_EPI) { if (wr == 1) PG8_BAR; }
    }
    PG8_WAIT_V(0);
    if constexpr (!ALIGN_EPI) { if (wr == 0) PG8_BAR; }
    PG8_BAR;
    if constexpr (Epi::AFTER_DRAIN) { E.fused(acc, cur, wr, wc, fr, fq, lds, wid, lane); S.done(cur); }
#undef PG8_SA
#undef PG8_SB
#undef PG8_STAGE
#undef PG8_LDA
#undef PG8_LDB
#undef PG8_MMA
#undef PG8_WAIT_V
#undef PG8_WAIT_L
#undef PG8_BAR
#undef PG8_SCHED
}
}

using pg8::bf16_t; using pg8::bf16x8; using pg8::f32x4; using pg8::u32x4; using pg8::Unit;
typedef unsigned u32x2 __attribute__((ext_vector_type(2)));
#ifndef NPART
#define NPART 2
#endif
constexpr int TH = 65536 / NPART;
constexpr int NBP = TH / 4096;
constexpr int SEQ = 4096, DM = 1024, NIN = 6144, LDP = 5120, DFF = 2816, NUP = 5632, DMIX = 2048;
constexpr int LSTR = 136;
constexpr float EPS = 1e-5f;
constexpr int PC_Z = 0, PC_SB = 1024, PC_X = 2048, PC_P = 4096;
constexpr int LDS_BYTES = 152 * 1024;
constexpr size_t WT_IN_B = (size_t)NIN * DM * 2, WT_OUT_B = (size_t)DM * DMIX * 2, WT_UP_B = (size_t)NUP * DM * 2, WT_DN_B = (size_t)DM * DFF * 2;
constexpr size_t WL_B = WT_IN_B + WT_OUT_B + WT_UP_B + WT_DN_B;
constexpr size_t OFF_ROWSS = 2 * WL_B;
constexpr size_t OFF_CHDEC = OFF_ROWSS + (size_t)NPART * 5 * TH * 16 * 4;
constexpr size_t OFF_PROJ = OFF_CHDEC + (size_t)NBP * 32 * 16 * 2 * 4;
constexpr size_t OFF_DT = OFF_PROJ + (size_t)TH * LDP * 2;
constexpr size_t OFF_ST = OFF_DT + (size_t)TH * 32 * 4;
constexpr size_t OFF_HB = OFF_ST + (size_t)NBP * 32 * 16 * 2 * 8192 * 2;
constexpr size_t WS_END = OFF_HB + (size_t)TH * DM * 2;
constexpr size_t OFF_BAR = WS_END;
constexpr size_t OFF_EDGER = OFF_BAR + 16384;
constexpr size_t OFF_EDGEP = OFF_EDGER + (size_t)(TH / 256) * 2 * NUP * 4;
constexpr size_t OFF_WDT = OFF_EDGEP + (size_t)(TH / 256) * 2 * NUP * 4;
constexpr size_t OFF_XEDGER = OFF_WDT + (size_t)2 * 32 * DM * 2;
constexpr size_t OFF_XEDGEP = OFF_XEDGER + (size_t)(TH / 256) * 2 * 2048 * 4;
constexpr size_t WS_NEED = OFF_XEDGEP + (size_t)(TH / 256) * 2 * 2048 * 4;
constexpr size_t OFF_ACT = OFF_PROJ;
static_assert((size_t)TH * DFF * 2 <= (size_t)TH * LDP * 2 && (size_t)TH * DM * 2 <= (size_t)NBP * 32 * 16 * 2 * 8192 * 2, "overlay sizes");
static_assert(OFF_HB % 256 == 0 && OFF_PROJ % 256 == 0 && OFF_ST % 256 == 0 && TH % 4096 == 0, "align");

struct Params {
    const float* in[19];
    float* out;
    unsigned char* ws;
    int ph_lo, ph_hi;
};
enum { I_X = 0, I_WIN, I_CXW, I_CXB, I_DTBF, I_DTBB, I_ALF, I_ALB, I_DSK, I_SNW, I_SCW, I_WOUT, I_N1, I_N2, I_WUP, I_FCW, I_FCB, I_WDN, I_FNW };

typedef __bf16 bf16x2_t __attribute__((ext_vector_type(2)));
typedef float f32x2_t __attribute__((ext_vector_type(2)));
__device__ __forceinline__ unsigned pk2(float lo, float hi) { const f32x2_t v = {lo, hi}; const bf16x2_t b = __builtin_convertvector(v, bf16x2_t); return __builtin_bit_cast(unsigned, b); }
__device__ __forceinline__ float bflo(unsigned w) { return __uint_as_float(w << 16); }
__device__ __forceinline__ float bfhi(unsigned w) { return __uint_as_float(w & 0xffff0000u); }
__device__ __forceinline__ float bf2f(bf16_t b) { return __uint_as_float(((unsigned)b) << 16); }
__device__ __forceinline__ float silu_f(float v) { return v * __builtin_amdgcn_rcpf(1.0f + __expf(-v)); }
__device__ __forceinline__ float softplus_f(float v) { return v > 20.0f ? v : log1pf(__expf(v)); }
__device__ __forceinline__ void unpack8(const u32x4 w, float (&f)[8]) { f[0] = bflo(w.x); f[1] = bfhi(w.x); f[2] = bflo(w.y); f[3] = bfhi(w.y); f[4] = bflo(w.z); f[5] = bfhi(w.z); f[6] = bflo(w.w); f[7] = bfhi(w.w); }
__device__ __forceinline__ u32x4 pack8(const float (&f)[8]) { u32x4 w; w.x = pk2(f[0], f[1]); w.y = pk2(f[2], f[3]); w.z = pk2(f[4], f[5]); w.w = pk2(f[6], f[7]); return w; }

__device__ __forceinline__ float row_rs(const float* rowss, int row) {
    const f32x4 a = *(const f32x4*)(rowss + (size_t)row * 16), b = *(const f32x4*)(rowss + (size_t)row * 16 + 4), c = *(const f32x4*)(rowss + (size_t)row * 16 + 8), d = *(const f32x4*)(rowss + (size_t)row * 16 + 12);
    const float s = (((a[0] + a[1]) + (a[2] + a[3])) + ((b[0] + b[1]) + (b[2] + b[3]))) + (((c[0] + c[1]) + (c[2] + c[3])) + ((d[0] + d[1]) + (d[2] + d[3])));
    return rsqrtf(s * (1.0f / 1024.0f) + EPS);
}
__device__ __forceinline__ void panel_rs(const float* rowss, int pm, int& cached_pm, float* rs_lds) {
    if (pm != cached_pm) {
        cached_pm = pm;
        int tid_ = threadIdx.x; asm volatile("" : "+v"(tid_));
        __syncthreads();
        if (tid_ < 256) rs_lds[tid_] = row_rs(rowss, pm * 256 + tid_);
        __syncthreads();
    }
}
struct EpiUp {
    static constexpr bool PERM = true, AFTER_DRAIN = false;
    bf16_t* U; const float* rowss; float* rs_lds; mutable int cached_pm;
    __device__ __forceinline__ void operator()(const f32x4 (&acc)[2][2][4][2], const Unit& u, int wr, int wc, int fr, int fq) const {
        const int row0 = u.pm * 256 + wr * 64 + fr;
        panel_rs(rowss, u.pm, cached_pm, rs_lds);
#pragma unroll
        for (int ai = 0; ai < 2; ++ai)
#pragma unroll
            for (int m = 0; m < 4; ++m) {
                const int row = row0 + ai * 128 + m * 16;
                const float rs = rs_lds[row & 255];
#pragma unroll
                for (int bj = 0; bj < 2; ++bj) { const f32x4 v0 = acc[ai][bj][m][0] * rs, v1 = acc[ai][bj][m][1] * rs; u32x4 w; w.x = pk2(v0[0], v0[1]); w.y = pk2(v0[2], v0[3]); w.z = pk2(v1[0], v1[1]); w.w = pk2(v1[2], v1[3]);
                    *(u32x4*)(U + (size_t)row * NUP + u.pn * 256 + bj * 128 + wc * 32 + 8 * fq) = w; }
            }
    }
};
struct EpiRes {
    static constexpr bool PERM = true, AFTER_DRAIN = false;
    bf16_t* HB; float* rowss_next;
    __device__ __forceinline__ void operator()(const f32x4 (&acc)[2][2][4][2], const Unit& u, int wr, int wc, int fr, int fq) const {
        const int row0 = u.pm * 256 + wr * 64 + fr, col0 = u.pn * 256 + wc * 32 + 8 * fq;
#pragma unroll
        for (int ai = 0; ai < 2; ++ai)
#pragma unroll
            for (int m = 0; m < 4; ++m) {
                const int row = row0 + ai * 128 + m * 16; float ss = 0.f;
#pragma unroll
                for (int bj = 0; bj < 2; ++bj) { const size_t off = (size_t)row * DM + col0 + bj * 128;
                    const u32x4 hb = *(const u32x4*)(HB + off);
                    f32x4 o0 = acc[ai][bj][m][0], o1 = acc[ai][bj][m][1];
                    o0[0] += bflo(hb.x); o0[1] += bfhi(hb.x); o0[2] += bflo(hb.y); o0[3] += bfhi(hb.y); o1[0] += bflo(hb.z); o1[1] += bfhi(hb.z); o1[2] += bflo(hb.w); o1[3] += bfhi(hb.w);
                    u32x4 w; w.x = pk2(o0[0], o0[1]); w.y = pk2(o0[2], o0[3]); w.z = pk2(o1[0], o1[1]); w.w = pk2(o1[2], o1[3]); *(u32x4*)(HB + off) = w;
                    ss += ((o0[0] * o0[0] + o0[1] * o0[1]) + (o0[2] * o0[2] + o0[3] * o0[3])) + ((o1[0] * o1[0] + o1[1] * o1[1]) + (o1[2] * o1[2] + o1[3] * o1[3])); }
                ss += __shfl_xor(ss, 16); ss += __shfl_xor(ss, 32);
                if (fq == 0) rowss_next[(size_t)row * 16 + u.pn * 4 + wc] = ss;
            }
    }
};


__device__ __forceinline__ float dpp_shr1(float old, float src) { return __builtin_bit_cast(float, __builtin_amdgcn_update_dpp(__builtin_bit_cast(int, old), __builtin_bit_cast(int, src), 0x111, 0xf, 0xf, false)); }
__device__ __forceinline__ float dpp_shl1(float old, float src) { return __builtin_bit_cast(float, __builtin_amdgcn_update_dpp(__builtin_bit_cast(int, old), __builtin_bit_cast(int, src), 0x101, 0xf, 0xf, false)); }
__device__ __forceinline__ float dpp_ror1(float src) { return __builtin_bit_cast(float, __builtin_amdgcn_update_dpp(0, __builtin_bit_cast(int, src), 0x121, 0xf, 0xf, false)); }
__device__ __forceinline__ float dpp_rol1(float src) { return __builtin_bit_cast(float, __builtin_amdgcn_update_dpp(0, __builtin_bit_cast(int, src), 0x12F, 0xf, 0xf, false)); }
struct EpiIn {
    static constexpr bool PERM = true, AFTER_DRAIN = false;
    bf16_t* P; const float* rowss; float* rs_lds; float* xch; const float* cxw; const float* cxb; float* XEDGER; float* XEDGEP; mutable int cached_pm;
    __device__ __forceinline__ void operator()(const f32x4 (&acc_)[2][2][4][2], const Unit& u, int wr, int wc, int fr_, int fq_) const {
        f32x4 (&acc)[2][2][4][2] = const_cast<f32x4 (&)[2][2][4][2]>(acc_);
        int fr = fr_, fq = fq_; asm volatile("" : "+v"(fr), "+v"(fq));
        const int row0 = u.pm * 256 + wr * 64 + fr; const int pn = u.pn;
        panel_rs(rowss, u.pm, cached_pm, rs_lds);
        if (pn >= 4 && pn < 12) {
#pragma unroll
            for (int ai = 0; ai < 2; ++ai)
#pragma unroll
                for (int m = 0; m < 4; ++m) { const float rs = rs_lds[ai * 128 + wr * 64 + m * 16 + fr];
#pragma unroll
                    for (int bj = 0; bj < 2; ++bj)
#pragma unroll
                        for (int n = 0; n < 2; ++n) acc[ai][bj][m][n] *= rs; }
#pragma unroll
            for (int ai = 0; ai < 2; ++ai) { const int seg = 2 * ai + wr;
                if (fr == 0) {
#pragma unroll
                    for (int bj = 0; bj < 2; ++bj)
#pragma unroll
                        for (int n = 0; n < 2; ++n) *(f32x4*)(xch + (((seg * 2 + 0) * 4 + wc) * 4 + fq) * 16 + bj * 8 + n * 4) = acc[ai][bj][0][n]; }
                if (fr == 15) {
#pragma unroll
                    for (int bj = 0; bj < 2; ++bj)
#pragma unroll
                        for (int n = 0; n < 2; ++n) *(f32x4*)(xch + (((seg * 2 + 1) * 4 + wc) * 4 + fq) * 16 + bj * 8 + n * 4) = acc[ai][bj][3][n]; } }
            __syncthreads();
            auto body = [&](auto BJ_, auto AI_) {
                constexpr int bj = decltype(BJ_)::value, ai = decltype(AI_)::value;
                const int ch = (pn - 4) * 256 + bj * 128 + wc * 32 + 8 * fq, seg = 2 * ai + wr;
                f32x4 w0[2], w1[2], w2[2], bb[2];
#pragma unroll
                for (int n = 0; n < 2; ++n) { w0[n] = *(const f32x4*)(cxw + ch + 4 * n); w1[n] = *(const f32x4*)(cxw + 2048 + ch + 4 * n); w2[n] = *(const f32x4*)(cxw + 4096 + ch + 4 * n); bb[n] = *(const f32x4*)(cxb + ch + 4 * n); }
#pragma unroll
                for (int m = 0; m < 4; ++m) {
                    f32x4 pr[2], pe[2], ne[2];
#pragma unroll
                    for (int n = 0; n < 2; ++n) { pe[n] = (f32x4){0.f, 0.f, 0.f, 0.f}; ne[n] = pe[n];
                        if (m == 0 && seg > 0) pe[n] = *(const f32x4*)(xch + ((((seg - 1) * 2 + 1) * 4 + wc) * 4 + fq) * 16 + bj * 8 + n * 4);
                        if (m == 3 && seg < 3) ne[n] = *(const f32x4*)(xch + ((((seg + 1) * 2 + 0) * 4 + wc) * 4 + fq) * 16 + bj * 8 + n * 4); }
#pragma unroll
                    for (int n = 0; n < 2; ++n)
#pragma unroll
                        for (int j = 0; j < 4; ++j) {
                            const float cur = acc[ai][bj][m][n][j];
                            const float ov = (m > 0) ? dpp_ror1(acc[ai][bj][m > 0 ? m - 1 : 0][n][j]) : pe[n][j];
                            const float nv = (m < 3) ? dpp_rol1(acc[ai][bj][m < 3 ? m + 1 : 3][n][j]) : ne[n][j];
                            const float prev = dpp_shr1(ov, cur), next = dpp_shl1(nv, cur);
                            pr[n][j] = w0[n][j] * prev + w1[n][j] * cur + w2[n][j] * next + bb[n][j]; }
                    const int row = u.pm * 256 + ai * 128 + wr * 64 + m * 16 + fr;
                    u32x4 w; w.x = pk2(silu_f(pr[0][0]), silu_f(pr[0][1])); w.y = pk2(silu_f(pr[0][2]), silu_f(pr[0][3])); w.z = pk2(silu_f(pr[1][0]), silu_f(pr[1][1])); w.w = pk2(silu_f(pr[1][2]), silu_f(pr[1][3]));
                    *(u32x4*)(P + (size_t)row * LDP + PC_X + ch) = w;
                    if ((m == 0 && seg == 0 && fr == 0) || (m == 3 && seg == 3 && fr == 15)) {
                        const size_t eb = ((size_t)u.pm * 2 + (m == 0 ? 0 : 1)) * 2048 + ch;
                        *(f32x4*)(XEDGER + eb) = acc[ai][bj][m][0]; *(f32x4*)(XEDGER + eb + 4) = acc[ai][bj][m][1];
                        *(f32x4*)(XEDGEP + eb) = pr[0];             *(f32x4*)(XEDGEP + eb + 4) = pr[1]; }
                }
                __builtin_amdgcn_sched_barrier(0);
            };
            body(std::integral_constant<int, 0>{}, std::integral_constant<int, 0>{}); body(std::integral_constant<int, 0>{}, std::integral_constant<int, 1>{});
            body(std::integral_constant<int, 1>{}, std::integral_constant<int, 0>{}); body(std::integral_constant<int, 1>{}, std::integral_constant<int, 1>{});
            return;
        }
#pragma unroll
        for (int ai = 0; ai < 2; ++ai)
#pragma unroll
            for (int m = 0; m < 4; ++m) {
                const int row = row0 + ai * 128 + m * 16;
                const float rs = rs_lds[row & 255];
                if (pn < 16) {
                    const int cbase = (pn < 4 ? PC_Z + pn * 256 : PC_SB + (pn - 12) * 256);
#pragma unroll
                    for (int bj = 0; bj < 2; ++bj) { const f32x4 v0 = acc[ai][bj][m][0] * rs, v1 = acc[ai][bj][m][1] * rs; u32x4 w; w.x = pk2(v0[0], v0[1]); w.y = pk2(v0[2], v0[3]); w.z = pk2(v1[0], v1[1]); w.w = pk2(v1[2], v1[3]);
                        *(u32x4*)(P + (size_t)row * LDP + cbase + bj * 128 + wc * 32 + 8 * fq) = w; }
                } else {
                    const float rs2 = rs * rs; const f32x4 v0 = acc[ai][0][m][0] * acc[ai][1][m][0] * rs2, v1 = acc[ai][0][m][1] * acc[ai][1][m][1] * rs2;
                    u32x4 w; w.x = pk2(v0[0], v0[1]); w.y = pk2(v0[2], v0[3]); w.z = pk2(v1[0], v1[1]); w.w = pk2(v1[2], v1[3]);
                    *(u32x4*)(P + (size_t)row * LDP + PC_P + (pn - 16) * 128 + wc * 32 + 8 * fq) = w;
                }
            }
    }
};
struct EpiAct {
    static constexpr bool PERM = true, AFTER_DRAIN = false;
    bf16_t* ACT; const float* rowss; float* rs_lds; float* xch; const float* cw; const float* cb; float* EDGER; float* EDGEP; mutable int cached_pm;
    __device__ __forceinline__ void operator()(const f32x4 (&acc_)[2][2][4][2], const Unit& u, int wr, int wc, int fr_, int fq_) const {
        int fr = fr_, fq = fq_; asm volatile("" : "+v"(fr), "+v"(fq));
        f32x4 (&acc)[2][2][4][2] = const_cast<f32x4 (&)[2][2][4][2]>(acc_);
        panel_rs(rowss, u.pm, cached_pm, rs_lds);
#pragma unroll
        for (int ai = 0; ai < 2; ++ai)
#pragma unroll
            for (int m = 0; m < 4; ++m) { const float rs = rs_lds[ai * 128 + wr * 64 + m * 16 + fr];
#pragma unroll
                for (int bj = 0; bj < 2; ++bj)
#pragma unroll
                    for (int n = 0; n < 2; ++n) acc[ai][bj][m][n] *= rs; }
#pragma unroll
        for (int ai = 0; ai < 2; ++ai) { const int seg = 2 * ai + wr;
            if (fr == 0) {
#pragma unroll
                for (int bj = 0; bj < 2; ++bj)
#pragma unroll
                    for (int n = 0; n < 2; ++n) *(f32x4*)(xch + (((seg * 2 + 0) * 4 + wc) * 4 + fq) * 16 + bj * 8 + n * 4) = acc[ai][bj][0][n]; }
            if (fr == 15) {
#pragma unroll
                for (int bj = 0; bj < 2; ++bj)
#pragma unroll
                    for (int n = 0; n < 2; ++n) *(f32x4*)(xch + (((seg * 2 + 1) * 4 + wc) * 4 + fq) * 16 + bj * 8 + n * 4) = acc[ai][bj][3][n]; } }
        const int f0 = u.pn * 128 + wc * 32 + 8 * fq;
        f32x4 w0v[8];
        { const int f = f0; w0v[0] = *(const f32x4*)(cw + f); w0v[1] = *(const f32x4*)(cw + NUP + f); w0v[2] = *(const f32x4*)(cw + 2 * NUP + f); w0v[3] = *(const f32x4*)(cb + f);
          w0v[4] = *(const f32x4*)(cw + DFF + f); w0v[5] = *(const f32x4*)(cw + NUP + DFF + f); w0v[6] = *(const f32x4*)(cw + 2 * NUP + DFF + f); w0v[7] = *(const f32x4*)(cb + DFF + f); }
        __syncthreads();
        auto body = [&](auto N_, auto AI_, const f32x4 (&wv)[8]) {
            constexpr int n = decltype(N_)::value, ai = decltype(AI_)::value;
            const int f = f0 + 4 * n, seg = 2 * ai + wr;
            const f32x4 wg0 = wv[0], wg1 = wv[1], wg2 = wv[2], bg = wv[3], wu0 = wv[4], wu1 = wv[5], wu2 = wv[6], bu = wv[7];
            f32x4 peg = (f32x4){0.f, 0.f, 0.f, 0.f}, peu = peg, neg = peg, neu = peg;
            if (seg > 0) { peg = *(const f32x4*)(xch + ((((seg - 1) * 2 + 1) * 4 + wc) * 4 + fq) * 16 + n * 4); peu = *(const f32x4*)(xch + ((((seg - 1) * 2 + 1) * 4 + wc) * 4 + fq) * 16 + 8 + n * 4); }
            if (seg < 3) { neg = *(const f32x4*)(xch + ((((seg + 1) * 2 + 0) * 4 + wc) * 4 + fq) * 16 + n * 4); neu = *(const f32x4*)(xch + ((((seg + 1) * 2 + 0) * 4 + wc) * 4 + fq) * 16 + 8 + n * 4); }
#pragma unroll
            for (int m = 0; m < 4; ++m) {
                const f32x4 sgm = acc[ai][0][m][n], sum_ = acc[ai][1][m][n];
                f32x4 pg, pu;
#pragma unroll
                for (int j = 0; j < 4; ++j) {
                    const float og = (m > 0) ? dpp_ror1(acc[ai][0][m > 0 ? m - 1 : 0][n][j]) : peg[j], ou = (m > 0) ? dpp_ror1(acc[ai][1][m > 0 ? m - 1 : 0][n][j]) : peu[j];
                    const float ng = (m < 3) ? dpp_rol1(acc[ai][0][m < 3 ? m + 1 : 3][n][j]) : neg[j], nu = (m < 3) ? dpp_rol1(acc[ai][1][m < 3 ? m + 1 : 3][n][j]) : neu[j];
                    const float gprev = dpp_shr1(og, sgm[j]), uprev = dpp_shr1(ou, sum_[j]);
                    const float gnext = dpp_shl1(ng, sgm[j]), unext = dpp_shl1(nu, sum_[j]);
                    pg[j] = wg0[j] * gprev + wg1[j] * sgm[j] + wg2[j] * gnext + bg[j];
                    pu[j] = wu0[j] * uprev + wu1[j] * sum_[j] + wu2[j] * unext + bu[j];
                }
                const int row = u.pm * 256 + ai * 128 + wr * 64 + m * 16 + fr;
                u32x2 w; w.x = pk2(silu_f(pg[0]) * pu[0], silu_f(pg[1]) * pu[1]); w.y = pk2(silu_f(pg[2]) * pu[2], silu_f(pg[3]) * pu[3]);
                *(u32x2*)(ACT + (size_t)row * DFF + f) = w;
                if ((m == 0 && seg == 0 && fr == 0) || (m == 3 && seg == 3 && fr == 15)) {
                    const size_t eb = ((size_t)u.pm * 2 + (m == 0 ? 0 : 1)) * NUP;
                    *(f32x4*)(EDGER + eb + f) = sgm; *(f32x4*)(EDGER + eb + DFF + f) = sum_;
                    *(f32x4*)(EDGEP + eb + f) = pg;  *(f32x4*)(EDGEP + eb + DFF + f) = pu; }
            }
        };
        body(std::integral_constant<int, 0>{}, std::integral_constant<int, 0>{}, w0v);
        f32x4 w1v[8];
        { const int f = f0 + 4; w1v[0] = *(const f32x4*)(cw + f); w1v[1] = *(const f32x4*)(cw + NUP + f); w1v[2] = *(const f32x4*)(cw + 2 * NUP + f); w1v[3] = *(const f32x4*)(cb + f);
          w1v[4] = *(const f32x4*)(cw + DFF + f); w1v[5] = *(const f32x4*)(cw + NUP + DFF + f); w1v[6] = *(const f32x4*)(cw + 2 * NUP + DFF + f); w1v[7] = *(const f32x4*)(cb + DFF + f); }
        __builtin_amdgcn_sched_barrier(0);
        body(std::integral_constant<int, 0>{}, std::integral_constant<int, 1>{}, w0v);
        __builtin_amdgcn_sched_barrier(0);
        body(std::integral_constant<int, 1>{}, std::integral_constant<int, 0>{}, w1v);
        __builtin_amdgcn_sched_barrier(0);
        body(std::integral_constant<int, 1>{}, std::integral_constant<int, 1>{}, w1v);
    }
};

__device__ __forceinline__ int src_in(int j) {
    if (j < 3072) return j;
    if (j < 4096) return j + 32;
    { const int t = (j - 4096) >> 8, r = (j - 4096) & 255; return r < 128 ? 4128 + t * 128 + r : 5152 + t * 128 + (r - 128); }
}
__device__ __forceinline__ void convert_weight(const float* W, int ldw, const float* scale, bf16_t* Wt, int K, int N, int kind, float* tile, int blk, int nblk) {
    int tid_ = threadIdx.x; asm volatile("" : "+v"(tid_));
    const int tid = tid_, nkt = K / 64, ntile = (N / 256) * nkt;
    for (int t = blk; t < ntile; t += nblk) {
        const int j0 = (t / nkt) * 256, k0 = (t % nkt) * 64;
        float v[32];
#pragma unroll
        for (int i = 0; i < 32; ++i) { const int kk = (tid >> 8) + 2 * i, jj = tid & 255; const int jx = j0 + jj; const int sj = kind == 1 ? src_in(jx) : (kind == 2 ? (((jx & 255) < 128) ? (jx >> 8) * 128 + (jx & 127) : DFF + (jx >> 8) * 128 + (jx & 127)) : jx);
            v[i] = W[(size_t)(k0 + kk) * ldw + (sj >= 0 ? sj : 0)]; if (sj < 0) v[i] = 0.f; }
        __syncthreads();
#pragma unroll
        for (int i = 0; i < 32; ++i) { const int kk = (tid >> 8) + 2 * i, jj = tid & 255; tile[kk * 257 + jj] = v[i]; }
        __syncthreads();
        const int kk = 2 * (tid & 31); const float s0 = scale ? scale[k0 + kk] : 1.0f, s1 = scale ? scale[k0 + kk + 1] : 1.0f;
#pragma unroll
        for (int i = 0; i < 16; ++i) { const int jj = (tid >> 5) + 16 * i;
            *(unsigned*)(Wt + (size_t)(j0 + jj) * K + k0 + kk) = pk2(tile[kk * 257 + jj] * s0, tile[(kk + 1) * 257 + jj] * s1); }
    }
}
__device__ __forceinline__ void phase_weights(const Params& p, float* tile) {
    const int G = gridDim.x; int cum = 0;
#define WBLK ((int)((blockIdx.x + (unsigned)G - (unsigned)(cum % G)) % (unsigned)G))
    for (int l = 0; l < 2; ++l) {
        unsigned char* wb = p.ws + (size_t)l * WL_B;
        convert_weight(p.in[I_WIN] + (size_t)l * DM * 6176, 6176, p.in[I_N1] + l * DM, (bf16_t*)wb, DM, NIN, 1, tile, WBLK, G); cum += (NIN / 256) * (DM / 64);
        convert_weight(p.in[I_WOUT] + (size_t)l * DMIX * DM, DM, nullptr, (bf16_t*)(wb + WT_IN_B), DMIX, DM, 0, tile, WBLK, G); cum += (DM / 256) * (DMIX / 64);
        convert_weight(p.in[I_WUP] + (size_t)l * DM * NUP, NUP, p.in[I_N2] + l * DM, (bf16_t*)(wb + WT_IN_B + WT_OUT_B), DM, NUP, 2, tile, WBLK, G); cum += (NUP / 256) * (DM / 64);
        convert_weight(p.in[I_WDN] + (size_t)l * DFF * DM, DM, nullptr, (bf16_t*)(wb + WT_IN_B + WT_OUT_B + WT_UP_B), DFF, DM, 0, tile, WBLK, G); cum += (DM / 256) * (DFF / 64);
    }
#undef WBLK
    {
        bf16_t* WDT = (bf16_t*)(p.ws + OFF_WDT); int tid_ = threadIdx.x; asm volatile("" : "+v"(tid_));
        for (int idx = blockIdx.x * 512 + tid_; idx < 2 * 32 * DM; idx += gridDim.x * 512) { const int l = idx >> 15, j = (idx >> 10) & 31, k = idx & 1023;
            const float v = p.in[I_WIN][((size_t)l * DM + k) * 6176 + 3072 + j] * p.in[I_N1][l * DM + k]; const unsigned w = pk2(v, v); WDT[idx] = (bf16_t)(w & 0xffffu); }
    }
}
__device__ __forceinline__ void phase_prep(const Params& p, int hf) {
    int tid_ = threadIdx.x; asm volatile("" : "+v"(tid_));
    const int tid = tid_, wid = tid >> 6, lane = tid & 63;
    float* rowss = (float*)(p.ws + OFF_ROWSS) + (size_t)hf * 5 * TH * 16;
    bf16_t* HB = (bf16_t*)(p.ws + OFF_HB);
    const float* x = p.in[I_X] + (size_t)hf * TH * DM;
#pragma unroll 4
    for (int row = blockIdx.x * 8 + wid; row < TH; row += gridDim.x * 8) {
        float ss = 0.f;
#pragma unroll
        for (int i = 0; i < 2; ++i) { const int c = i * 512 + lane * 8;
            const f32x4 v = *(const f32x4*)(x + (size_t)row * DM + c), v2 = *(const f32x4*)(x + (size_t)row * DM + c + 4);
            ss += ((v[0] * v[0] + v[1] * v[1]) + (v[2] * v[2] + v[3] * v[3])) + ((v2[0] * v2[0] + v2[1] * v2[1]) + (v2[2] * v2[2] + v2[3] * v2[3]));
            u32x4 w; w.x = pk2(v[0], v[1]); w.y = pk2(v[2], v[3]); w.z = pk2(v2[0], v2[1]); w.w = pk2(v2[2], v2[3]); *(u32x4*)(HB + (size_t)row * DM + c) = w; }
#pragma unroll
        for (int o = 32; o >= 1; o >>= 1) ss += __shfl_xor(ss, o);
        if (lane < 16) rowss[(size_t)row * 16 + lane] = lane == 0 ? ss : 0.f;
    }
}
__device__ __forceinline__ void phase_final(const Params& p, int hf) {
    int tid_ = threadIdx.x; asm volatile("" : "+v"(tid_));
    const int tid = tid_, wid = tid >> 6, lane = tid & 63;
    const float* rowss = (const float*)(p.ws + OFF_ROWSS) + ((size_t)hf * 5 + 4) * TH * 16;
    float* h = p.out + (size_t)hf * TH * DM; const float* w = p.in[I_FNW]; const bf16_t* HB = (const bf16_t*)(p.ws + OFF_HB);
#pragma unroll 4
    for (int row = blockIdx.x * 8 + wid; row < TH; row += gridDim.x * 8) {
        const float rs = row_rs(rowss, row);
#pragma unroll
        for (int i = 0; i < 2; ++i) { const int c = i * 512 + lane * 8; const u32x4 hb = *(const u32x4*)(HB + (size_t)row * DM + c); const f32x4 g = *(const f32x4*)(w + c), g2 = *(const f32x4*)(w + c + 4);
            f32x4 v, v2; v[0] = bflo(hb.x); v[1] = bfhi(hb.x); v[2] = bflo(hb.y); v[3] = bfhi(hb.y); v2[0] = bflo(hb.z); v2[1] = bfhi(hb.z); v2[2] = bflo(hb.w); v2[3] = bfhi(hb.w);
            *(f32x4*)(h + (size_t)row * DM + c) = v * rs * g; *(f32x4*)(h + (size_t)row * DM + c + 4) = v2 * rs * g2; }
    }
}
__device__ __forceinline__ void phase_edgefix(const Params& p, int l) {
    const float* EDGER = (const float*)(p.ws + OFF_EDGER); const float* EDGEP = (const float*)(p.ws + OFF_EDGEP); bf16_t* ACT = (bf16_t*)(p.ws + OFF_ACT);
    const float* cw = p.in[I_FCW] + (size_t)l * 3 * NUP;
    int tid_ = threadIdx.x; asm volatile("" : "+v"(tid_));
    for (int idx = blockIdx.x * 512 + tid_; idx < (TH / 256) * 2 * DFF; idx += gridDim.x * 512) {
        const int f = idx % DFF, pe = idx / DFF, e = pe & 1, pm = pe >> 1, t = 256 * pm + (e ? 255 : 0);
        const bool has = e ? (((t + 1) % SEQ) != 0) : ((t % SEQ) != 0);
        float ng = 0.f, nu = 0.f;
        if (has) { const size_t nb = ((size_t)(pm + (e ? 1 : -1)) * 2 + (e ? 0 : 1)) * NUP; ng = EDGER[nb + f]; nu = EDGER[nb + DFF + f]; }
        const int wk = e ? 2 : 0; const size_t eb = ((size_t)pm * 2 + e) * NUP;
        const float pg = EDGEP[eb + f] + cw[wk * NUP + f] * ng, pu = EDGEP[eb + DFF + f] + cw[wk * NUP + DFF + f] * nu;
        const float o = silu_f(pg) * pu; const unsigned w = pk2(o, o); ACT[(size_t)t * DFF + f] = (bf16_t)(w & 0xffffu);
    }
}
__device__ __forceinline__ void edgefix_panel(const Params& p, int l, int pm) {
    const float* EDGER = (const float*)(p.ws + OFF_EDGER); const float* EDGEP = (const float*)(p.ws + OFF_EDGEP); bf16_t* ACT = (bf16_t*)(p.ws + OFF_ACT);
    const float* cw = p.in[I_FCW] + (size_t)l * 3 * NUP;
    int tid_ = threadIdx.x; asm volatile("" : "+v"(tid_));
    for (int idx = tid_; idx < 2 * DFF; idx += 512) {
        const int e = idx >= DFF ? 1 : 0, f = idx - e * DFF, t = 256 * pm + (e ? 255 : 0);
        const bool has = e ? (((t + 1) % SEQ) != 0) : ((t % SEQ) != 0);
        float ng = 0.f, nu = 0.f;
        if (has) { const size_t nb = ((size_t)(pm + (e ? 1 : -1)) * 2 + (e ? 0 : 1)) * NUP; ng = EDGER[nb + f]; nu = EDGER[nb + DFF + f]; }
        const int wk = e ? 2 : 0; const size_t eb = ((size_t)pm * 2 + e) * NUP;
        const float pg = EDGEP[eb + f] + cw[wk * NUP + f] * ng, pu = EDGEP[eb + DFF + f] + cw[wk * NUP + DFF + f] * nu;
        const float o = silu_f(pg) * pu; const unsigned w = pk2(o, o); ACT[(size_t)t * DFF + f] = (bf16_t)(w & 0xffffu);
    }
}
__device__ __forceinline__ void phase_dt(const Params& p, int l, const float* rowss) {
    int tid_ = threadIdx.x; asm volatile("" : "+v"(tid_));
    const int wid = tid_ >> 6, lane = tid_ & 63, fr = lane & 15, fq = lane >> 4;
    const bf16_t* HB = (const bf16_t*)(p.ws + OFF_HB); const bf16_t* WDT = (const bf16_t*)(p.ws + OFF_WDT) + (size_t)l * 32 * DM; float* DT = (float*)(p.ws + OFF_DT);
    for (int tb = blockIdx.x; tb < TH / 128; tb += gridDim.x) {
        const int tok = tb * 128 + wid * 16 + fr;
        f32x4 a0 = (f32x4){0.f, 0.f, 0.f, 0.f}, a1 = a0;
#pragma unroll 1
        for (int k0 = 0; k0 < 32; k0 += 8) {
            bf16x8 hf[8], w0[8], w1[8];
#pragma unroll
            for (int i = 0; i < 8; ++i) { const int ko = 32 * (k0 + i) + 8 * fq;
                hf[i] = *(const bf16x8*)(HB + (size_t)tok * DM + ko); w0[i] = *(const bf16x8*)(WDT + (size_t)fr * DM + ko); w1[i] = *(const bf16x8*)(WDT + (size_t)(16 + fr) * DM + ko); }
#pragma unroll
            for (int i = 0; i < 8; ++i) { a0 = __builtin_amdgcn_mfma_f32_16x16x32_bf16(w0[i], hf[i], a0, 0, 0, 0); a1 = __builtin_amdgcn_mfma_f32_16x16x32_bf16(w1[i], hf[i], a1, 0, 0, 0); }
        }
        const float rs = row_rs(rowss, tok);
        *(f32x4*)(DT + (size_t)tok * 32 + 4 * fq) = a0 * rs; *(f32x4*)(DT + (size_t)tok * 32 + 16 + 4 * fq) = a1 * rs;
    }
}
__device__ __forceinline__ void phase_xedgefix(const Params& p, int l) {
    const float* XEDGER = (const float*)(p.ws + OFF_XEDGER); const float* XEDGEP = (const float*)(p.ws + OFF_XEDGEP); bf16_t* P = (bf16_t*)(p.ws + OFF_PROJ);
    const float* cxw = p.in[I_CXW] + (size_t)l * 3 * 2048;
    int tid_ = threadIdx.x; asm volatile("" : "+v"(tid_));
    for (int idx = blockIdx.x * 512 + tid_; idx < (TH / 256) * 2 * 2048; idx += gridDim.x * 512) {
        const int ch = idx & 2047, pe = idx >> 11, e = pe & 1, pm = pe >> 1, t = 256 * pm + (e ? 255 : 0);
        const bool has = e ? (((t + 1) % SEQ) != 0) : ((t % SEQ) != 0);
        float nb = 0.f;
        if (has) nb = XEDGER[((size_t)(pm + (e ? 1 : -1)) * 2 + (e ? 0 : 1)) * 2048 + ch];
        const float pre = XEDGEP[((size_t)pm * 2 + e) * 2048 + ch] + cxw[(e ? 2 : 0) * 2048 + ch] * nb;
        const float o = silu_f(pre); const unsigned w = pk2(o, o); P[(size_t)t * LDP + PC_X + ch] = (bf16_t)(w & 0xffffu);
    }
}
__device__ __forceinline__ void phase_shortconv(const Params& p, int l) {
    bf16_t* P = (bf16_t*)(p.ws + OFF_PROJ);
    const float* cw = p.in[I_SCW] + (size_t)l * 3 * 1024;
    int tid_ = threadIdx.x; asm volatile("" : "+v"(tid_));
    const int j0 = (tid_ & 127) * 8, sub = tid_ >> 7;
    float w[3][8];
#pragma unroll
    for (int k = 0; k < 3; ++k) { const f32x4 a0 = *(const f32x4*)(cw + k * 1024 + j0), a1 = *(const f32x4*)(cw + k * 1024 + j0 + 4);
#pragma unroll
        for (int j = 0; j < 4; ++j) { w[k][j] = a0[j]; w[k][4 + j] = a1[j]; } }
    for (int tb = blockIdx.x; tb < TH / 32; tb += gridDim.x) {
        const int t0 = tb * 32 + sub * 8, pos0 = t0 % SEQ;
        u32x4 rp[10], rb[8];
#pragma unroll
        for (int r = 0; r < 10; ++r) { const int pos = pos0 - 1 + r; const bool ok = pos >= 0 && pos < SEQ;
            rp[r] = *(const u32x4*)(P + (size_t)(ok ? t0 - 1 + r : t0) * LDP + PC_P + j0);
            if (!ok) rp[r] = (u32x4){0u, 0u, 0u, 0u}; }
#pragma unroll
        for (int r = 0; r < 8; ++r) rb[r] = *(const u32x4*)(P + (size_t)(t0 + r) * LDP + PC_SB + j0);
#pragma unroll
        for (int r = 0; r < 8; ++r) { float p0[8], p1[8], p2[8], sb[8], o[8]; unpack8(rp[r], p0); unpack8(rp[r + 1], p1); unpack8(rp[r + 2], p2); unpack8(rb[r], sb);
#pragma unroll
            for (int j = 0; j < 8; ++j) o[j] = sb[j] * (w[0][j] * p0[j] + w[1][j] * p1[j] + w[2][j] * p2[j]);
            *(u32x4*)(P + (size_t)(t0 + r) * LDP + PC_SB + j0) = pack8(o); }
    }
}

__device__ __forceinline__ int chperm(int t, int i) { return 32 * (t >> 1) + 8 * (i >> 2) + 4 * (t & 1) + (i & 3); }
__device__ __forceinline__ void ssd_dt_load(const float* DT, int t0, int g, int wid, int lane, float& r0, float& r1) {
    const int dir = wid >> 2, hh = wid & 3, h = 4 * g + hh;
    r0 = DT[(size_t)(t0 + lane) * 32 + dir * 16 + h]; r1 = DT[(size_t)(t0 + 64 + lane) * 32 + dir * 16 + h];
}
__device__ __forceinline__ float ssd_dt_scan(const Params& p, int l, float r0, float r1, int g, float* sm_dt, float* sm_cs, int wid, int lane) {
    const int dir = wid >> 2, hh = wid & 3, h = 4 * g + hh;
    const float bias = p.in[dir ? I_DTBB : I_DTBF][l * 16 + h]; const float A = -__expf(p.in[dir ? I_ALB : I_ALF][l * 16 + h]);
    const float d0 = softplus_f(r0 + bias), d1 = softplus_f(r1 + bias);
    const float a0 = A * d0, a1 = A * d1;
    float s0 = a0, s1 = a1;
#pragma unroll
    for (int o = 1; o < 64; o <<= 1) { const float u0 = __shfl_up(s0, o), u1 = __shfl_up(s1, o); if (lane >= o) { s0 += u0; s1 += u1; } }
    const float tot0 = __shfl(s0, 63); s1 += tot0; const float total = __shfl(s1, 63);
    float c0 = s0, c1 = s1;
    if (dir) { c0 = total - s0 + a0; c1 = total - s1 + a1; }
    const int b = (dir * 4 + hh) * 128;
    sm_dt[b + lane] = d0; sm_dt[b + 64 + lane] = d1; sm_cs[b + lane] = c0; sm_cs[b + 64 + lane] = c1;
    return total;
}
template <int NCH> struct ConvTr {
    static constexpr int NPAIR = NCH / 2, NT = NPAIR * 16 / 512;
    unsigned xr[NT][8];
    __device__ __forceinline__ void load(const bf16_t* P, int t0, int pos0, int col0, int tid) {
#pragma unroll
        for (int it = 0; it < NT; ++it) { const int task = tid + it * 512, cp = task % NPAIR, to = task / NPAIR, ch = 2 * cp;
#pragma unroll
            for (int r = 0; r < 8; ++r) xr[it][r] = *(const unsigned*)(P + (size_t)(t0 + 8 * to + r) * LDP + col0 + ch); }
    }
    __device__ __forceinline__ void compute(const float*, const float*, int, bf16_t* dst, int tid) const {
#pragma unroll
        for (int it = 0; it < NT; ++it) { const int task = tid + it * 512, cp = task % NPAIR, to = task / NPAIR, ch = 2 * cp;
            u32x4 lo, hi;
            lo.x = (xr[it][0] & 0xffffu) | (xr[it][1] << 16); lo.y = (xr[it][2] & 0xffffu) | (xr[it][3] << 16); lo.z = (xr[it][4] & 0xffffu) | (xr[it][5] << 16); lo.w = (xr[it][6] & 0xffffu) | (xr[it][7] << 16);
            hi.x = (xr[it][0] >> 16) | (xr[it][1] & 0xffff0000u); hi.y = (xr[it][2] >> 16) | (xr[it][3] & 0xffff0000u); hi.z = (xr[it][4] >> 16) | (xr[it][5] & 0xffff0000u); hi.w = (xr[it][6] >> 16) | (xr[it][7] & 0xffff0000u);
            *(u32x4*)(dst + (size_t)ch * LSTR + 8 * to) = lo;
            *(u32x4*)(dst + (size_t)(ch + 1) * LSTR + 8 * to) = hi; }
    }
};
template <int NCH> struct ConvNat {
    static constexpr int NG = NCH / 8, NT = NG * 128 / 512;
    u32x4 xr[NT];
    __device__ __forceinline__ void load(const bf16_t* P, int t0, int pos0, int col0, int tid) {
#pragma unroll
        for (int it = 0; it < NT; ++it) { const int task = tid + it * 512, cg8 = task % NG, l = task / NG; xr[it] = *(const u32x4*)(P + (size_t)(t0 + l) * LDP + col0 + 8 * cg8); }
    }
    __device__ __forceinline__ void compute(const float*, const float*, int, bf16_t* dst, int tid) const {
#pragma unroll
        for (int it = 0; it < NT; ++it) { const int task = tid + it * 512, cg8 = task % NG, l = task / NG; *(u32x4*)(dst + (size_t)l * LSTR + 8 * cg8) = xr[it]; }
    }
};

__device__ __forceinline__ void phase_ssd_states(const Params& p, int l, unsigned char* smem) {
    int tid_ = threadIdx.x; asm volatile("" : "+v"(tid_));
    const int tid = tid_, wid = tid >> 6, lane = tid & 63, fr = lane & 15, fq = lane >> 4;
    const bf16_t* P = (const bf16_t*)(p.ws + OFF_PROJ); const float* DT = (const float*)(p.ws + OFF_DT);
    bf16_t* ST = (bf16_t*)(p.ws + OFF_ST); float* CHDEC = (float*)(p.ws + OFF_CHDEC);
    const float* cw = p.in[I_CXW] + (size_t)l * 3 * 2048; const float* cb = p.in[I_CXB] + (size_t)l * 2048;
    bf16_t* XT = (bf16_t*)smem;
    bf16_t* BT = (bf16_t*)(smem + 256 * LSTR * 2);
    float* sm_dt = (float*)(smem + 384 * LSTR * 2);
    float* sm_cs = sm_dt + 1024;
    float* sm_w = sm_cs + 1024;
    {
        const float* XEDGER = (const float*)(p.ws + OFF_XEDGER); const float* XEDGEP = (const float*)(p.ws + OFF_XEDGEP); bf16_t* Pw = (bf16_t*)(p.ws + OFF_PROJ);
        const float* cxw = p.in[I_CXW] + (size_t)l * 3 * 2048;
        for (int item = blockIdx.x; item < NBP * 128; item += gridDim.x) {
            const int g = item & 3, c = (item >> 2) & 31, b = item >> 7, e = c & 1, pm = b * 16 + (c >> 1), t = b * SEQ + c * 128 + (e ? 127 : 0);
            const int ch = tid < 256 ? 256 * g + tid : (tid < 384 ? 1024 + 128 * g + (tid - 256) : 1536 + 128 * g + (tid - 384));
            const bool has = e ? (c != 31) : (c != 0);
            float nb = 0.f;
            if (has) nb = XEDGER[((size_t)(pm + (e ? 1 : -1)) * 2 + (e ? 0 : 1)) * 2048 + ch];
            const float pre = XEDGEP[((size_t)pm * 2 + e) * 2048 + ch] + cxw[(e ? 2 : 0) * 2048 + ch] * nb;
            const float o = silu_f(pre); const unsigned w = pk2(o, o); Pw[(size_t)t * LDP + PC_X + ch] = (bf16_t)(w & 0xffffu);
        }
        asm volatile("s_waitcnt vmcnt(0)" ::: "memory"); __syncthreads();
    }
    for (int item = blockIdx.x; item < NBP * 128; item += gridDim.x) {
        const int g = item & 3, c = (item >> 2) & 31, b = item >> 7;
        const int t0 = b * SEQ + c * 128, pos0 = c * 128;
        __syncthreads();
        float r0, r1; ssd_dt_load(DT, t0, g, wid, lane, r0, r1);
        ConvTr<256> cx; ConvTr<128> cbt;
        cx.load(P, t0, pos0, PC_X + 256 * g, tid); cbt.load(P, t0, pos0, PC_X + 1024 + 128 * g, tid);
        const float total = ssd_dt_scan(p, l, r0, r1, g, sm_dt, sm_cs, wid, lane);
        cx.compute(cw, cb, 256 * g, XT, tid); cbt.compute(cw, cb, 1024 + 128 * g, BT, tid);
        const int dir = wid >> 2, hh = wid & 3, h = 4 * g + hh, sb = (dir * 4 + hh) * 128;
        {
            sm_w[sb + lane] = sm_dt[sb + lane] * __expf(total - sm_cs[sb + lane]);
            sm_w[sb + 64 + lane] = sm_dt[sb + 64 + lane] * __expf(total - sm_cs[sb + 64 + lane]);
            if (lane == 0) CHDEC[((b * 32 + c) * 16 + h) * 2 + dir] = __expf(total);
        }
        __syncthreads();
        f32x4 acc[4][8];
#pragma unroll
        for (int i = 0; i < 4; ++i)
#pragma unroll
            for (int j = 0; j < 8; ++j) acc[i][j] = (f32x4){0.f, 0.f, 0.f, 0.f};
#pragma unroll 1
        for (int ks = 0; ks < 4; ++ks) {
            const f32x4 w0 = *(const f32x4*)(sm_w + sb + 32 * ks + 8 * fq), w1 = *(const f32x4*)(sm_w + sb + 32 * ks + 8 * fq + 4);
            bf16x8 xf[4];
#pragma unroll
            for (int pi = 0; pi < 4; ++pi) { const u32x4 raw = *(const u32x4*)(XT + (size_t)(64 * hh + chperm(pi, fr)) * LSTR + 32 * ks + 8 * fq); float f[8]; unpack8(raw, f);
                f[0] *= w0[0]; f[1] *= w0[1]; f[2] *= w0[2]; f[3] *= w0[3]; f[4] *= w1[0]; f[5] *= w1[1]; f[6] *= w1[2]; f[7] *= w1[3];
                const u32x4 pk = pack8(f); xf[pi] = __builtin_bit_cast(bf16x8, pk); }
#pragma unroll
            for (int ni = 0; ni < 8; ++ni) { const bf16x8 bf = *(const bf16x8*)(BT + (size_t)chperm(ni, fr) * LSTR + 32 * ks + 8 * fq);
#pragma unroll
                for (int pi = 0; pi < 4; ++pi) acc[pi][ni] = __builtin_amdgcn_mfma_f32_16x16x32_bf16(bf, xf[pi], acc[pi][ni], 0, 0, 0); }
        }
        bf16_t* S = ST + ((size_t)((b * 32 + c) * 16 + h) * 2 + dir) * 8192;
#pragma unroll
        for (int pi = 0; pi < 4; ++pi)
#pragma unroll
            for (int q = 0; q < 4; ++q) { u32x4 w; w.x = pk2(acc[pi][2 * q][0], acc[pi][2 * q][1]); w.y = pk2(acc[pi][2 * q][2], acc[pi][2 * q][3]); w.z = pk2(acc[pi][2 * q + 1][0], acc[pi][2 * q + 1][1]); w.w = pk2(acc[pi][2 * q + 1][2], acc[pi][2 * q + 1][3]);
                *(u32x4*)(S + ((q * 4 + pi) * 16 + fr) * 32 + 8 * fq) = w; }
    }
}
__device__ __forceinline__ void phase_ssd_scan(const Params& p) {
    bf16_t* ST = (bf16_t*)(p.ws + OFF_ST); const float* CHDEC = (const float*)(p.ws + OFF_CHDEC);
    const int ntask = NBP * 16 * 2 * 1024;
    int tid_ = threadIdx.x; asm volatile("" : "+v"(tid_));
    for (int task = blockIdx.x * 512 + tid_; task < ntask; task += gridDim.x * 512) {
        const int e = task & 1023, dir = (task >> 10) & 1, h = (task >> 11) & 15, b = task >> 15;
        const int c0 = dir ? 31 : 0, cstep = dir ? -1 : 1;
        const size_t idx0 = (size_t)((b * 32 + c0) * 16 + h) * 2 + dir; const long istep = (long)cstep * 32;
        float run[8];
#pragma unroll
        for (int j = 0; j < 8; ++j) run[j] = 0.f;
#pragma unroll 1
        for (int i0 = 0; i0 < 32; i0 += 16) {
            u32x4 v[16]; float d[16];
#pragma unroll
            for (int i = 0; i < 16; ++i) { const size_t idx = idx0 + (long)(i0 + i) * istep; v[i] = *(const u32x4*)(ST + idx * 8192 + e * 8); d[i] = CHDEC[idx]; }
#pragma unroll
            for (int i = 0; i < 16; ++i) { const size_t idx = idx0 + (long)(i0 + i) * istep; float sv[8]; unpack8(v[i], sv);
                *(u32x4*)(ST + idx * 8192 + e * 8) = pack8(run);
#pragma unroll
                for (int j = 0; j < 8; ++j) run[j] = run[j] * d[i] + sv[j]; }
        }
    }
}
__device__ __forceinline__ void phase_ssd_out(const Params& p, int l, unsigned char* smem) {
    bf16_t* P = (bf16_t*)(p.ws + OFF_PROJ); const float* DT = (const float*)(p.ws + OFF_DT);
    const bf16_t* ST = (const bf16_t*)(p.ws + OFF_ST);
    const float* cw = p.in[I_CXW] + (size_t)l * 3 * 2048; const float* cb = p.in[I_CXB] + (size_t)l * 2048;
    const float* dsk = p.in[I_DSK] + l * 16; const float* nw = p.in[I_SNW] + l * 1024;
    bf16_t* XT = (bf16_t*)smem;
    bf16_t* CN = (bf16_t*)(smem + 256 * LSTR * 2);
    bf16_t* BN = (bf16_t*)(smem + 384 * LSTR * 2);
    float* sm_dt = (float*)(smem + 512 * LSTR * 2);
    float* sm_cs = sm_dt + 1024;
    float* sm_ss = sm_cs + 1024;
    for (int item = blockIdx.x; item < NBP * 128; item += gridDim.x) {
        int tid_ = threadIdx.x; asm volatile("" : "+v"(tid_));
        const int tid = tid_, wid = tid >> 6, lane = tid & 63, fr = lane & 15, fq = lane >> 4, hh = wid >> 1, lh = wid & 1;
        const int g = item & 3, c = (item >> 2) & 31, b = item >> 7;
        const int t0 = b * SEQ + c * 128, pos0 = c * 128, h = 4 * g + hh;
        __syncthreads();
        const bf16_t* Hf = ST + ((size_t)((b * 32 + c) * 16 + h) * 2 + 0) * 8192;
        bf16x8 hv[4][4];
        {
            float r0, r1; ssd_dt_load(DT, t0, g, wid, lane, r0, r1);
            ConvNat<128> cbn, ccn; ConvTr<256> cx;
            cbn.load(P, t0, pos0, PC_X + 1024 + 128 * g, tid); ccn.load(P, t0, pos0, PC_X + 1536 + 128 * g, tid); cx.load(P, t0, pos0, PC_X + 256 * g, tid);
            __builtin_amdgcn_sched_barrier(0);
            ssd_dt_scan(p, l, r0, r1, g, sm_dt, sm_cs, wid, lane);
            cbn.compute(cw, cb, 1024 + 128 * g, BN, tid);
            ccn.compute(cw, cb, 1536 + 128 * g, CN, tid);
            cx.compute(cw, cb, 256 * g, XT, tid);
        }
#pragma unroll
        for (int ks = 0; ks < 4; ++ks)
#pragma unroll
            for (int pt = 0; pt < 4; ++pt) hv[ks][pt] = *(const bf16x8*)(Hf + ((ks * 4 + pt) * 16 + fr) * 32 + 8 * fq);
        __syncthreads();
        {
            f32x4 cbacc[8];
#pragma unroll
            for (int st = 0; st < 8; ++st) cbacc[st] = (f32x4){0.f, 0.f, 0.f, 0.f};
#pragma unroll
            for (int ks = 0; ks < 4; ++ks) {
                const bf16x8 cf = *(const bf16x8*)(CN + (size_t)(16 * wid + fr) * LSTR + 32 * ks + 8 * fq);
#pragma unroll
                for (int st = 0; st < 8; ++st) { const bf16x8 bf = *(const bf16x8*)(BN + (size_t)(16 * st + fr) * LSTR + 32 * ks + 8 * fq);
                    cbacc[st] = __builtin_amdgcn_mfma_f32_16x16x32_bf16(bf, cf, cbacc[st], 0, 0, 0); }
            }
            __syncthreads();
#pragma unroll
            for (int st = 0; st < 8; ++st) { u32x2 w; w.x = pk2(cbacc[st][0], cbacc[st][1]); w.y = pk2(cbacc[st][2], cbacc[st][3]);
                *(u32x2*)(BN + (size_t)(16 * wid + fr) * LSTR + 16 * st + 4 * fq) = w; }
        }
        __syncthreads();
        const float* dtf = sm_dt + hh * 128; const float* dtb = sm_dt + (4 + hh) * 128; const float* acs = sm_cs + hh * 128; const float* rcs = sm_cs + (4 + hh) * 128;
        f32x4 acc[4][4];
#pragma unroll
        for (int dir = 0; dir < 2; ++dir) {
            const float* csd = dir ? rcs : acs;
            f32x4 acc2[4][4];
#pragma unroll
            for (int i = 0; i < 4; ++i)
#pragma unroll
                for (int j = 0; j < 4; ++j) acc2[i][j] = (f32x4){0.f, 0.f, 0.f, 0.f};
#pragma unroll
            for (int ks = 0; ks < 4; ++ks) {
                bf16x8 a[4];
#pragma unroll
                for (int lt = 0; lt < 4; ++lt) a[lt] = *(const bf16x8*)(CN + (size_t)(64 * lh + 16 * lt + fr) * LSTR + 32 * ks + 8 * fq);
#pragma unroll
                for (int lt = 0; lt < 4; ++lt)
#pragma unroll
                    for (int pt = 0; pt < 4; ++pt) acc2[lt][pt] = __builtin_amdgcn_mfma_f32_16x16x32_bf16(hv[ks][pt], a[lt], acc2[lt][pt], 0, 0, 0);
                if (dir == 0) {
#pragma unroll
                    for (int pt = 0; pt < 4; ++pt) hv[ks][pt] = *(const bf16x8*)(Hf + 8192 + ((ks * 4 + pt) * 16 + fr) * 32 + 8 * fq); }
                __builtin_amdgcn_sched_barrier(0);
            }
#pragma unroll
            for (int lt = 0; lt < 4; ++lt) { const float ev = __expf(csd[64 * lh + 16 * lt + fr]);
#pragma unroll
                for (int pt = 0; pt < 4; ++pt) acc[lt][pt] = dir ? acc[lt][pt] + acc2[lt][pt] * ev : acc2[lt][pt] * ev; }
        }
        u32x2 zr[4][4];
#pragma unroll
        for (int lt = 0; lt < 4; ++lt)
#pragma unroll
            for (int q = 0; q < 2; ++q) { const u32x4 zz = *(const u32x4*)(P + (size_t)(t0 + 64 * lh + 16 * lt + fr) * LDP + PC_Z + 256 * g + 64 * hh + 32 * q + 8 * fq);
                zr[lt][2 * q].x = zz.x; zr[lt][2 * q].y = zz.y; zr[lt][2 * q + 1].x = zz.z; zr[lt][2 * q + 1].y = zz.w; }
        const float dskip = dsk[h];
#pragma unroll 1
        for (int ks = 0; ks < 4; ++ks) {
            const int s0 = 32 * ks + 8 * fq;
            float as_[8], rs_[8], df_[8], db_[8];
            { const f32x4 t0_ = *(const f32x4*)(acs + s0), t1_ = *(const f32x4*)(acs + s0 + 4), u0_ = *(const f32x4*)(rcs + s0), u1_ = *(const f32x4*)(rcs + s0 + 4);
              const f32x4 v0_ = *(const f32x4*)(dtf + s0), v1_ = *(const f32x4*)(dtf + s0 + 4), x0_ = *(const f32x4*)(dtb + s0), x1_ = *(const f32x4*)(dtb + s0 + 4);
#pragma unroll
              for (int j = 0; j < 4; ++j) { as_[j] = t0_[j]; as_[4 + j] = t1_[j]; rs_[j] = u0_[j]; rs_[4 + j] = u1_[j]; df_[j] = v0_[j]; df_[4 + j] = v1_[j]; db_[j] = x0_[j]; db_[4 + j] = x1_[j]; } }
            bf16x8 bx[4];
#pragma unroll
            for (int pt = 0; pt < 4; ++pt) bx[pt] = *(const bf16x8*)(XT + (size_t)(64 * hh + chperm(pt, fr)) * LSTR + s0);
#pragma unroll
            for (int lt = 0; lt < 4; ++lt) {
                const int lrow = 64 * lh + 16 * lt + fr;
                const float al = acs[lrow], rl = rcs[lrow], dd = dtf[lrow] + dtb[lrow];
                float cbv[8]; unpack8(*(const u32x4*)(BN + (size_t)lrow * LSTR + s0), cbv);
#pragma unroll
                for (int j = 0; j < 8; ++j) { const int s = s0 + j; const bool fw = s < lrow;
                    const float d = fw ? al - as_[j] : rl - rs_[j]; float v = __expf(d) * (fw ? df_[j] : db_[j]); v = (s == lrow) ? dd : v; cbv[j] = cbv[j] * v + ((s == lrow) ? dskip : 0.f); }
                const u32x4 pk = pack8(cbv); const bf16x8 gfr = __builtin_bit_cast(bf16x8, pk);
#pragma unroll
                for (int pt = 0; pt < 4; ++pt) acc[lt][pt] = __builtin_amdgcn_mfma_f32_16x16x32_bf16(bx[pt], gfr, acc[lt][pt], 0, 0, 0);
                __builtin_amdgcn_sched_barrier(0);
            }
        }
#pragma unroll
        for (int lt = 0; lt < 4; ++lt) { float sq = 0.f;
#pragma unroll
            for (int pt = 0; pt < 4; ++pt) { const float z0 = bflo(zr[lt][pt].x), z1 = bfhi(zr[lt][pt].x), z2 = bflo(zr[lt][pt].y), z3 = bfhi(zr[lt][pt].y);
                f32x4 y = acc[lt][pt]; y[0] *= silu_f(z0); y[1] *= silu_f(z1); y[2] *= silu_f(z2); y[3] *= silu_f(z3); acc[lt][pt] = y;
                sq += (y[0] * y[0] + y[1] * y[1]) + (y[2] * y[2] + y[3] * y[3]); }
            sq += __shfl_xor(sq, 16); sq += __shfl_xor(sq, 32);
            if (fq == 0) sm_ss[(64 * lh + 16 * lt + fr) * 4 + hh] = sq; }
        __syncthreads();
        f32x4 nwv[4];
#pragma unroll
        for (int pt = 0; pt < 4; ++pt) nwv[pt] = *(const f32x4*)(nw + 256 * g + 64 * hh + 32 * (pt >> 1) + 8 * fq + 4 * (pt & 1));
#pragma unroll
        for (int lt = 0; lt < 4; ++lt) { const int lrow = 64 * lh + 16 * lt + fr; const f32x4 sv = *(const f32x4*)(sm_ss + lrow * 4);
            const float rs = rsqrtf(((sv[0] + sv[1]) + (sv[2] + sv[3])) * (1.0f / 256.0f) + EPS);
#pragma unroll
            for (int q = 0; q < 2; ++q) { const f32x4 y0 = acc[lt][2 * q] * rs * nwv[2 * q], y1 = acc[lt][2 * q + 1] * rs * nwv[2 * q + 1]; u32x4 w; w.x = pk2(y0[0], y0[1]); w.y = pk2(y0[2], y0[3]); w.z = pk2(y1[0], y1[1]); w.w = pk2(y1[2], y1[3]);
                *(u32x4*)(P + (size_t)(t0 + lrow) * LDP + PC_Z + 256 * g + 64 * hh + 32 * q + 8 * fq) = w; } }
    }
}

#define XB_TMO      128
#define XB_XCNT(j)  (256  + 64 * (j))
#define XB_XSUB(j)  (1280 + 64 * (j))
#define XB_XGEN(j)  (2304 + 64 * (j))
#define XB_TOP      3328
#define XB_TOPGEN   3392
#define XCD_BAR_WORDS 3456
#define XB_SPIN_CAP (1u << 20)
__device__ __forceinline__ unsigned xb_ld(unsigned* p)              { return __hip_atomic_load(p, __ATOMIC_RELAXED, __HIP_MEMORY_SCOPE_AGENT); }
__device__ __forceinline__ unsigned xb_add(unsigned* p, unsigned v) { return __hip_atomic_fetch_add(p, v, __ATOMIC_RELAXED, __HIP_MEMORY_SCOPE_AGENT); }
__device__ __forceinline__ unsigned xb_xcc_id() { return (unsigned)__builtin_amdgcn_s_getreg((3 << 11) | 20) & 0xFu; }
#define XB_SPIN(cond, bar) do { unsigned _sp = 0; while (cond) { __builtin_amdgcn_s_sleep(1); \
    if ((++_sp & 255u) == 0u) { if (xb_ld(&(bar)[XB_TMO])) break; if (_sp > XB_SPIN_CAP) { atomicAdd(&(bar)[XB_TMO], 1u); break; } } } } while (0)
struct XcdBarrier { unsigned* bar; unsigned x; volatile PG8_LAS unsigned* st; };
__device__ __forceinline__ XcdBarrier xcd_barrier_post(unsigned* bar, volatile PG8_LAS unsigned* st) {
    XcdBarrier b; b.bar = bar; b.x = xb_xcc_id(); b.st = st;
    if (threadIdx.x == 0) (void)xb_add(&bar[XB_XCNT(b.x)], 1u);
    return b;
}
__device__ __forceinline__ void xcd_barrier_complete(unsigned* bar, unsigned x, unsigned& nloc, unsigned& nx) {
    const unsigned G = gridDim.x * gridDim.y * gridDim.z;
    unsigned sum, cnt, mine, sp = 0u;
    for (;;) {
        sum = 0u; cnt = 0u; mine = 0u;
#pragma unroll
        for (unsigned j = 0; j < 16; ++j) { const unsigned c = xb_ld(&bar[XB_XCNT(j)]); sum += c; cnt += (c > 0u) ? 1u : 0u; mine = (j == x) ? c : mine; }
        if (sum == G) break;
        __builtin_amdgcn_s_sleep(1);
        if ((++sp & 255u) == 0u) { if (xb_ld(&bar[XB_TMO])) break; if (sp > XB_SPIN_CAP) { atomicAdd(&bar[XB_TMO], 1u); break; } }
    }
    nloc = mine > 0u ? mine : 1u; nx = cnt > 0u ? cnt : 1u;
}
__device__ __forceinline__ void xcd_barrier(const XcdBarrier& b) {
    asm volatile("s_waitcnt vmcnt(0)" ::: "memory");
    __syncthreads();
    if (threadIdx.x == 0) {
        unsigned* bar = b.bar;
        __builtin_amdgcn_s_waitcnt(0);
        unsigned nloc = b.st[0], nx = b.st[1];
        if (nloc == 0u) { xcd_barrier_complete(bar, b.x, nloc, nx); b.st[0] = nloc; b.st[1] = nx; }
        const unsigned old = xb_add(&bar[XB_XSUB(b.x)], 1u);
        const unsigned gen = old / nloc;
        if (old + 1u == (gen + 1u) * nloc) {
            __builtin_amdgcn_fence(__ATOMIC_RELEASE, "agent");
            asm volatile("s_waitcnt vmcnt(0)" ::: "memory");
            const unsigned og = xb_add(&bar[XB_TOP], 1u);
            const unsigned tg = og / nx;
            if (og + 1u == (tg + 1u) * nx) xb_add(&bar[XB_TOPGEN], 1u);
            else XB_SPIN(xb_ld(&bar[XB_TOPGEN]) == tg, bar);
            __builtin_amdgcn_fence(__ATOMIC_ACQUIRE, "agent");
            xb_add(&bar[XB_XGEN(b.x)], 1u);
            asm volatile("s_waitcnt vmcnt(0)" ::: "memory");
        } else {
            XB_SPIN(xb_ld(&bar[XB_XGEN(b.x)]) == gen, bar);
            __builtin_amdgcn_fence(__ATOMIC_ACQUIRE, "agent");
            asm volatile("s_waitcnt vmcnt(0)" ::: "memory");
        }
    }
    __syncthreads();
}

constexpr int PH_PER_HALF = 16, N_PHASES = NPART * PH_PER_HALF;
__global__ void __launch_bounds__(512, 2) mega(Params p0) {
    extern __shared__ __attribute__((aligned(16))) unsigned char smem[];
    cg::grid_group grid = cg::this_grid();
    volatile PG8_LAS unsigned* xst = (volatile PG8_LAS unsigned*)((PG8_LAS unsigned char*)smem + (LDS_BYTES - 16));
    if (threadIdx.x == 0) { xst[0] = 0u; xst[1] = 0u; }
    __syncthreads();
    const XcdBarrier xb = xcd_barrier_post((unsigned*)(p0.ws + OFF_BAR), xst);
    for (int ph = p0.ph_lo; ph < p0.ph_hi; ++ph) {
        const int hf = ph / PH_PER_HALF, lp = ph % PH_PER_HALF;
        if (hf >= 1 && lp == 0) continue;
        Params p = p0; asm volatile("" : "+s"(p.ws), "+s"(p.out));
        unsigned char* ws = p.ws;
        float* rowss = (float*)(ws + OFF_ROWSS) + (size_t)hf * 5 * TH * 16;
        bf16_t* HB = (bf16_t*)(ws + OFF_HB);
        if (lp == 0) {
#ifdef REP0
            for (int rep = 0; rep < 2; ++rep) {
#endif
            if (hf == 0) phase_weights(p, (float*)smem);
            phase_prep(p, hf);
#ifdef REP0
            }
#endif
        } else if (lp == 15) {
            phase_final(p, hf);
            if (hf + 1 < NPART) phase_prep(p, hf + 1);
        } else {
            const int l = (lp - 1) / 7, k = (lp - 1) % 7;
#ifdef REPK
            for (int rep = 0; rep < ((REPK) ? 2 : 1); ++rep) {
#endif
            unsigned char* wb = ws + (size_t)l * WL_B;
            float* hout = p.out + (size_t)hf * TH * DM;
            if (k == 0) {
                pg8::Gemm g{HB, (const bf16_t*)wb, TH, NIN, DM}; pg8::StaticOrder S; S.init(TH, NIN, gridDim.x, blockIdx.x);
                EpiIn E{(bf16_t*)(ws + OFF_PROJ), rowss + (size_t)(2 * l) * TH * 16, (float*)(smem + 131072), (float*)(smem + 132096), p.in[I_CXW] + (size_t)l * 3 * 2048, p.in[I_CXB] + (size_t)l * 2048,
                        (float*)(ws + OFF_XEDGER), (float*)(ws + OFF_XEDGEP), -1};
                phase_dt(p, l, rowss + (size_t)(2 * l) * TH * 16);
                pg8::gemm_phase<EpiIn, pg8::StaticOrder, true, true>((PG8_LAS unsigned char*)smem, g, S, E);
            } else if (k == 1) {
#ifndef NO_STATES
                phase_ssd_states(p, l, smem);
#endif
            } else if (k == 2) {
                phase_ssd_scan(p);
            } else if (k == 3) {
#ifndef NO_OUT
                phase_ssd_out(p, l, smem);
#endif
                phase_shortconv(p, l);
            } else if (k == 4) {
                pg8::Gemm g{(const bf16_t*)(ws + OFF_PROJ), (const bf16_t*)(wb + WT_IN_B), TH, DM, DMIX, LDP}; pg8::StaticOrder S; S.init(TH, DM, gridDim.x, blockIdx.x);
                EpiRes E{HB, rowss + (size_t)(2 * l + 1) * TH * 16};
                pg8::gemm_phase<EpiRes, pg8::StaticOrder, true, true>((PG8_LAS unsigned char*)smem, g, S, E);
#ifdef REP4
                if (l == 0) pg8::gemm_phase<EpiRes, pg8::StaticOrder, true, true>((PG8_LAS unsigned char*)smem, g, S, E);
#endif
            } else if (k == 5) {
                pg8::Gemm g{HB, (const bf16_t*)(wb + WT_IN_B + WT_OUT_B), TH, NUP, DM}; pg8::StaticOrder S; S.init(TH, NUP, gridDim.x, blockIdx.x);
                EpiAct E{(bf16_t*)(ws + OFF_ACT), rowss + (size_t)(2 * l + 1) * TH * 16, (float*)(smem + 131072), (float*)(smem + 132096), p.in[I_FCW] + (size_t)l * 3 * NUP, p.in[I_FCB] + (size_t)l * NUP,
                         (float*)(ws + OFF_EDGER), (float*)(ws + OFF_EDGEP), -1};
                pg8::gemm_phase<EpiAct, pg8::StaticOrder, true, true>((PG8_LAS unsigned char*)smem, g, S, E);
            } else {
                pg8::Gemm g{(const bf16_t*)(ws + OFF_ACT), (const bf16_t*)(wb + WT_IN_B + WT_OUT_B + WT_UP_B), TH, DM, DFF}; pg8::StaticOrder S; S.init(TH, DM, gridDim.x, blockIdx.x);
                {
                    pg8::Unit uu; int last_pm = -1;
                    for (int i = 0; S.next(i, uu); ++i) if (uu.pm != last_pm) { last_pm = uu.pm; edgefix_panel(p, l, uu.pm); }
                    asm volatile("s_waitcnt vmcnt(0)" ::: "memory"); __syncthreads();
                }
                EpiRes E{HB, rowss + (size_t)(2 * l + 2) * TH * 16};
                pg8::gemm_phase<EpiRes, pg8::StaticOrder, true, true>((PG8_LAS unsigned char*)smem, g, S, E);
            }
#ifdef REPK
            }
#endif
        }
        if (ph + 1 < p0.ph_hi) { if (ph == 0) grid.sync(); else xcd_barrier(xb); }
    }
}


#ifndef MULTI_LAUNCH
#define MULTI_LAUNCH 0
#endif
extern "C" void kernel_launch(void* const* d_in, const int* in_sizes, int n_in, void* d_out, int out_size, void* d_ws, size_t ws_size, hipStream_t stream) {
    static int grid = 0;
    if (grid == 0) {
        if (n_in != 19 || ws_size < WS_NEED) { fprintf(stderr, "kernel_launch: unexpected n_in %d / ws_size %zu (need %zu)\n", n_in, ws_size, (size_t)WS_NEED); grid = -1; return; }
        int dev = 0, cus = 0, per_cu = 0;
        hipGetDevice(&dev); hipDeviceGetAttribute(&cus, hipDeviceAttributeMultiprocessorCount, dev);
        if (hipFuncSetAttribute((const void*)mega, hipFuncAttributeMaxDynamicSharedMemorySize, LDS_BYTES) != hipSuccess) { fprintf(stderr, "kernel_launch: hipFuncSetAttribute failed\n"); grid = -1; return; }
        if (hipOccupancyMaxActiveBlocksPerMultiprocessor(&per_cu, (const void*)mega, 512, LDS_BYTES) != hipSuccess || per_cu < 1) { fprintf(stderr, "kernel_launch: occupancy query says %d\n", per_cu); per_cu = 1; }
        (void)hipGetLastError();
        grid = cus * 1;
        fprintf(stderr, "kernel_launch: grid %d (cus %d, per_cu %d), ws %zu\n", grid, cus, per_cu, ws_size);
    }
    if (grid < 0) return;
#ifdef DBG_MEMSET
    (void)hipMemsetAsync(d_ws, 0, WS_END, stream); (void)hipMemsetAsync(d_out, 0, (size_t)out_size * 4, stream);
#endif
    (void)hipMemsetAsync((unsigned char*)d_ws + OFF_BAR, 0, 16384, stream);
    Params p{};
    for (int i = 0; i < 19; ++i) p.in[i] = (const float*)d_in[i];
    p.out = (float*)d_out; p.ws = (unsigned char*)d_ws;
#if MULTI_LAUNCH
    for (int ph = 0; ph < N_PHASES; ++ph) { p.ph_lo = ph; p.ph_hi = ph + 1; hipLaunchKernelGGL(mega, dim3(grid), dim3(512), LDS_BYTES, stream, p); }
#else
    p.ph_lo = 0; p.ph_hi = N_PHASES;
    void* args[] = {&p};
    hipError_t e = hipLaunchCooperativeKernel((const void*)mega, dim3(grid), dim3(512), args, LDS_BYTES, stream);
    if (e != hipSuccess) fprintf(stderr, "cooperative launch failed: %s (grid %d)\n", hipGetErrorString(e), grid);
#endif
}
```

```cpp
#include <hip/hip_runtime.h>
#include <hip/hip_cooperative_groups.h>
#include <cstdio>
#include <type_traits>
namespace cg = cooperative_groups;
namespace pg8 {
#define PG8_LAS __attribute__((address_space(3)))
typedef unsigned short bf16_t;
typedef short bf16x8 __attribute__((ext_vector_type(8)));
typedef float f32x4 __attribute__((ext_vector_type(4)));
typedef unsigned u32x4 __attribute__((ext_vector_type(4)));
constexpr int BM = 256, BK = 64, HALF = 128, HTB = HALF * BK * 2  , STAGE_BYTES = 8 * HTB, NXCD = 8, WGM = 8;

__host__ __device__ __forceinline__ int lds_byte(int r, int c) { const int st = (r >> 4) * 2 + (c >> 5), rr = r & 15, cc = c & 31, ob = rr * 64 + cc * 2; return st * 1024 + (ob ^ (((ob >> 9) & 1) << 5)); }
__host__ __device__ __forceinline__ void stage_rc(int b, int& R, int& C) { const int st = b / 1024, sb = b % 1024, swz = sb ^ (((sb >> 9) & 1) << 5); R = (st >> 1) * 16 + swz / 64; C = (st & 1) * 32 + (swz % 64) / 2; }
__host__ __device__ __forceinline__ int perm32(int rho) { const int n = rho >> 4, i = rho & 15; return 8 * (i >> 2) + 4 * n + (i & 3); }

struct Unit { int pm, pn; };
struct Gemm { const bf16_t* A; const bf16_t* Bt; int M, N, K; int lda = 0; };
struct StaticOrder {
    int nM, nN, nwg, G, c;
    __host__ __device__ void init(int M, int N, int G_, int c_) { nM = M / BM; nN = N / BM; nwg = nM * nN; G = G_; c = c_; }
    __host__ __device__ bool next(int i, Unit& u) const {
        const long L = (long)i * G + c; if (L >= nwg) return false;
        int wgid = (int)L; { const int q = nwg / NXCD, r = nwg % NXCD, xcd = wgid % NXCD, off = wgid / NXCD; wgid = (xcd < r ? xcd * (q + 1) : r * (q + 1) + (xcd - r) * q) + off; }
        const int nig = WGM * nN, gid = wgid / nig, fm = gid * WGM, gsz = (nM - fm) < WGM ? (nM - fm) : WGM;
        u.pm = fm + ((wgid % nig) % gsz); u.pn = (wgid % nig) / gsz; return true;
    }
    __device__ __forceinline__ void a_ready(const Unit&) const {}
    __device__ __forceinline__ void done(const Unit&) const {}
};
__device__ __forceinline__ unsigned cvt_pk_bf16(float lo, float hi) { unsigned r; asm volatile("v_cvt_pk_bf16_f32 %0, %1, %2" : "=v"(r) : "v"(lo), "v"(hi)); return r; }
template <class Epi, class Sched, bool ALIGN_EPI = false, bool SP2 = false>
__device__ __forceinline__ void gemm_phase(PG8_LAS unsigned char* lds, const Gemm g, const Sched& S, const Epi& E) {
    int tid_ = threadIdx.x; asm volatile("" : "+v"(tid_));
    const int tid = tid_, wid = __builtin_amdgcn_readfirstlane(tid >> 6), lane = tid & 63, wr = wid >> 2, wc = wid & 3, fr = lane & 15, fq = lane >> 4;
    const int K = g.K, nt = K / BK, LDA = g.lda ? g.lda : g.K;
    unsigned voffA[2], voffB[2];
#pragma unroll
    for (int i = 0; i < 2; ++i) { int R, C; stage_rc(tid * 16 + i * 8192, R, C); const int Rb = Epi::PERM ? ((R & ~31) + perm32(R & 31)) : R;
        voffA[i] = (unsigned)(R * LDA + C) * 2u; voffB[i] = (unsigned)(Rb * K + C) * 2u; }
    const size_t kstep = (size_t)(BK * 2);
    const size_t hstep = (size_t)HALF * K * 2;
    const size_t tstep = 2 * hstep;
    const size_t hstepA = (size_t)HALF * LDA * 2, tstepA = 2 * hstepA;
    const unsigned ldsw = (unsigned)wid * 1024u;
    const int aoff = lds_byte(wr * 64 + fr, fq * 8), boff = lds_byte(wc * 32 + fr, fq * 8);
#define PG8_SA(b, h) (((b) * 2 + (h)) * HTB)
#define PG8_SB(b, h) ((4 + (b) * 2 + (h)) * HTB)
#define PG8_STAGE(bufoff, gbase, voff) do { _Pragma("unroll") for (int _i = 0; _i < 2; ++_i) \
        __builtin_amdgcn_global_load_lds((const unsigned*)((const char*)(gbase) + (voff)[_i]), (PG8_LAS unsigned*)(lds + (bufoff) + ldsw + _i * 8192), 16, 0, 0); } while (0)
#define PG8_LDA(dst, b, h) do { _Pragma("unroll") for (int m = 0; m < 4; ++m) _Pragma("unroll") for (int k = 0; k < 2; ++k) dst[m][k] = *(const PG8_LAS bf16x8*)(lds + PG8_SA(b, h) + aoff + m * 2048 + k * 1024); } while (0)
#define PG8_LDB(dst, b, h) do { _Pragma("unroll") for (int n = 0; n < 2; ++n) _Pragma("unroll") for (int k = 0; k < 2; ++k) dst[n][k] = *(const PG8_LAS bf16x8*)(lds + PG8_SB(b, h) + boff + n * 2048 + k * 1024); } while (0)
#define PG8_MMA(ai, bj, At, Bt) do { __builtin_amdgcn_s_setprio(1); _Pragma("unroll") for (int m = 0; m < 4; ++m) _Pragma("unroll") for (int n = 0; n < 2; ++n) _Pragma("unroll") for (int k = 0; k < 2; ++k) \
        acc[ai][bj][m][n] = __builtin_amdgcn_mfma_f32_16x16x32_bf16(Bt[n][k], At[m][k], acc[ai][bj][m][n], 0, 0, 0); __builtin_amdgcn_s_setprio(0); } while (0)
#define PG8_WAIT_V(n) asm volatile("s_waitcnt vmcnt(" #n ")" ::: "memory")
#define PG8_WAIT_L(n) asm volatile("s_waitcnt lgkmcnt(" #n ")" ::: "memory")
#define PG8_BAR __builtin_amdgcn_s_barrier()
#define PG8_SCHED __builtin_amdgcn_sched_barrier(0)
    Unit cur, nxt; int ui = 0;
    if (!S.next(0, cur)) return;
    f32x4 acc[2][2][4][2];
#pragma unroll
    for (int a = 0; a < 2; ++a)
#pragma unroll
        for (int b = 0; b < 2; ++b)
#pragma unroll
            for (int m = 0; m < 4; ++m)
#pragma unroll
                for (int n = 0; n < 2; ++n) acc[a][b][m][n] = (f32x4){0.f, 0.f, 0.f, 0.f};
    bf16x8 At[4][2], B0[2][2], B1[2][2];
    const char* cA = (const char*)g.A + (size_t)cur.pm * tstepA; const char* cB = (const char*)g.Bt + (size_t)cur.pn * tstep;
    S.a_ready(cur);
    if constexpr (SP2) {
        PG8_STAGE(PG8_SB(0, 0), cB, voffB); PG8_STAGE(PG8_SB(0, 1), cB + hstep, voffB); PG8_STAGE(PG8_SA(0, 0), cA, voffA); PG8_STAGE(PG8_SA(0, 1), cA + hstepA, voffA);
        if (wr == 1) PG8_BAR;
        PG8_WAIT_V(2); PG8_BAR;
        PG8_STAGE(PG8_SB(1, 0), cB + kstep, voffB); PG8_STAGE(PG8_SA(1, 0), cA + kstep, voffA); PG8_STAGE(PG8_SB(1, 1), cB + hstep + kstep, voffB);
        PG8_WAIT_V(6); PG8_BAR;
    } else {
        PG8_STAGE(PG8_SB(0, 0), cB, voffB); PG8_STAGE(PG8_SA(0, 0), cA, voffA); PG8_STAGE(PG8_SB(0, 1), cB + hstep, voffB); PG8_STAGE(PG8_SA(0, 1), cA + hstepA, voffA);
        if (wr == 1) PG8_BAR;
        PG8_WAIT_V(4); PG8_BAR;
        PG8_STAGE(PG8_SB(1, 0), cB + kstep, voffB); PG8_STAGE(PG8_SA(1, 0), cA + kstep, voffA); PG8_STAGE(PG8_SB(1, 1), cB + hstep + kstep, voffB);
        PG8_WAIT_V(6); PG8_BAR;
    }
    for (;;) {
        const bool has_next = S.next(ui + 1, nxt);
        const char* nA = has_next ? (const char*)g.A + (size_t)nxt.pm * tstepA : cA; const char* nB = has_next ? (const char*)g.Bt + (size_t)nxt.pn * tstep : cB;
        for (int t = 0; t < nt; t += 2) {
            const bool last = (t == nt - 2);
            const char* a1 = cA + (size_t)(t + 1) * kstep;
            const char* a2 = last ? nA : cA + (size_t)(t + 2) * kstep; const char* b2 = last ? nB : cB + (size_t)(t + 2) * kstep;
            const char* a3 = a2 + kstep; const char* b3 = b2 + kstep;
            if (last && has_next) S.a_ready(nxt);
            if constexpr (SP2) {
            PG8_LDB(B0, 0, 0); PG8_LDB(B1, 0, 1); PG8_SCHED; PG8_LDA(At, 0, 0); PG8_STAGE(PG8_SA(1, 1), a1 + hstepA, voffA);
            PG8_WAIT_V(8); PG8_WAIT_L(0); PG8_BAR; PG8_MMA(0, 0, At, B0); PG8_MMA(0, 1, At, B1); PG8_BAR; PG8_SCHED;
            PG8_LDA(At, 0, 1); PG8_STAGE(PG8_SB(0, 0), b2, voffB); PG8_STAGE(PG8_SB(0, 1), b2 + hstep, voffB); PG8_STAGE(PG8_SA(0, 0), a2, voffA);
            PG8_WAIT_V(8); PG8_WAIT_L(0); PG8_BAR; PG8_MMA(1, 0, At, B0); PG8_MMA(1, 1, At, B1); PG8_BAR; PG8_SCHED;
            PG8_LDB(B0, 1, 0); PG8_LDB(B1, 1, 1); PG8_SCHED; PG8_LDA(At, 1, 0); PG8_STAGE(PG8_SA(0, 1), a2 + hstepA, voffA);
            PG8_WAIT_V(8); PG8_WAIT_L(0); PG8_BAR; PG8_MMA(0, 0, At, B0); PG8_MMA(0, 1, At, B1); PG8_BAR; PG8_SCHED;
            PG8_LDA(At, 1, 1); PG8_STAGE(PG8_SB(1, 0), b3, voffB); PG8_STAGE(PG8_SB(1, 1), b3 + hstep, voffB); PG8_STAGE(PG8_SA(1, 0), a3, voffA);
            PG8_WAIT_V(8); PG8_WAIT_L(0); PG8_BAR; PG8_MMA(1, 0, At, B0); PG8_MMA(1, 1, At, B1); PG8_BAR; PG8_SCHED;
            } else {
            PG8_LDB(B0, 0, 0); PG8_SCHED; PG8_LDA(At, 0, 0); PG8_STAGE(PG8_SA(1, 1), a1 + hstepA, voffA);
            PG8_WAIT_L(8); PG8_BAR; PG8_WAIT_L(0); PG8_MMA(0, 0, At, B0); PG8_BAR; PG8_SCHED;
            PG8_LDB(B1, 0, 1); PG8_STAGE(PG8_SB(0, 0), b2, voffB);
            PG8_BAR; PG8_WAIT_L(0); PG8_MMA(0, 1, At, B1); PG8_BAR;
            PG8_LDA(At, 0, 1); PG8_STAGE(PG8_SA(0, 0), a2, voffA);
            PG8_BAR; PG8_WAIT_L(0); PG8_MMA(1, 0, At, B0); PG8_BAR; PG8_SCHED;
            PG8_STAGE(PG8_SB(0, 1), b2 + hstep, voffB);
            PG8_WAIT_V(6); PG8_BAR; PG8_MMA(1, 1, At, B1); PG8_BAR;
            PG8_LDB(B0, 1, 0); PG8_SCHED; PG8_LDA(At, 1, 0); PG8_STAGE(PG8_SA(0, 1), a2 + hstepA, voffA);
            PG8_WAIT_L(8); PG8_BAR; PG8_WAIT_L(0); PG8_MMA(0, 0, At, B0); PG8_BAR; PG8_SCHED;
            PG8_LDB(B1, 1, 1); PG8_STAGE(PG8_SB(1, 0), b3, voffB);
            PG8_BAR; PG8_WAIT_L(0); PG8_MMA(0, 1, At, B1); PG8_BAR;
            PG8_LDA(At, 1, 1); PG8_STAGE(PG8_SA(1, 0), a3, voffA);
            PG8_BAR; PG8_WAIT_L(0); PG8_MMA(1, 0, At, B0); PG8_BAR; PG8_SCHED;
            PG8_STAGE(PG8_SB(1, 1), b3 + hstep, voffB);
            PG8_WAIT_V(6); PG8_BAR; PG8_MMA(1, 1, At, B1); PG8_BAR;
            }
        }
        if constexpr (ALIGN_EPI) { if (wr == 0) PG8_BAR; }
        if constexpr (!Epi::AFTER_DRAIN) { E(acc, cur, wr, wc, fr, fq); S.done(cur); }
        if (!has_next) break;
#pragma unroll
        for (int a = 0; a < 2; ++a)
#pragma unroll
            for (int b = 0; b < 2; ++b)
#pragma unroll
                for (int m = 0; m < 4; ++m)
#pragma unroll
                    for (int n = 0; n < 2; ++n) acc[a][b][m][n] = (f32x4){0.f, 0.f, 0.f, 0.f};
        cur = nxt; cA = nA; cB = nB; ++ui;
        if constexpr (ALIGN_EPI) { if (wr == 1) PG8_BAR; }
    }
    PG8_WAIT_V(0);
    if constexpr (!ALIGN_EPI) { if (wr == 0) PG8_BAR; }
    PG8_BAR;
    if constexpr (Epi::AFTER_DRAIN) { E.fused(acc, cur, wr, wc, fr, fq, lds, wid, lane); S.done(cur); }
#undef PG8_SA
#undef PG8_SB
#undef PG8_STAGE
#undef PG8_LDA
#undef PG8_LDB
#undef PG8_MMA
#undef PG8_WAIT_V
#undef PG8_WAIT_L
#undef PG8_BAR
#undef PG8_SCHED
}
}

using pg8::bf16_t; using pg8::bf16x8; using pg8::f32x4; using pg8::u32x4; using pg8::Unit;
typedef unsigned u32x2 __attribute__((ext_vector_type(2)));
#ifndef NPART
#define NPART 2
#endif
constexpr int TH = 65536 / NPART;
constexpr int NBP = TH / 4096;
constexpr int SEQ = 4096, DM = 1024, NIN = 6144, LDP = 5120, DFF = 2816, NUP = 5632, DMIX = 2048;
constexpr int LSTR = 136;
constexpr float EPS = 1e-5f;
constexpr int PC_Z = 0, PC_SB = 1024, PC_X = 2048, PC_P = 4096;
constexpr int LDS_BYTES = 152 * 1024;
constexpr size_t WT_IN_B = (size_t)NIN * DM * 2, WT_OUT_B = (size_t)DM * DMIX * 2, WT_UP_B = (size_t)NUP * DM * 2, WT_DN_B = (size_t)DM * DFF * 2;
constexpr size_t WL_B = WT_IN_B + WT_OUT_B + WT_UP_B + WT_DN_B;
constexpr size_t OFF_ROWSS = 2 * WL_B;
constexpr size_t OFF_CHDEC = OFF_ROWSS + (size_t)NPART * 5 * TH * 16 * 4;
constexpr size_t OFF_PROJ = OFF_CHDEC + (size_t)NBP * 32 * 16 * 2 * 4;
constexpr size_t OFF_DT = OFF_PROJ + (size_t)TH * LDP * 2;
constexpr size_t OFF_ST = OFF_DT + (size_t)TH * 32 * 4;
constexpr size_t OFF_HB = OFF_ST + (size_t)NBP * 32 * 16 * 2 * 8192 * 2;
constexpr size_t WS_END = OFF_HB + (size_t)TH * DM * 2;
constexpr size_t OFF_BAR = WS_END;
constexpr size_t OFF_EDGER = OFF_BAR + 16384;
constexpr size_t OFF_EDGEP = OFF_EDGER + (size_t)(TH / 256) * 2 * NUP * 4;
constexpr size_t OFF_WDT = OFF_EDGEP + (size_t)(TH / 256) * 2 * NUP * 4;
constexpr size_t OFF_XEDGER = OFF_WDT + (size_t)2 * 32 * DM * 2;
constexpr size_t OFF_XEDGEP = OFF_XEDGER + (size_t)(TH / 256) * 2 * 2048 * 4;
constexpr size_t OFF_DTCS = OFF_XEDGEP + (size_t)(TH / 256) * 2 * 2048 * 4;
constexpr size_t WS_NEED = OFF_DTCS + (size_t)NBP * 128 * 2048 * 4;
constexpr size_t OFF_ACT = OFF_PROJ;
static_assert((size_t)TH * DFF * 2 <= (size_t)TH * LDP * 2 && (size_t)TH * DM * 2 <= (size_t)NBP * 32 * 16 * 2 * 8192 * 2, "overlay sizes");
static_assert(OFF_HB % 256 == 0 && OFF_PROJ % 256 == 0 && OFF_ST % 256 == 0 && TH % 4096 == 0, "align");

struct Params {
    const float* in[19];
    float* out;
    unsigned char* ws;
    int ph_lo, ph_hi;
};
enum { I_X = 0, I_WIN, I_CXW, I_CXB, I_DTBF, I_DTBB, I_ALF, I_ALB, I_DSK, I_SNW, I_SCW, I_WOUT, I_N1, I_N2, I_WUP, I_FCW, I_FCB, I_WDN, I_FNW };

typedef __bf16 bf16x2_t __attribute__((ext_vector_type(2)));
typedef float f32x2_t __attribute__((ext_vector_type(2)));
__device__ __forceinline__ unsigned pk2(float lo, float hi) { const f32x2_t v = {lo, hi}; const bf16x2_t b = __builtin_convertvector(v, bf16x2_t); return __builtin_bit_cast(unsigned, b); }
__device__ __forceinline__ float bflo(unsigned w) { return __uint_as_float(w << 16); }
__device__ __forceinline__ float bfhi(unsigned w) { return __uint_as_float(w & 0xffff0000u); }
__device__ __forceinline__ float bf2f(bf16_t b) { return __uint_as_float(((unsigned)b) << 16); }
__device__ __forceinline__ float silu_f(float v) { return v * __builtin_amdgcn_rcpf(1.0f + __expf(-v)); }
__device__ __forceinline__ float softplus_f(float v) { return v > 20.0f ? v : log1pf(__expf(v)); }
__device__ __forceinline__ void unpack8(const u32x4 w, float (&f)[8]) { f[0] = bflo(w.x); f[1] = bfhi(w.x); f[2] = bflo(w.y); f[3] = bfhi(w.y); f[4] = bflo(w.z); f[5] = bfhi(w.z); f[6] = bflo(w.w); f[7] = bfhi(w.w); }
__device__ __forceinline__ u32x4 pack8(const float (&f)[8]) { u32x4 w; w.x = pk2(f[0], f[1]); w.y = pk2(f[2], f[3]); w.z = pk2(f[4], f[5]); w.w = pk2(f[6], f[7]); return w; }

__device__ __forceinline__ float row_rs(const float* rowss, int row) {
    const f32x4 a = *(const f32x4*)(rowss + (size_t)row * 16), b = *(const f32x4*)(rowss + (size_t)row * 16 + 4), c = *(const f32x4*)(rowss + (size_t)row * 16 + 8), d = *(const f32x4*)(rowss + (size_t)row * 16 + 12);
    const float s = (((a[0] + a[1]) + (a[2] + a[3])) + ((b[0] + b[1]) + (b[2] + b[3]))) + (((c[0] + c[1]) + (c[2] + c[3])) + ((d[0] + d[1]) + (d[2] + d[3])));
    return rsqrtf(s * (1.0f / 1024.0f) + EPS);
}
__device__ __forceinline__ void panel_rs(const float* rowss, int pm, int& cached_pm, float* rs_lds) {
    if (pm != cached_pm) {
        cached_pm = pm;
        int tid_ = threadIdx.x; asm volatile("" : "+v"(tid_));
        __syncthreads();
        if (tid_ < 256) rs_lds[tid_] = row_rs(rowss, pm * 256 + tid_);
        __syncthreads();
    }
}
struct EpiUp {
    static constexpr bool PERM = true, AFTER_DRAIN = false;
    bf16_t* U; const float* rowss; float* rs_lds; mutable int cached_pm;
    __device__ __forceinline__ void operator()(const f32x4 (&acc)[2][2][4][2], const Unit& u, int wr, int wc, int fr, int fq) const {
        const int row0 = u.pm * 256 + wr * 64 + fr;
        panel_rs(rowss, u.pm, cached_pm, rs_lds);
#pragma unroll
        for (int ai = 0; ai < 2; ++ai)
#pragma unroll
            for (int m = 0; m < 4; ++m) {
                const int row = row0 + ai * 128 + m * 16;
                const float rs = rs_lds[row & 255];
#pragma unroll
                for (int bj = 0; bj < 2; ++bj) { const f32x4 v0 = acc[ai][bj][m][0] * rs, v1 = acc[ai][bj][m][1] * rs; u32x4 w; w.x = pk2(v0[0], v0[1]); w.y = pk2(v0[2], v0[3]); w.z = pk2(v1[0], v1[1]); w.w = pk2(v1[2], v1[3]);
                    *(u32x4*)(U + (size_t)row * NUP + u.pn * 256 + bj * 128 + wc * 32 + 8 * fq) = w; }
            }
    }
};
struct EpiRes {
    static constexpr bool PERM = true, AFTER_DRAIN = false;
    bf16_t* HB; float* rowss_next;
    __device__ __forceinline__ void operator()(const f32x4 (&acc)[2][2][4][2], const Unit& u, int wr, int wc, int fr, int fq) const {
        const int row0 = u.pm * 256 + wr * 64 + fr, col0 = u.pn * 256 + wc * 32 + 8 * fq;
#pragma unroll
        for (int ai = 0; ai < 2; ++ai)
#pragma unroll
            for (int m = 0; m < 4; ++m) {
                const int row = row0 + ai * 128 + m * 16; float ss = 0.f;
#pragma unroll
                for (int bj = 0; bj < 2; ++bj) { const size_t off = (size_t)row * DM + col0 + bj * 128;
                    const u32x4 hb = *(const u32x4*)(HB + off);
                    f32x4 o0 = acc[ai][bj][m][0], o1 = acc[ai][bj][m][1];
                    o0[0] += bflo(hb.x); o0[1] += bfhi(hb.x); o0[2] += bflo(hb.y); o0[3] += bfhi(hb.y); o1[0] += bflo(hb.z); o1[1] += bfhi(hb.z); o1[2] += bflo(hb.w); o1[3] += bfhi(hb.w);
                    u32x4 w; w.x = pk2(o0[0], o0[1]); w.y = pk2(o0[2], o0[3]); w.z = pk2(o1[0], o1[1]); w.w = pk2(o1[2], o1[3]); *(u32x4*)(HB + off) = w;
                    ss += ((o0[0] * o0[0] + o0[1] * o0[1]) + (o0[2] * o0[2] + o0[3] * o0[3])) + ((o1[0] * o1[0] + o1[1] * o1[1]) + (o1[2] * o1[2] + o1[3] * o1[3])); }
                ss += __shfl_xor(ss, 16); ss += __shfl_xor(ss, 32);
                if (fq == 0) rowss_next[(size_t)row * 16 + u.pn * 4 + wc] = ss;
            }
    }
};


__device__ __forceinline__ float dpp_shr1(float old, float src) { return __builtin_bit_cast(float, __builtin_amdgcn_update_dpp(__builtin_bit_cast(int, old), __builtin_bit_cast(int, src), 0x111, 0xf, 0xf, false)); }
__device__ __forceinline__ float dpp_shl1(float old, float src) { return __builtin_bit_cast(float, __builtin_amdgcn_update_dpp(__builtin_bit_cast(int, old), __builtin_bit_cast(int, src), 0x101, 0xf, 0xf, false)); }
__device__ __forceinline__ float dpp_ror1(float src) { return __builtin_bit_cast(float, __builtin_amdgcn_update_dpp(0, __builtin_bit_cast(int, src), 0x121, 0xf, 0xf, false)); }
__device__ __forceinline__ float dpp_rol1(float src) { return __builtin_bit_cast(float, __builtin_amdgcn_update_dpp(0, __builtin_bit_cast(int, src), 0x12F, 0xf, 0xf, false)); }
struct EpiIn {
    static constexpr bool PERM = true, AFTER_DRAIN = false;
    bf16_t* P; const float* rowss; float* rs_lds; float* xch; const float* cxw; const float* cxb; float* XEDGER; float* XEDGEP; mutable int cached_pm;
    __device__ __forceinline__ void operator()(const f32x4 (&acc_)[2][2][4][2], const Unit& u, int wr, int wc, int fr_, int fq_) const {
        f32x4 (&acc)[2][2][4][2] = const_cast<f32x4 (&)[2][2][4][2]>(acc_);
        int fr = fr_, fq = fq_; asm volatile("" : "+v"(fr), "+v"(fq));
        const int row0 = u.pm * 256 + wr * 64 + fr; const int pn = u.pn;
        panel_rs(rowss, u.pm, cached_pm, rs_lds);
        if (pn >= 4 && pn < 12) {
#pragma unroll
            for (int ai = 0; ai < 2; ++ai)
#pragma unroll
                for (int m = 0; m < 4; ++m) { const float rs = rs_lds[ai * 128 + wr * 64 + m * 16 + fr];
#pragma unroll
                    for (int bj = 0; bj < 2; ++bj)
#pragma unroll
                        for (int n = 0; n < 2; ++n) acc[ai][bj][m][n] *= rs; }
#pragma unroll
            for (int ai = 0; ai < 2; ++ai) { const int seg = 2 * ai + wr;
                if (fr == 0) {
#pragma unroll
                    for (int bj = 0; bj < 2; ++bj)
#pragma unroll
                        for (int n = 0; n < 2; ++n) *(f32x4*)(xch + (((seg * 2 + 0) * 4 + wc) * 4 + fq) * 16 + bj * 8 + n * 4) = acc[ai][bj][0][n]; }
                if (fr == 15) {
#pragma unroll
                    for (int bj = 0; bj < 2; ++bj)
#pragma unroll
                        for (int n = 0; n < 2; ++n) *(f32x4*)(xch + (((seg * 2 + 1) * 4 + wc) * 4 + fq) * 16 + bj * 8 + n * 4) = acc[ai][bj][3][n]; } }
            __syncthreads();
            auto body = [&](auto BJ_, auto AI_) {
                constexpr int bj = decltype(BJ_)::value, ai = decltype(AI_)::value;
                const int ch = (pn - 4) * 256 + bj * 128 + wc * 32 + 8 * fq, seg = 2 * ai + wr;
                f32x4 w0[2], w1[2], w2[2], bb[2];
#pragma unroll
                for (int n = 0; n < 2; ++n) { w0[n] = *(const f32x4*)(cxw + ch + 4 * n); w1[n] = *(const f32x4*)(cxw + 2048 + ch + 4 * n); w2[n] = *(const f32x4*)(cxw + 4096 + ch + 4 * n); bb[n] = *(const f32x4*)(cxb + ch + 4 * n); }
#pragma unroll
                for (int m = 0; m < 4; ++m) {
                    f32x4 pr[2], pe[2], ne[2];
#pragma unroll
                    for (int n = 0; n < 2; ++n) { pe[n] = (f32x4){0.f, 0.f, 0.f, 0.f}; ne[n] = pe[n];
                        if (m == 0 && seg > 0) pe[n] = *(const f32x4*)(xch + ((((seg - 1) * 2 + 1) * 4 + wc) * 4 + fq) * 16 + bj * 8 + n * 4);
                        if (m == 3 && seg < 3) ne[n] = *(const f32x4*)(xch + ((((seg + 1) * 2 + 0) * 4 + wc) * 4 + fq) * 16 + bj * 8 + n * 4); }
#pragma unroll
                    for (int n = 0; n < 2; ++n)
#pragma unroll
                        for (int j = 0; j < 4; ++j) {
                            const float cur = acc[ai][bj][m][n][j];
                            const float ov = (m > 0) ? dpp_ror1(acc[ai][bj][m > 0 ? m - 1 : 0][n][j]) : pe[n][j];
                            const float nv = (m < 3) ? dpp_rol1(acc[ai][bj][m < 3 ? m + 1 : 3][n][j]) : ne[n][j];
                            const float prev = dpp_shr1(ov, cur), next = dpp_shl1(nv, cur);
                            pr[n][j] = w0[n][j] * prev + w1[n][j] * cur + w2[n][j] * next + bb[n][j]; }
                    const int row = u.pm * 256 + ai * 128 + wr * 64 + m * 16 + fr;
                    u32x4 w; w.x = pk2(silu_f(pr[0][0]), silu_f(pr[0][1])); w.y = pk2(silu_f(pr[0][2]), silu_f(pr[0][3])); w.z = pk2(silu_f(pr[1][0]), silu_f(pr[1][1])); w.w = pk2(silu_f(pr[1][2]), silu_f(pr[1][3]));
                    *(u32x4*)(P + (size_t)row * LDP + PC_X + ch) = w;
                    if ((m == 0 && seg == 0 && fr == 0) || (m == 3 && seg == 3 && fr == 15)) {
                        const size_t eb = ((size_t)u.pm * 2 + (m == 0 ? 0 : 1)) * 2048 + ch;
                        *(f32x4*)(XEDGER + eb) = acc[ai][bj][m][0]; *(f32x4*)(XEDGER + eb + 4) = acc[ai][bj][m][1];
                        *(f32x4*)(XEDGEP + eb) = pr[0];             *(f32x4*)(XEDGEP + eb + 4) = pr[1]; }
                }
                __builtin_amdgcn_sched_barrier(0);
            };
            body(std::integral_constant<int, 0>{}, std::integral_constant<int, 0>{}); body(std::integral_constant<int, 0>{}, std::integral_constant<int, 1>{});
            body(std::integral_constant<int, 1>{}, std::integral_constant<int, 0>{}); body(std::integral_constant<int, 1>{}, std::integral_constant<int, 1>{});
            return;
        }
#pragma unroll
        for (int ai = 0; ai < 2; ++ai)
#pragma unroll
            for (int m = 0; m < 4; ++m) {
                const int row = row0 + ai * 128 + m * 16;
                const float rs = rs_lds[row & 255];
                if (pn < 16) {
                    const int cbase = (pn < 4 ? PC_Z + pn * 256 : PC_SB + (pn - 12) * 256);
#pragma unroll
                    for (int bj = 0; bj < 2; ++bj) { const f32x4 v0 = acc[ai][bj][m][0] * rs, v1 = acc[ai][bj][m][1] * rs; u32x4 w; w.x = pk2(v0[0], v0[1]); w.y = pk2(v0[2], v0[3]); w.z = pk2(v1[0], v1[1]); w.w = pk2(v1[2], v1[3]);
                        *(u32x4*)(P + (size_t)row * LDP + cbase + bj * 128 + wc * 32 + 8 * fq) = w; }
                } else {
                    const float rs2 = rs * rs; const f32x4 v0 = acc[ai][0][m][0] * acc[ai][1][m][0] * rs2, v1 = acc[ai][0][m][1] * acc[ai][1][m][1] * rs2;
                    u32x4 w; w.x = pk2(v0[0], v0[1]); w.y = pk2(v0[2], v0[3]); w.z = pk2(v1[0], v1[1]); w.w = pk2(v1[2], v1[3]);
                    *(u32x4*)(P + (size_t)row * LDP + PC_P + (pn - 16) * 128 + wc * 32 + 8 * fq) = w;
                }
            }
    }
};
struct EpiAct {
    static constexpr bool PERM = true, AFTER_DRAIN = false;
    bf16_t* ACT; const float* rowss; float* rs_lds; float* xch; const float* cw; const float* cb; float* EDGER; float* EDGEP; mutable int cached_pm;
    __device__ __forceinline__ void operator()(const f32x4 (&acc_)[2][2][4][2], const Unit& u, int wr, int wc, int fr_, int fq_) const {
        int fr = fr_, fq = fq_; asm volatile("" : "+v"(fr), "+v"(fq));
        f32x4 (&acc)[2][2][4][2] = const_cast<f32x4 (&)[2][2][4][2]>(acc_);
        panel_rs(rowss, u.pm, cached_pm, rs_lds);
#pragma unroll
        for (int ai = 0; ai < 2; ++ai)
#pragma unroll
            for (int m = 0; m < 4; ++m) { const float rs = rs_lds[ai * 128 + wr * 64 + m * 16 + fr];
#pragma unroll
                for (int bj = 0; bj < 2; ++bj)
#pragma unroll
                    for (int n = 0; n < 2; ++n) acc[ai][bj][m][n] *= rs; }
#pragma unroll
        for (int ai = 0; ai < 2; ++ai) { const int seg = 2 * ai + wr;
            if (fr == 0) {
#pragma unroll
                for (int bj = 0; bj < 2; ++bj)
#pragma unroll
                    for (int n = 0; n < 2; ++n) *(f32x4*)(xch + (((seg * 2 + 0) * 4 + wc) * 4 + fq) * 16 + bj * 8 + n * 4) = acc[ai][bj][0][n]; }
            if (fr == 15) {
#pragma unroll
                for (int bj = 0; bj < 2; ++bj)
#pragma unroll
                    for (int n = 0; n < 2; ++n) *(f32x4*)(xch + (((seg * 2 + 1) * 4 + wc) * 4 + fq) * 16 + bj * 8 + n * 4) = acc[ai][bj][3][n]; } }
        const int f0 = u.pn * 128 + wc * 32 + 8 * fq;
        f32x4 w0v[8];
        { const int f = f0; w0v[0] = *(const f32x4*)(cw + f); w0v[1] = *(const f32x4*)(cw + NUP + f); w0v[2] = *(const f32x4*)(cw + 2 * NUP + f); w0v[3] = *(const f32x4*)(cb + f);
          w0v[4] = *(const f32x4*)(cw + DFF + f); w0v[5] = *(const f32x4*)(cw + NUP + DFF + f); w0v[6] = *(const f32x4*)(cw + 2 * NUP + DFF + f); w0v[7] = *(const f32x4*)(cb + DFF + f); }
        __syncthreads();
        auto body = [&](auto N_, auto AI_, const f32x4 (&wv)[8]) {
            constexpr int n = decltype(N_)::value, ai = decltype(AI_)::value;
            const int f = f0 + 4 * n, seg = 2 * ai + wr;
            const f32x4 wg0 = wv[0], wg1 = wv[1], wg2 = wv[2], bg = wv[3], wu0 = wv[4], wu1 = wv[5], wu2 = wv[6], bu = wv[7];
            f32x4 peg = (f32x4){0.f, 0.f, 0.f, 0.f}, peu = peg, neg = peg, neu = peg;
            if (seg > 0) { peg = *(const f32x4*)(xch + ((((seg - 1) * 2 + 1) * 4 + wc) * 4 + fq) * 16 + n * 4); peu = *(const f32x4*)(xch + ((((seg - 1) * 2 + 1) * 4 + wc) * 4 + fq) * 16 + 8 + n * 4); }
            if (seg < 3) { neg = *(const f32x4*)(xch + ((((seg + 1) * 2 + 0) * 4 + wc) * 4 + fq) * 16 + n * 4); neu = *(const f32x4*)(xch + ((((seg + 1) * 2 + 0) * 4 + wc) * 4 + fq) * 16 + 8 + n * 4); }
#pragma unroll
            for (int m = 0; m < 4; ++m) {
                const f32x4 sgm = acc[ai][0][m][n], sum_ = acc[ai][1][m][n];
                f32x4 pg, pu;
#pragma unroll
                for (int j = 0; j < 4; ++j) {
                    const float og = (m > 0) ? dpp_ror1(acc[ai][0][m > 0 ? m - 1 : 0][n][j]) : peg[j], ou = (m > 0) ? dpp_ror1(acc[ai][1][m > 0 ? m - 1 : 0][n][j]) : peu[j];
                    const float ng = (m < 3) ? dpp_rol1(acc[ai][0][m < 3 ? m + 1 : 3][n][j]) : neg[j], nu = (m < 3) ? dpp_rol1(acc[ai][1][m < 3 ? m + 1 : 3][n][j]) : neu[j];
                    const float gprev = dpp_shr1(og, sgm[j]), uprev = dpp_shr1(ou, sum_[j]);
                    const float gnext = dpp_shl1(ng, sgm[j]), unext = dpp_shl1(nu, sum_[j]);
                    pg[j] = wg0[j] * gprev + wg1[j] * sgm[j] + wg2[j] * gnext + bg[j];
                    pu[j] = wu0[j] * uprev + wu1[j] * sum_[j] + wu2[j] * unext + bu[j];
                }
                const int row = u.pm * 256 + ai * 128 + wr * 64 + m * 16 + fr;
                u32x2 w; w.x = pk2(silu_f(pg[0]) * pu[0], silu_f(pg[1]) * pu[1]); w.y = pk2(silu_f(pg[2]) * pu[2], silu_f(pg[3]) * pu[3]);
                *(u32x2*)(ACT + (size_t)row * DFF + f) = w;
                if ((m == 0 && seg == 0 && fr == 0) || (m == 3 && seg == 3 && fr == 15)) {
                    const size_t eb = ((size_t)u.pm * 2 + (m == 0 ? 0 : 1)) * NUP;
                    *(f32x4*)(EDGER + eb + f) = sgm; *(f32x4*)(EDGER + eb + DFF + f) = sum_;
                    *(f32x4*)(EDGEP + eb + f) = pg;  *(f32x4*)(EDGEP + eb + DFF + f) = pu; }
            }
        };
        body(std::integral_constant<int, 0>{}, std::integral_constant<int, 0>{}, w0v);
        f32x4 w1v[8];
        { const int f = f0 + 4; w1v[0] = *(const f32x4*)(cw + f); w1v[1] = *(const f32x4*)(cw + NUP + f); w1v[2] = *(const f32x4*)(cw + 2 * NUP + f); w1v[3] = *(const f32x4*)(cb + f);
          w1v[4] = *(const f32x4*)(cw + DFF + f); w1v[5] = *(const f32x4*)(cw + NUP + DFF + f); w1v[6] = *(const f32x4*)(cw + 2 * NUP + DFF + f); w1v[7] = *(const f32x4*)(cb + DFF + f); }
        __builtin_amdgcn_sched_barrier(0);
        body(std::integral_constant<int, 0>{}, std::integral_constant<int, 1>{}, w0v);
        __builtin_amdgcn_sched_barrier(0);
        body(std::integral_constant<int, 1>{}, std::integral_constant<int, 0>{}, w1v);
        __builtin_amdgcn_sched_barrier(0);
        body(std::integral_constant<int, 1>{}, std::integral_constant<int, 1>{}, w1v);
    }
};

__device__ __forceinline__ int src_in(int j) {
    if (j < 3072) return j;
    if (j < 4096) return j + 32;
    { const int t = (j - 4096) >> 8, r = (j - 4096) & 255; return r < 128 ? 4128 + t * 128 + r : 5152 + t * 128 + (r - 128); }
}
__device__ __forceinline__ void convert_weight(const float* W, int ldw, const float* scale, bf16_t* Wt, int K, int N, int kind, float* tile, int blk, int nblk) {
    int tid_ = threadIdx.x; asm volatile("" : "+v"(tid_));
    const int tid = tid_, nkt = K / 64, ntile = (N / 256) * nkt;
    for (int t = blk; t < ntile; t += nblk) {
        const int j0 = (t / nkt) * 256, k0 = (t % nkt) * 64;
        float v[32];
#pragma unroll
        for (int i = 0; i < 32; ++i) { const int kk = (tid >> 8) + 2 * i, jj = tid & 255; const int jx = j0 + jj; const int sj = kind == 1 ? src_in(jx) : (kind == 2 ? (((jx & 255) < 128) ? (jx >> 8) * 128 + (jx & 127) : DFF + (jx >> 8) * 128 + (jx & 127)) : jx);
            v[i] = W[(size_t)(k0 + kk) * ldw + (sj >= 0 ? sj : 0)]; if (sj < 0) v[i] = 0.f; }
        __syncthreads();
#pragma unroll
        for (int i = 0; i < 32; ++i) { const int kk = (tid >> 8) + 2 * i, jj = tid & 255; tile[kk * 257 + jj] = v[i]; }
        __syncthreads();
        const int kk = 2 * (tid & 31); const float s0 = scale ? scale[k0 + kk] : 1.0f, s1 = scale ? scale[k0 + kk + 1] : 1.0f;
#pragma unroll
        for (int i = 0; i < 16; ++i) { const int jj = (tid >> 5) + 16 * i;
            *(unsigned*)(Wt + (size_t)(j0 + jj) * K + k0 + kk) = pk2(tile[kk * 257 + jj] * s0, tile[(kk + 1) * 257 + jj] * s1); }
    }
}
__device__ __forceinline__ void phase_weights(const Params& p, float* tile) {
    const int G = gridDim.x; int cum = 0;
#define WBLK ((int)((blockIdx.x + (unsigned)G - (unsigned)(cum % G)) % (unsigned)G))
    for (int l = 0; l < 2; ++l) {
        unsigned char* wb = p.ws + (size_t)l * WL_B;
        convert_weight(p.in[I_WIN] + (size_t)l * DM * 6176, 6176, p.in[I_N1] + l * DM, (bf16_t*)wb, DM, NIN, 1, tile, WBLK, G); cum += (NIN / 256) * (DM / 64);
        convert_weight(p.in[I_WOUT] + (size_t)l * DMIX * DM, DM, nullptr, (bf16_t*)(wb + WT_IN_B), DMIX, DM, 0, tile, WBLK, G); cum += (DM / 256) * (DMIX / 64);
        convert_weight(p.in[I_WUP] + (size_t)l * DM * NUP, NUP, p.in[I_N2] + l * DM, (bf16_t*)(wb + WT_IN_B + WT_OUT_B), DM, NUP, 2, tile, WBLK, G); cum += (NUP / 256) * (DM / 64);
        convert_weight(p.in[I_WDN] + (size_t)l * DFF * DM, DM, nullptr, (bf16_t*)(wb + WT_IN_B + WT_OUT_B + WT_UP_B), DFF, DM, 0, tile, WBLK, G); cum += (DM / 256) * (DFF / 64);
    }
#undef WBLK
    {
        bf16_t* WDT = (bf16_t*)(p.ws + OFF_WDT); int tid_ = threadIdx.x; asm volatile("" : "+v"(tid_));
        for (int idx = blockIdx.x * 512 + tid_; idx < 2 * 32 * DM; idx += gridDim.x * 512) { const int l = idx >> 15, j = (idx >> 10) & 31, k = idx & 1023;
            const float v = p.in[I_WIN][((size_t)l * DM + k) * 6176 + 3072 + j] * p.in[I_N1][l * DM + k]; const unsigned w = pk2(v, v); WDT[idx] = (bf16_t)(w & 0xffffu); }
    }
}
__device__ __forceinline__ void phase_prep(const Params& p, int hf) {
    int tid_ = threadIdx.x; asm volatile("" : "+v"(tid_));
    const int tid = tid_, wid = tid >> 6, lane = tid & 63;
    float* rowss = (float*)(p.ws + OFF_ROWSS) + (size_t)hf * 5 * TH * 16;
    bf16_t* HB = (bf16_t*)(p.ws + OFF_HB);
    const float* x = p.in[I_X] + (size_t)hf * TH * DM;
#pragma unroll 4
    for (int row = blockIdx.x * 8 + wid; row < TH; row += gridDim.x * 8) {
        float ss = 0.f;
#pragma unroll
        for (int i = 0; i < 2; ++i) { const int c = i * 512 + lane * 8;
            const f32x4 v = *(const f32x4*)(x + (size_t)row * DM + c), v2 = *(const f32x4*)(x + (size_t)row * DM + c + 4);
            ss += ((v[0] * v[0] + v[1] * v[1]) + (v[2] * v[2] + v[3] * v[3])) + ((v2[0] * v2[0] + v2[1] * v2[1]) + (v2[2] * v2[2] + v2[3] * v2[3]));
            u32x4 w; w.x = pk2(v[0], v[1]); w.y = pk2(v[2], v[3]); w.z = pk2(v2[0], v2[1]); w.w = pk2(v2[2], v2[3]); *(u32x4*)(HB + (size_t)row * DM + c) = w; }
#pragma unroll
        for (int o = 32; o >= 1; o >>= 1) ss += __shfl_xor(ss, o);
        if (lane < 16) rowss[(size_t)row * 16 + lane] = lane == 0 ? ss : 0.f;
    }
}
__device__ __forceinline__ void phase_final(const Params& p, int hf) {
    int tid_ = threadIdx.x; asm volatile("" : "+v"(tid_));
    const int tid = tid_, wid = tid >> 6, lane = tid & 63;
    const float* rowss = (const float*)(p.ws + OFF_ROWSS) + ((size_t)hf * 5 + 4) * TH * 16;
    float* h = p.out + (size_t)hf * TH * DM; const float* w = p.in[I_FNW]; const bf16_t* HB = (const bf16_t*)(p.ws + OFF_HB);
#pragma unroll 4
    for (int row = blockIdx.x * 8 + wid; row < TH; row += gridDim.x * 8) {
        const float rs = row_rs(rowss, row);
#pragma unroll
        for (int i = 0; i < 2; ++i) { const int c = i * 512 + lane * 8; const u32x4 hb = *(const u32x4*)(HB + (size_t)row * DM + c); const f32x4 g = *(const f32x4*)(w + c), g2 = *(const f32x4*)(w + c + 4);
            f32x4 v, v2; v[0] = bflo(hb.x); v[1] = bfhi(hb.x); v[2] = bflo(hb.y); v[3] = bfhi(hb.y); v2[0] = bflo(hb.z); v2[1] = bfhi(hb.z); v2[2] = bflo(hb.w); v2[3] = bfhi(hb.w);
            *(f32x4*)(h + (size_t)row * DM + c) = v * rs * g; *(f32x4*)(h + (size_t)row * DM + c + 4) = v2 * rs * g2; }
    }
}
__device__ __forceinline__ void phase_edgefix(const Params& p, int l) {
    const float* EDGER = (const float*)(p.ws + OFF_EDGER); const float* EDGEP = (const float*)(p.ws + OFF_EDGEP); bf16_t* ACT = (bf16_t*)(p.ws + OFF_ACT);
    const float* cw = p.in[I_FCW] + (size_t)l * 3 * NUP;
    int tid_ = threadIdx.x; asm volatile("" : "+v"(tid_));
    for (int idx = blockIdx.x * 512 + tid_; idx < (TH / 256) * 2 * DFF; idx += gridDim.x * 512) {
        const int f = idx % DFF, pe = idx / DFF, e = pe & 1, pm = pe >> 1, t = 256 * pm + (e ? 255 : 0);
        const bool has = e ? (((t + 1) % SEQ) != 0) : ((t % SEQ) != 0);
        float ng = 0.f, nu = 0.f;
        if (has) { const size_t nb = ((size_t)(pm + (e ? 1 : -1)) * 2 + (e ? 0 : 1)) * NUP; ng = EDGER[nb + f]; nu = EDGER[nb + DFF + f]; }
        const int wk = e ? 2 : 0; const size_t eb = ((size_t)pm * 2 + e) * NUP;
        const float pg = EDGEP[eb + f] + cw[wk * NUP + f] * ng, pu = EDGEP[eb + DFF + f] + cw[wk * NUP + DFF + f] * nu;
        const float o = silu_f(pg) * pu; const unsigned w = pk2(o, o); ACT[(size_t)t * DFF + f] = (bf16_t)(w & 0xffffu);
    }
}
__device__ __forceinline__ void edgefix_panel(const Params& p, int l, int pm) {
    const float* EDGER = (const float*)(p.ws + OFF_EDGER); const float* EDGEP = (const float*)(p.ws + OFF_EDGEP); bf16_t* ACT = (bf16_t*)(p.ws + OFF_ACT);
    const float* cw = p.in[I_FCW] + (size_t)l * 3 * NUP;
    int tid_ = threadIdx.x; asm volatile("" : "+v"(tid_));
    for (int idx = tid_; idx < 2 * DFF; idx += 512) {
        const int e = idx >= DFF ? 1 : 0, f = idx - e * DFF, t = 256 * pm + (e ? 255 : 0);
        const bool has = e ? (((t + 1) % SEQ) != 0) : ((t % SEQ) != 0);
        float ng = 0.f, nu = 0.f;
        if (has) { const size_t nb = ((size_t)(pm + (e ? 1 : -1)) * 2 + (e ? 0 : 1)) * NUP; ng = EDGER[nb + f]; nu = EDGER[nb + DFF + f]; }
        const int wk = e ? 2 : 0; const size_t eb = ((size_t)pm * 2 + e) * NUP;
        const float pg = EDGEP[eb + f] + cw[wk * NUP + f] * ng, pu = EDGEP[eb + DFF + f] + cw[wk * NUP + DFF + f] * nu;
        const float o = silu_f(pg) * pu; const unsigned w = pk2(o, o); ACT[(size_t)t * DFF + f] = (bf16_t)(w & 0xffffu);
    }
}
__device__ __forceinline__ void phase_dt(const Params& p, int l, const float* rowss) {
    int tid_ = threadIdx.x; asm volatile("" : "+v"(tid_));
    const int wid = tid_ >> 6, lane = tid_ & 63, fr = lane & 15, fq = lane >> 4;
    const bf16_t* HB = (const bf16_t*)(p.ws + OFF_HB); const bf16_t* WDT = (const bf16_t*)(p.ws + OFF_WDT) + (size_t)l * 32 * DM; float* DT = (float*)(p.ws + OFF_DT);
    for (int tb = blockIdx.x; tb < TH / 128; tb += gridDim.x) {
        const int tok = tb * 128 + wid * 16 + fr;
        f32x4 a0 = (f32x4){0.f, 0.f, 0.f, 0.f}, a1 = a0;
#pragma unroll 1
        for (int k0 = 0; k0 < 32; k0 += 8) {
            bf16x8 hf[8], w0[8], w1[8];
#pragma unroll
            for (int i = 0; i < 8; ++i) { const int ko = 32 * (k0 + i) + 8 * fq;
                hf[i] = *(const bf16x8*)(HB + (size_t)tok * DM + ko); w0[i] = *(const bf16x8*)(WDT + (size_t)fr * DM + ko); w1[i] = *(const bf16x8*)(WDT + (size_t)(16 + fr) * DM + ko); }
#pragma unroll
            for (int i = 0; i < 8; ++i) { a0 = __builtin_amdgcn_mfma_f32_16x16x32_bf16(w0[i], hf[i], a0, 0, 0, 0); a1 = __builtin_amdgcn_mfma_f32_16x16x32_bf16(w1[i], hf[i], a1, 0, 0, 0); }
        }
        const float rs = row_rs(rowss, tok);
        *(f32x4*)(DT + (size_t)tok * 32 + 4 * fq) = a0 * rs; *(f32x4*)(DT + (size_t)tok * 32 + 16 + 4 * fq) = a1 * rs;
    }
}
__device__ __forceinline__ void phase_xedgefix(const Params& p, int l) {
    const float* XEDGER = (const float*)(p.ws + OFF_XEDGER); const float* XEDGEP = (const float*)(p.ws + OFF_XEDGEP); bf16_t* P = (bf16_t*)(p.ws + OFF_PROJ);
    const float* cxw = p.in[I_CXW] + (size_t)l * 3 * 2048;
    int tid_ = threadIdx.x; asm volatile("" : "+v"(tid_));
    for (int idx = blockIdx.x * 512 + tid_; idx < (TH / 256) * 2 * 2048; idx += gridDim.x * 512) {
        const int ch = idx & 2047, pe = idx >> 11, e = pe & 1, pm = pe >> 1, t = 256 * pm + (e ? 255 : 0);
        const bool has = e ? (((t + 1) % SEQ) != 0) : ((t % SEQ) != 0);
        float nb = 0.f;
        if (has) nb = XEDGER[((size_t)(pm + (e ? 1 : -1)) * 2 + (e ? 0 : 1)) * 2048 + ch];
        const float pre = XEDGEP[((size_t)pm * 2 + e) * 2048 + ch] + cxw[(e ? 2 : 0) * 2048 + ch] * nb;
        const float o = silu_f(pre); const unsigned w = pk2(o, o); P[(size_t)t * LDP + PC_X + ch] = (bf16_t)(w & 0xffffu);
    }
}
__device__ __forceinline__ void phase_shortconv(const Params& p, int l) {
    bf16_t* P = (bf16_t*)(p.ws + OFF_PROJ);
    const float* cw = p.in[I_SCW] + (size_t)l * 3 * 1024;
    int tid_ = threadIdx.x; asm volatile("" : "+v"(tid_));
    const int j0 = (tid_ & 127) * 8, sub = tid_ >> 7;
    float w[3][8];
#pragma unroll
    for (int k = 0; k < 3; ++k) { const f32x4 a0 = *(const f32x4*)(cw + k * 1024 + j0), a1 = *(const f32x4*)(cw + k * 1024 + j0 + 4);
#pragma unroll
        for (int j = 0; j < 4; ++j) { w[k][j] = a0[j]; w[k][4 + j] = a1[j]; } }
    for (int tb = blockIdx.x; tb < TH / 32; tb += gridDim.x) {
        const int t0 = tb * 32 + sub * 8, pos0 = t0 % SEQ;
        u32x4 rp[10], rb[8];
#pragma unroll
        for (int r = 0; r < 10; ++r) { const int pos = pos0 - 1 + r; const bool ok = pos >= 0 && pos < SEQ;
            rp[r] = *(const u32x4*)(P + (size_t)(ok ? t0 - 1 + r : t0) * LDP + PC_P + j0);
            if (!ok) rp[r] = (u32x4){0u, 0u, 0u, 0u}; }
#pragma unroll
        for (int r = 0; r < 8; ++r) rb[r] = *(const u32x4*)(P + (size_t)(t0 + r) * LDP + PC_SB + j0);
#pragma unroll
        for (int r = 0; r < 8; ++r) { float p0[8], p1[8], p2[8], sb[8], o[8]; unpack8(rp[r], p0); unpack8(rp[r + 1], p1); unpack8(rp[r + 2], p2); unpack8(rb[r], sb);
#pragma unroll
            for (int j = 0; j < 8; ++j) o[j] = sb[j] * (w[0][j] * p0[j] + w[1][j] * p1[j] + w[2][j] * p2[j]);
            *(u32x4*)(P + (size_t)(t0 + r) * LDP + PC_SB + j0) = pack8(o); }
    }
}

__device__ __forceinline__ int chperm(int t, int i) { return 32 * (t >> 1) + 8 * (i >> 2) + 4 * (t & 1) + (i & 3); }
__device__ __forceinline__ void ssd_dt_load(const float* DT, int t0, int g, int wid, int lane, float& r0, float& r1) {
    const int dir = wid >> 2, hh = wid & 3, h = 4 * g + hh;
    r0 = DT[(size_t)(t0 + lane) * 32 + dir * 16 + h]; r1 = DT[(size_t)(t0 + 64 + lane) * 32 + dir * 16 + h];
}
__device__ __forceinline__ float ssd_dt_scan(const Params& p, int l, float r0, float r1, int g, float* sm_dt, float* sm_cs, int wid, int lane) {
    const int dir = wid >> 2, hh = wid & 3, h = 4 * g + hh;
    const float bias = p.in[dir ? I_DTBB : I_DTBF][l * 16 + h]; const float A = -__expf(p.in[dir ? I_ALB : I_ALF][l * 16 + h]);
    const float d0 = softplus_f(r0 + bias), d1 = softplus_f(r1 + bias);
    const float a0 = A * d0, a1 = A * d1;
    float s0 = a0, s1 = a1;
#pragma unroll
    for (int o = 1; o < 64; o <<= 1) { const float u0 = __shfl_up(s0, o), u1 = __shfl_up(s1, o); if (lane >= o) { s0 += u0; s1 += u1; } }
    const float tot0 = __shfl(s0, 63); s1 += tot0; const float total = __shfl(s1, 63);
    float c0 = s0, c1 = s1;
    if (dir) { c0 = total - s0 + a0; c1 = total - s1 + a1; }
    const int b = (dir * 4 + hh) * 128;
    sm_dt[b + lane] = d0; sm_dt[b + 64 + lane] = d1; sm_cs[b + lane] = c0; sm_cs[b + 64 + lane] = c1;
    return total;
}
template <int NCH> struct ConvTr {
    static constexpr int NPAIR = NCH / 2, NT = NPAIR * 16 / 512;
    unsigned xr[NT][8];
    __device__ __forceinline__ void load(const bf16_t* P, int t0, int pos0, int col0, int tid) {
#pragma unroll
        for (int it = 0; it < NT; ++it) { const int task = tid + it * 512, cp = task % NPAIR, to = task / NPAIR, ch = 2 * cp;
#pragma unroll
            for (int r = 0; r < 8; ++r) xr[it][r] = *(const unsigned*)(P + (size_t)(t0 + 8 * to + r) * LDP + col0 + ch); }
    }
    __device__ __forceinline__ void compute(const float*, const float*, int, bf16_t* dst, int tid) const {
#pragma unroll
        for (int it = 0; it < NT; ++it) { const int task = tid + it * 512, cp = task % NPAIR, to = task / NPAIR, ch = 2 * cp;
            u32x4 lo, hi;
            lo.x = (xr[it][0] & 0xffffu) | (xr[it][1] << 16); lo.y = (xr[it][2] & 0xffffu) | (xr[it][3] << 16); lo.z = (xr[it][4] & 0xffffu) | (xr[it][5] << 16); lo.w = (xr[it][6] & 0xffffu) | (xr[it][7] << 16);
            hi.x = (xr[it][0] >> 16) | (xr[it][1] & 0xffff0000u); hi.y = (xr[it][2] >> 16) | (xr[it][3] & 0xffff0000u); hi.z = (xr[it][4] >> 16) | (xr[it][5] & 0xffff0000u); hi.w = (xr[it][6] >> 16) | (xr[it][7] & 0xffff0000u);
            *(u32x4*)(dst + (size_t)ch * LSTR + 8 * to) = lo;
            *(u32x4*)(dst + (size_t)(ch + 1) * LSTR + 8 * to) = hi; }
    }
};
template <int NCH> struct ConvNat {
    static constexpr int NG = NCH / 8, NT = NG * 128 / 512;
    u32x4 xr[NT];
    __device__ __forceinline__ void load(const bf16_t* P, int t0, int pos0, int col0, int tid) {
#pragma unroll
        for (int it = 0; it < NT; ++it) { const int task = tid + it * 512, cg8 = task % NG, l = task / NG; xr[it] = *(const u32x4*)(P + (size_t)(t0 + l) * LDP + col0 + 8 * cg8); }
    }
    __device__ __forceinline__ void compute(const float*, const float*, int, bf16_t* dst, int tid) const {
#pragma unroll
        for (int it = 0; it < NT; ++it) { const int task = tid + it * 512, cg8 = task % NG, l = task / NG; *(u32x4*)(dst + (size_t)l * LSTR + 8 * cg8) = xr[it]; }
    }
};

__device__ __forceinline__ void phase_ssd_states(const Params& p, int l, unsigned char* smem) {
    int tid_ = threadIdx.x; asm volatile("" : "+v"(tid_));
    const int tid = tid_, wid = tid >> 6, lane = tid & 63, fr = lane & 15, fq = lane >> 4;
    const bf16_t* P = (const bf16_t*)(p.ws + OFF_PROJ); const float* DT = (const float*)(p.ws + OFF_DT);
    bf16_t* ST = (bf16_t*)(p.ws + OFF_ST); float* CHDEC = (float*)(p.ws + OFF_CHDEC);
    const float* cw = p.in[I_CXW] + (size_t)l * 3 * 2048; const float* cb = p.in[I_CXB] + (size_t)l * 2048;
    bf16_t* XT = (bf16_t*)smem;
    bf16_t* BT = (bf16_t*)(smem + 256 * LSTR * 2);
    float* sm_dt = (float*)(smem + 384 * LSTR * 2);
    float* sm_cs = sm_dt + 1024;
    float* sm_w = sm_cs + 1024;
    {
        const float* XEDGER = (const float*)(p.ws + OFF_XEDGER); const float* XEDGEP = (const float*)(p.ws + OFF_XEDGEP); bf16_t* Pw = (bf16_t*)(p.ws + OFF_PROJ);
        const float* cxw = p.in[I_CXW] + (size_t)l * 3 * 2048;
        for (int item = blockIdx.x; item < NBP * 128; item += gridDim.x) {
            const int g = item & 3, c = (item >> 2) & 31, b = item >> 7, e = c & 1, pm = b * 16 + (c >> 1), t = b * SEQ + c * 128 + (e ? 127 : 0);
            const int ch = tid < 256 ? 256 * g + tid : (tid < 384 ? 1024 + 128 * g + (tid - 256) : 1536 + 128 * g + (tid - 384));
            const bool has = e ? (c != 31) : (c != 0);
            float nb = 0.f;
            if (has) nb = XEDGER[((size_t)(pm + (e ? 1 : -1)) * 2 + (e ? 0 : 1)) * 2048 + ch];
            const float pre = XEDGEP[((size_t)pm * 2 + e) * 2048 + ch] + cxw[(e ? 2 : 0) * 2048 + ch] * nb;
            const float o = silu_f(pre); const unsigned w = pk2(o, o); Pw[(size_t)t * LDP + PC_X + ch] = (bf16_t)(w & 0xffffu);
        }
        asm volatile("s_waitcnt vmcnt(0)" ::: "memory"); __syncthreads();
    }
    for (int item = blockIdx.x; item < NBP * 128; item += gridDim.x) {
        const int g = item & 3, c = (item >> 2) & 31, b = item >> 7;
        const int t0 = b * SEQ + c * 128, pos0 = c * 128;
        __syncthreads();
        float r0, r1; ssd_dt_load(DT, t0, g, wid, lane, r0, r1);
        ConvTr<256> cx; ConvTr<128> cbt;
        cx.load(P, t0, pos0, PC_X + 256 * g, tid); cbt.load(P, t0, pos0, PC_X + 1024 + 128 * g, tid);
        const float total = ssd_dt_scan(p, l, r0, r1, g, sm_dt, sm_cs, wid, lane);
        cx.compute(cw, cb, 256 * g, XT, tid); cbt.compute(cw, cb, 1024 + 128 * g, BT, tid);
        const int dir = wid >> 2, hh = wid & 3, h = 4 * g + hh, sb = (dir * 4 + hh) * 128;
        {
            sm_w[sb + lane] = sm_dt[sb + lane] * __expf(total - sm_cs[sb + lane]);
            sm_w[sb + 64 + lane] = sm_dt[sb + 64 + lane] * __expf(total - sm_cs[sb + 64 + lane]);
            if (lane == 0) CHDEC[((b * 32 + c) * 16 + h) * 2 + dir] = __expf(total);
        }
        __syncthreads();
        *(f32x4*)((float*)(p.ws + OFF_DTCS) + (size_t)item * 2048 + tid * 4) = *(const f32x4*)(sm_dt + tid * 4);
        f32x4 acc[4][8];
#pragma unroll
        for (int i = 0; i < 4; ++i)
#pragma unroll
            for (int j = 0; j < 8; ++j) acc[i][j] = (f32x4){0.f, 0.f, 0.f, 0.f};
#pragma unroll 1
        for (int ks = 0; ks < 4; ++ks) {
            const f32x4 w0 = *(const f32x4*)(sm_w + sb + 32 * ks + 8 * fq), w1 = *(const f32x4*)(sm_w + sb + 32 * ks + 8 * fq + 4);
            bf16x8 xf[4];
#pragma unroll
            for (int pi = 0; pi < 4; ++pi) { const u32x4 raw = *(const u32x4*)(XT + (size_t)(64 * hh + chperm(pi, fr)) * LSTR + 32 * ks + 8 * fq); float f[8]; unpack8(raw, f);
                f[0] *= w0[0]; f[1] *= w0[1]; f[2] *= w0[2]; f[3] *= w0[3]; f[4] *= w1[0]; f[5] *= w1[1]; f[6] *= w1[2]; f[7] *= w1[3];
                const u32x4 pk = pack8(f); xf[pi] = __builtin_bit_cast(bf16x8, pk); }
#pragma unroll
            for (int ni = 0; ni < 8; ++ni) { const bf16x8 bf = *(const bf16x8*)(BT + (size_t)chperm(ni, fr) * LSTR + 32 * ks + 8 * fq);
#pragma unroll
                for (int pi = 0; pi < 4; ++pi) acc[pi][ni] = __builtin_amdgcn_mfma_f32_16x16x32_bf16(bf, xf[pi], acc[pi][ni], 0, 0, 0); }
        }
        bf16_t* S = ST + ((size_t)((b * 32 + c) * 16 + h) * 2 + dir) * 8192;
#pragma unroll
        for (int pi = 0; pi < 4; ++pi)
#pragma unroll
            for (int q = 0; q < 4; ++q) { u32x4 w; w.x = pk2(acc[pi][2 * q][0], acc[pi][2 * q][1]); w.y = pk2(acc[pi][2 * q][2], acc[pi][2 * q][3]); w.z = pk2(acc[pi][2 * q + 1][0], acc[pi][2 * q + 1][1]); w.w = pk2(acc[pi][2 * q + 1][2], acc[pi][2 * q + 1][3]);
                *(u32x4*)(S + ((q * 4 + pi) * 16 + fr) * 32 + 8 * fq) = w; }
    }
}
__device__ __forceinline__ void phase_ssd_scan(const Params& p) {
    bf16_t* ST = (bf16_t*)(p.ws + OFF_ST); const float* CHDEC = (const float*)(p.ws + OFF_CHDEC);
    const int ntask = NBP * 16 * 2 * 1024;
    int tid_ = threadIdx.x; asm volatile("" : "+v"(tid_));
    for (int task = blockIdx.x * 512 + tid_; task < ntask; task += gridDim.x * 512) {
        const int e = task & 1023, dir = (task >> 10) & 1, h = (task >> 11) & 15, b = task >> 15;
        const int c0 = dir ? 31 : 0, cstep = dir ? -1 : 1;
        const size_t idx0 = (size_t)((b * 32 + c0) * 16 + h) * 2 + dir; const long istep = (long)cstep * 32;
        float run[8];
#pragma unroll
        for (int j = 0; j < 8; ++j) run[j] = 0.f;
#pragma unroll 1
        for (int i0 = 0; i0 < 32; i0 += 16) {
            u32x4 v[16]; float d[16];
#pragma unroll
            for (int i = 0; i < 16; ++i) { const size_t idx = idx0 + (long)(i0 + i) * istep; v[i] = *(const u32x4*)(ST + idx * 8192 + e * 8); d[i] = CHDEC[idx]; }
#pragma unroll
            for (int i = 0; i < 16; ++i) { const size_t idx = idx0 + (long)(i0 + i) * istep; float sv[8]; unpack8(v[i], sv);
                *(u32x4*)(ST + idx * 8192 + e * 8) = pack8(run);
#pragma unroll
                for (int j = 0; j < 8; ++j) run[j] = run[j] * d[i] + sv[j]; }
        }
    }
}
__device__ __forceinline__ void phase_ssd_out(const Params& p, int l, unsigned char* smem) {
    bf16_t* P = (bf16_t*)(p.ws + OFF_PROJ); const float* DT = (const float*)(p.ws + OFF_DT);
    const bf16_t* ST = (const bf16_t*)(p.ws + OFF_ST);
    const float* cw = p.in[I_CXW] + (size_t)l * 3 * 2048; const float* cb = p.in[I_CXB] + (size_t)l * 2048;
    const float* dsk = p.in[I_DSK] + l * 16; const float* nw = p.in[I_SNW] + l * 1024;
    bf16_t* XT = (bf16_t*)smem;
    bf16_t* CN = (bf16_t*)(smem + 256 * LSTR * 2);
    bf16_t* BN = (bf16_t*)(smem + 384 * LSTR * 2);
    float* sm_dt = (float*)(smem + 512 * LSTR * 2);
    float* sm_cs = sm_dt + 1024;
    float* sm_ss = sm_cs + 1024;
    for (int item = blockIdx.x; item < NBP * 128; item += gridDim.x) {
        int tid_ = threadIdx.x; asm volatile("" : "+v"(tid_));
        const int tid = tid_, wid = tid >> 6, lane = tid & 63, fr = lane & 15, fq = lane >> 4, hh = wid >> 1, lh = wid & 1;
        const int g = item & 3, c = (item >> 2) & 31, b = item >> 7;
        const int t0 = b * SEQ + c * 128, pos0 = c * 128, h = 4 * g + hh;
        __syncthreads();
        const bf16_t* Hf = ST + ((size_t)((b * 32 + c) * 16 + h) * 2 + 0) * 8192;
        bf16x8 hv[4][4];
        {
            const f32x4 dtcs = *(const f32x4*)((const float*)(p.ws + OFF_DTCS) + (size_t)item * 2048 + tid * 4);
            ConvNat<128> cbn, ccn; ConvTr<256> cx;
            cbn.load(P, t0, pos0, PC_X + 1024 + 128 * g, tid); ccn.load(P, t0, pos0, PC_X + 1536 + 128 * g, tid); cx.load(P, t0, pos0, PC_X + 256 * g, tid);
            __builtin_amdgcn_sched_barrier(0);
            *(f32x4*)(sm_dt + tid * 4) = dtcs;
            cbn.compute(cw, cb, 1024 + 128 * g, BN, tid);
            ccn.compute(cw, cb, 1536 + 128 * g, CN, tid);
            cx.compute(cw, cb, 256 * g, XT, tid);
        }
#pragma unroll
        for (int ks = 0; ks < 4; ++ks)
#pragma unroll
            for (int pt = 0; pt < 4; ++pt) hv[ks][pt] = *(const bf16x8*)(Hf + ((ks * 4 + pt) * 16 + fr) * 32 + 8 * fq);
        __syncthreads();
        {
            f32x4 cbacc[8];
#pragma unroll
            for (int st = 0; st < 8; ++st) cbacc[st] = (f32x4){0.f, 0.f, 0.f, 0.f};
#pragma unroll
            for (int ks = 0; ks < 4; ++ks) {
                const bf16x8 cf = *(const bf16x8*)(CN + (size_t)(16 * wid + fr) * LSTR + 32 * ks + 8 * fq);
#pragma unroll
                for (int st = 0; st < 8; ++st) { const bf16x8 bf = *(const bf16x8*)(BN + (size_t)(16 * st + fr) * LSTR + 32 * ks + 8 * fq);
                    cbacc[st] = __builtin_amdgcn_mfma_f32_16x16x32_bf16(bf, cf, cbacc[st], 0, 0, 0); }
            }
            __syncthreads();
#pragma unroll
            for (int st = 0; st < 8; ++st) { u32x2 w; w.x = pk2(cbacc[st][0], cbacc[st][1]); w.y = pk2(cbacc[st][2], cbacc[st][3]);
                *(u32x2*)(BN + (size_t)(16 * wid + fr) * LSTR + 16 * st + 4 * fq) = w; }
        }
        __syncthreads();
        const float* dtf = sm_dt + hh * 128; const float* dtb = sm_dt + (4 + hh) * 128; const float* acs = sm_cs + hh * 128; const float* rcs = sm_cs + (4 + hh) * 128;
        f32x4 acc[4][4];
#pragma unroll
        for (int dir = 0; dir < 2; ++dir) {
            const float* csd = dir ? rcs : acs;
            f32x4 acc2[4][4];
#pragma unroll
            for (int i = 0; i < 4; ++i)
#pragma unroll
                for (int j = 0; j < 4; ++j) acc2[i][j] = (f32x4){0.f, 0.f, 0.f, 0.f};
#pragma unroll
            for (int ks = 0; ks < 4; ++ks) {
                bf16x8 a[4];
#pragma unroll
                for (int lt = 0; lt < 4; ++lt) a[lt] = *(const bf16x8*)(CN + (size_t)(64 * lh + 16 * lt + fr) * LSTR + 32 * ks + 8 * fq);
#pragma unroll
                for (int lt = 0; lt < 4; ++lt)
#pragma unroll
                    for (int pt = 0; pt < 4; ++pt) acc2[lt][pt] = __builtin_amdgcn_mfma_f32_16x16x32_bf16(hv[ks][pt], a[lt], acc2[lt][pt], 0, 0, 0);
                if (dir == 0) {
#pragma unroll
                    for (int pt = 0; pt < 4; ++pt) hv[ks][pt] = *(const bf16x8*)(Hf + 8192 + ((ks * 4 + pt) * 16 + fr) * 32 + 8 * fq); }
                __builtin_amdgcn_sched_barrier(0);
            }
#pragma unroll
            for (int lt = 0; lt < 4; ++lt) { const float ev = __expf(csd[64 * lh + 16 * lt + fr]);
#pragma unroll
                for (int pt = 0; pt < 4; ++pt) acc[lt][pt] = dir ? acc[lt][pt] + acc2[lt][pt] * ev : acc2[lt][pt] * ev; }
        }
        u32x2 zr[4][4];
#pragma unroll
        for (int lt = 0; lt < 4; ++lt)
#pragma unroll
            for (int q = 0; q < 2; ++q) { const u32x4 zz = *(const u32x4*)(P + (size_t)(t0 + 64 * lh + 16 * lt + fr) * LDP + PC_Z + 256 * g + 64 * hh + 32 * q + 8 * fq);
                zr[lt][2 * q].x = zz.x; zr[lt][2 * q].y = zz.y; zr[lt][2 * q + 1].x = zz.z; zr[lt][2 * q + 1].y = zz.w; }
        const float dskip = dsk[h];
#pragma unroll 1
        for (int ks = 0; ks < 4; ++ks) {
            const int s0 = 32 * ks + 8 * fq;
            float as_[8], rs_[8], df_[8], db_[8];
            { const f32x4 t0_ = *(const f32x4*)(acs + s0), t1_ = *(const f32x4*)(acs + s0 + 4), u0_ = *(const f32x4*)(rcs + s0), u1_ = *(const f32x4*)(rcs + s0 + 4);
              const f32x4 v0_ = *(const f32x4*)(dtf + s0), v1_ = *(const f32x4*)(dtf + s0 + 4), x0_ = *(const f32x4*)(dtb + s0), x1_ = *(const f32x4*)(dtb + s0 + 4);
#pragma unroll
              for (int j = 0; j < 4; ++j) { as_[j] = t0_[j]; as_[4 + j] = t1_[j]; rs_[j] = u0_[j]; rs_[4 + j] = u1_[j]; df_[j] = v0_[j]; df_[4 + j] = v1_[j]; db_[j] = x0_[j]; db_[4 + j] = x1_[j]; } }
            bf16x8 bx[4];
#pragma unroll
            for (int pt = 0; pt < 4; ++pt) bx[pt] = *(const bf16x8*)(XT + (size_t)(64 * hh + chperm(pt, fr)) * LSTR + s0);
#pragma unroll
            for (int lt = 0; lt < 4; ++lt) {
                const int lrow = 64 * lh + 16 * lt + fr;
                const float al = acs[lrow], rl = rcs[lrow], dd = dtf[lrow] + dtb[lrow];
                float cbv[8]; unpack8(*(const u32x4*)(BN + (size_t)lrow * LSTR + s0), cbv);
#pragma unroll
                for (int j = 0; j < 8; ++j) { const int s = s0 + j; const bool fw = s < lrow;
                    const float d = fw ? al - as_[j] : rl - rs_[j]; float v = __expf(d) * (fw ? df_[j] : db_[j]); v = (s == lrow) ? dd : v; cbv[j] = cbv[j] * v + ((s == lrow) ? dskip : 0.f); }
                const u32x4 pk = pack8(cbv); const bf16x8 gfr = __builtin_bit_cast(bf16x8, pk);
#pragma unroll
                for (int pt = 0; pt < 4; ++pt) acc[lt][pt] = __builtin_amdgcn_mfma_f32_16x16x32_bf16(bx[pt], gfr, acc[lt][pt], 0, 0, 0);
                __builtin_amdgcn_sched_barrier(0);
            }
        }
#pragma unroll
        for (int lt = 0; lt < 4; ++lt) { float sq = 0.f;
#pragma unroll
            for (int pt = 0; pt < 4; ++pt) { const float z0 = bflo(zr[lt][pt].x), z1 = bfhi(zr[lt][pt].x), z2 = bflo(zr[lt][pt].y), z3 = bfhi(zr[lt][pt].y);
                f32x4 y = acc[lt][pt]; y[0] *= silu_f(z0); y[1] *= silu_f(z1); y[2] *= silu_f(z2); y[3] *= silu_f(z3); acc[lt][pt] = y;
                sq += (y[0] * y[0] + y[1] * y[1]) + (y[2] * y[2] + y[3] * y[3]); }
            sq += __shfl_xor(sq, 16); sq += __shfl_xor(sq, 32);
            if (fq == 0) sm_ss[(64 * lh + 16 * lt + fr) * 4 + hh] = sq; }
        __syncthreads();
        f32x4 nwv[4];
#pragma unroll
        for (int pt = 0; pt < 4; ++pt) nwv[pt] = *(const f32x4*)(nw + 256 * g + 64 * hh + 32 * (pt >> 1) + 8 * fq + 4 * (pt & 1));
#pragma unroll
        for (int lt = 0; lt < 4; ++lt) { const int lrow = 64 * lh + 16 * lt + fr; const f32x4 sv = *(const f32x4*)(sm_ss + lrow * 4);
            const float rs = rsqrtf(((sv[0] + sv[1]) + (sv[2] + sv[3])) * (1.0f / 256.0f) + EPS);
#pragma unroll
            for (int q = 0; q < 2; ++q) { const f32x4 y0 = acc[lt][2 * q] * rs * nwv[2 * q], y1 = acc[lt][2 * q + 1] * rs * nwv[2 * q + 1]; u32x4 w; w.x = pk2(y0[0], y0[1]); w.y = pk2(y0[2], y0[3]); w.z = pk2(y1[0], y1[1]); w.w = pk2(y1[2], y1[3]);
                *(u32x4*)(P + (size_t)(t0 + lrow) * LDP + PC_Z + 256 * g + 64 * hh + 32 * q + 8 * fq) = w; } }
    }
}

#define XB_TMO      128
#define XB_XCNT(j)  (256  + 64 * (j))
#define XB_XSUB(j)  (1280 + 64 * (j))
#define XB_XGEN(j)  (2304 + 64 * (j))
#define XB_TOP      3328
#define XB_TOPGEN   3392
#define XCD_BAR_WORDS 3456
#define XB_SPIN_CAP (1u << 20)
__device__ __forceinline__ unsigned xb_ld(unsigned* p)              { return __hip_atomic_load(p, __ATOMIC_RELAXED, __HIP_MEMORY_SCOPE_AGENT); }
__device__ __forceinline__ unsigned xb_add(unsigned* p, unsigned v) { return __hip_atomic_fetch_add(p, v, __ATOMIC_RELAXED, __HIP_MEMORY_SCOPE_AGENT); }
__device__ __forceinline__ unsigned xb_xcc_id() { return (unsigned)__builtin_amdgcn_s_getreg((3 << 11) | 20) & 0xFu; }
#define XB_SPIN(cond, bar) do { unsigned _sp = 0; while (cond) { __builtin_amdgcn_s_sleep(1); \
    if ((++_sp & 255u) == 0u) { if (xb_ld(&(bar)[XB_TMO])) break; if (_sp > XB_SPIN_CAP) { atomicAdd(&(bar)[XB_TMO], 1u); break; } } } } while (0)
struct XcdBarrier { unsigned* bar; unsigned x; volatile PG8_LAS unsigned* st; };
__device__ __forceinline__ XcdBarrier xcd_barrier_post(unsigned* bar, volatile PG8_LAS unsigned* st) {
    XcdBarrier b; b.bar = bar; b.x = xb_xcc_id(); b.st = st;
    if (threadIdx.x == 0) (void)xb_add(&bar[XB_XCNT(b.x)], 1u);
    return b;
}
__device__ __forceinline__ void xcd_barrier_complete(unsigned* bar, unsigned x, unsigned& nloc, unsigned& nx) {
    const unsigned G = gridDim.x * gridDim.y * gridDim.z;
    unsigned sum, cnt, mine, sp = 0u;
    for (;;) {
        sum = 0u; cnt = 0u; mine = 0u;
#pragma unroll
        for (unsigned j = 0; j < 16; ++j) { const unsigned c = xb_ld(&bar[XB_XCNT(j)]); sum += c; cnt += (c > 0u) ? 1u : 0u; mine = (j == x) ? c : mine; }
        if (sum == G) break;
        __builtin_amdgcn_s_sleep(1);
        if ((++sp & 255u) == 0u) { if (xb_ld(&bar[XB_TMO])) break; if (sp > XB_SPIN_CAP) { atomicAdd(&bar[XB_TMO], 1u); break; } }
    }
    nloc = mine > 0u ? mine : 1u; nx = cnt > 0u ? cnt : 1u;
}
__device__ __forceinline__ void xcd_barrier(const XcdBarrier& b) {
    asm volatile("s_waitcnt vmcnt(0)" ::: "memory");
    __syncthreads();
    if (threadIdx.x == 0) {
        unsigned* bar = b.bar;
        __builtin_amdgcn_s_waitcnt(0);
        unsigned nloc = b.st[0], nx = b.st[1];
        if (nloc == 0u) { xcd_barrier_complete(bar, b.x, nloc, nx); b.st[0] = nloc; b.st[1] = nx; }
        const unsigned old = xb_add(&bar[XB_XSUB(b.x)], 1u);
        const unsigned gen = old / nloc;
        if (old + 1u == (gen + 1u) * nloc) {
            __builtin_amdgcn_fence(__ATOMIC_RELEASE, "agent");
            asm volatile("s_waitcnt vmcnt(0)" ::: "memory");
            const unsigned og = xb_add(&bar[XB_TOP], 1u);
            const unsigned tg = og / nx;
            if (og + 1u == (tg + 1u) * nx) xb_add(&bar[XB_TOPGEN], 1u);
            else XB_SPIN(xb_ld(&bar[XB_TOPGEN]) == tg, bar);
            __builtin_amdgcn_fence(__ATOMIC_ACQUIRE, "agent");
            xb_add(&bar[XB_XGEN(b.x)], 1u);
            asm volatile("s_waitcnt vmcnt(0)" ::: "memory");
        } else {
            XB_SPIN(xb_ld(&bar[XB_XGEN(b.x)]) == gen, bar);
            __builtin_amdgcn_fence(__ATOMIC_ACQUIRE, "agent");
            asm volatile("s_waitcnt vmcnt(0)" ::: "memory");
        }
    }
    __syncthreads();
}

constexpr int PH_PER_HALF = 16, N_PHASES = NPART * PH_PER_HALF;
__global__ void __launch_bounds__(512, 2) mega(Params p0) {
    extern __shared__ __attribute__((aligned(16))) unsigned char smem[];
    cg::grid_group grid = cg::this_grid();
    volatile PG8_LAS unsigned* xst = (volatile PG8_LAS unsigned*)((PG8_LAS unsigned char*)smem + (LDS_BYTES - 16));
    if (threadIdx.x == 0) { xst[0] = 0u; xst[1] = 0u; }
    __syncthreads();
    const XcdBarrier xb = xcd_barrier_post((unsigned*)(p0.ws + OFF_BAR), xst);
    for (int ph = p0.ph_lo; ph < p0.ph_hi; ++ph) {
        const int hf = ph / PH_PER_HALF, lp = ph % PH_PER_HALF;
        if (hf >= 1 && lp == 0) continue;
        Params p = p0; asm volatile("" : "+s"(p.ws), "+s"(p.out));
        unsigned char* ws = p.ws;
        float* rowss = (float*)(ws + OFF_ROWSS) + (size_t)hf * 5 * TH * 16;
        bf16_t* HB = (bf16_t*)(ws + OFF_HB);
        if (lp == 0) {
#ifdef REP0
            for (int rep = 0; rep < 2; ++rep) {
#endif
            if (hf == 0) phase_weights(p, (float*)smem);
            phase_prep(p, hf);
#ifdef REP0
            }
#endif
        } else if (lp == 15) {
            phase_final(p, hf);
            if (hf + 1 < NPART) phase_prep(p, hf + 1);
        } else {
            const int l = (lp - 1) / 7, k = (lp - 1) % 7;
#ifdef REPK
            for (int rep = 0; rep < ((REPK) ? 2 : 1); ++rep) {
#endif
            unsigned char* wb = ws + (size_t)l * WL_B;
            float* hout = p.out + (size_t)hf * TH * DM;
            if (k == 0) {
                pg8::Gemm g{HB, (const bf16_t*)wb, TH, NIN, DM}; pg8::StaticOrder S; S.init(TH, NIN, gridDim.x, blockIdx.x);
                EpiIn E{(bf16_t*)(ws + OFF_PROJ), rowss + (size_t)(2 * l) * TH * 16, (float*)(smem + 131072), (float*)(smem + 132096), p.in[I_CXW] + (size_t)l * 3 * 2048, p.in[I_CXB] + (size_t)l * 2048,
                        (float*)(ws + OFF_XEDGER), (float*)(ws + OFF_XEDGEP), -1};
                phase_dt(p, l, rowss + (size_t)(2 * l) * TH * 16);
                pg8::gemm_phase<EpiIn, pg8::StaticOrder, true, true>((PG8_LAS unsigned char*)smem, g, S, E);
            } else if (k == 1) {
#ifndef NO_STATES
                phase_ssd_states(p, l, smem);
#endif
            } else if (k == 2) {
                phase_ssd_scan(p);
            } else if (k == 3) {
#ifndef NO_OUT
                phase_ssd_out(p, l, smem);
#endif
                phase_shortconv(p, l);
            } else if (k == 4) {
                pg8::Gemm g{(const bf16_t*)(ws + OFF_PROJ), (const bf16_t*)(wb + WT_IN_B), TH, DM, DMIX, LDP}; pg8::StaticOrder S; S.init(TH, DM, gridDim.x, blockIdx.x);
                EpiRes E{HB, rowss + (size_t)(2 * l + 1) * TH * 16};
                pg8::gemm_phase<EpiRes, pg8::StaticOrder, true, true>((PG8_LAS unsigned char*)smem, g, S, E);
#ifdef REP4
                if (l == 0) pg8::gemm_phase<EpiRes, pg8::StaticOrder, true, true>((PG8_LAS unsigned char*)smem, g, S, E);
#endif
            } else if (k == 5) {
                pg8::Gemm g{HB, (const bf16_t*)(wb + WT_IN_B + WT_OUT_B), TH, NUP, DM}; pg8::StaticOrder S; S.init(TH, NUP, gridDim.x, blockIdx.x);
                EpiAct E{(bf16_t*)(ws + OFF_ACT), rowss + (size_t)(2 * l + 1) * TH * 16, (float*)(smem + 131072), (float*)(smem + 132096), p.in[I_FCW] + (size_t)l * 3 * NUP, p.in[I_FCB] + (size_t)l * NUP,
                         (float*)(ws + OFF_EDGER), (float*)(ws + OFF_EDGEP), -1};
                pg8::gemm_phase<EpiAct, pg8::StaticOrder, true, true>((PG8_LAS unsigned char*)smem, g, S, E);
            } else {
                pg8::Gemm g{(const bf16_t*)(ws + OFF_ACT), (const bf16_t*)(wb + WT_IN_B + WT_OUT_B + WT_UP_B), TH, DM, DFF}; pg8::StaticOrder S; S.init(TH, DM, gridDim.x, blockIdx.x);
                {
                    pg8::Unit uu; int last_pm = -1;
                    for (int i = 0; S.next(i, uu); ++i) if (uu.pm != last_pm) { last_pm = uu.pm; edgefix_panel(p, l, uu.pm); }
                    asm volatile("s_waitcnt vmcnt(0)" ::: "memory"); __syncthreads();
                }
                EpiRes E{HB, rowss + (size_t)(2 * l + 2) * TH * 16};
                pg8::gemm_phase<EpiRes, pg8::StaticOrder, true, true>((PG8_LAS unsigned char*)smem, g, S, E);
            }
#ifdef REPK
            }
#endif
        }
        if (ph + 1 < p0.ph_hi) { if (ph == 0) grid.sync(); else xcd_barrier(xb); }
    }
}


#ifndef MULTI_LAUNCH
#define MULTI_LAUNCH 0
#endif
extern "C" void kernel_launch(void* const* d_in, const int* in_sizes, int n_in, void* d_out, int out_size, void* d_ws, size_t ws_size, hipStream_t stream) {
    static int grid = 0;
    if (grid == 0) {
        if (n_in != 19 || ws_size < WS_NEED) { fprintf(stderr, "kernel_launch: unexpected n_in %d / ws_size %zu (need %zu)\n", n_in, ws_size, (size_t)WS_NEED); grid = -1; return; }
        int dev = 0, cus = 0, per_cu = 0;
        hipGetDevice(&dev); hipDeviceGetAttribute(&cus, hipDeviceAttributeMultiprocessorCount, dev);
        if (hipFuncSetAttribute((const void*)mega, hipFuncAttributeMaxDynamicSharedMemorySize, LDS_BYTES) != hipSuccess) { fprintf(stderr, "kernel_launch: hipFuncSetAttribute failed\n"); grid = -1; return; }
        if (hipOccupancyMaxActiveBlocksPerMultiprocessor(&per_cu, (const void*)mega, 512, LDS_BYTES) != hipSuccess || per_cu < 1) { fprintf(stderr, "kernel_launch: occupancy query says %d\n", per_cu); per_cu = 1; }
        (void)hipGetLastError();
        grid = cus * 1;
        fprintf(stderr, "kernel_launch: grid %d (cus %d, per_cu %d), ws %zu\n", grid, cus, per_cu, ws_size);
    }
    if (grid < 0) return;
#ifdef DBG_MEMSET
    (void)hipMemsetAsync(d_ws, 0, WS_END, stream); (void)hipMemsetAsync(d_out, 0, (size_t)out_size * 4, stream);
#endif
    (void)hipMemsetAsync((unsigned char*)d_ws + OFF_BAR, 0, 16384, stream);
    Params p{};
    for (int i = 0; i < 19; ++i) p.in[i] = (const float*)d_in[i];
    p.out = (float*)d_out; p.ws = (unsigned char*)d_ws;
#if MULTI_LAUNCH
    for (int ph = 0; ph < N_PHASES; ++ph) { p.ph_lo = ph; p.ph_hi = ph + 1; hipLaunchKernelGGL(mega, dim3(grid), dim3(512), LDS_BYTES, stream, p); }
#else
    p.ph_lo = 0; p.ph_hi = N_PHASES;
    void* args[] = {&p};
    hipError_t e = hipLaunchCooperativeKernel((const void*)mega, dim3(grid), dim3(512), args, LDS_BYTES, stream);
    if (e != hipSuccess) fprintf(stderr, "cooperative launch failed: %s (grid %d)\n", hipGetErrorString(e), grid);
#endif
}
```

```cpp
#include <hip/hip_runtime.h>
#include <hip/hip_cooperative_groups.h>
#include <cstdio>
#include <type_traits>
namespace cg = cooperative_groups;
namespace pg8 {
#define PG8_LAS __attribute__((address_space(3)))
typedef unsigned short bf16_t;
typedef short bf16x8 __attribute__((ext_vector_type(8)));
typedef float f32x4 __attribute__((ext_vector_type(4)));
typedef unsigned u32x4 __attribute__((ext_vector_type(4)));
constexpr int BM = 256, BK = 64, HALF = 128, HTB = HALF * BK * 2  , STAGE_BYTES = 8 * HTB, NXCD = 8, WGM = 8;

__host__ __device__ __forceinline__ int lds_byte(int r, int c) { const int st = (r >> 4) * 2 + (c >> 5), rr = r & 15, cc = c & 31, ob = rr * 64 + cc * 2; return st * 1024 + (ob ^ (((ob >> 9) & 1) << 5)); }
__host__ __device__ __forceinline__ void stage_rc(int b, int& R, int& C) { const int st = b / 1024, sb = b % 1024, swz = sb ^ (((sb >> 9) & 1) << 5); R = (st >> 1) * 16 + swz / 64; C = (st & 1) * 32 + (swz % 64) / 2; }
__host__ __device__ __forceinline__ int perm32(int rho) { const int n = rho >> 4, i = rho & 15; return 8 * (i >> 2) + 4 * n + (i & 3); }

struct Unit { int pm, pn; };
struct Gemm { const bf16_t* A; const bf16_t* Bt; int M, N, K; int lda = 0; };
struct StaticOrder {
    int nM, nN, nwg, G, c;
    __host__ __device__ void init(int M, int N, int G_, int c_) { nM = M / BM; nN = N / BM; nwg = nM * nN; G = G_; c = c_; }
    __host__ __device__ bool next(int i, Unit& u) const {
        const long L = (long)i * G + c; if (L >= nwg) return false;
        int wgid = (int)L; { const int q = nwg / NXCD, r = nwg % NXCD, xcd = wgid % NXCD, off = wgid / NXCD; wgid = (xcd < r ? xcd * (q + 1) : r * (q + 1) + (xcd - r) * q) + off; }
        const int nig = WGM * nN, gid = wgid / nig, fm = gid * WGM, gsz = (nM - fm) < WGM ? (nM - fm) : WGM;
        u.pm = fm + ((wgid % nig) % gsz); u.pn = (wgid % nig) / gsz; return true;
    }
    __device__ __forceinline__ void a_ready(const Unit&) const {}
    __device__ __forceinline__ void done(const Unit&) const {}
};
__device__ __forceinline__ unsigned cvt_pk_bf16(float lo, float hi) { unsigned r; asm volatile("v_cvt_pk_bf16_f32 %0, %1, %2" : "=v"(r) : "v"(lo), "v"(hi)); return r; }
template <class Epi, class Sched, bool ALIGN_EPI = false, bool SP2 = false>
__device__ __forceinline__ void gemm_phase(PG8_LAS unsigned char* lds, const Gemm g, const Sched& S, const Epi& E) {
    int tid_ = threadIdx.x; asm volatile("" : "+v"(tid_));
    const int tid = tid_, wid = __builtin_amdgcn_readfirstlane(tid >> 6), lane = tid & 63, wr = wid >> 2, wc = wid & 3, fr = lane & 15, fq = lane >> 4;
    const int K = g.K, nt = K / BK, LDA = g.lda ? g.lda : g.K;
    unsigned voffA[2], voffB[2];
#pragma unroll
    for (int i = 0; i < 2; ++i) { int R, C; stage_rc(tid * 16 + i * 8192, R, C); const int Rb = Epi::PERM ? ((R & ~31) + perm32(R & 31)) : R;
        voffA[i] = (unsigned)(R * LDA + C) * 2u; voffB[i] = (unsigned)(Rb * K + C) * 2u; }
    const size_t kstep = (size_t)(BK * 2);
    const size_t hstep = (size_t)HALF * K * 2;
    const size_t tstep = 2 * hstep;
    const size_t hstepA = (size_t)HALF * LDA * 2, tstepA = 2 * hstepA;
    const unsigned ldsw = (unsigned)wid * 1024u;
    const int aoff = lds_byte(wr * 64 + fr, fq * 8), boff = lds_byte(wc * 32 + fr, fq * 8);
#define PG8_SA(b, h) (((b) * 2 + (h)) * HTB)
#define PG8_SB(b, h) ((4 + (b) * 2 + (h)) * HTB)
#define PG8_STAGE(bufoff, gbase, voff) do { _Pragma("unroll") for (int _i = 0; _i < 2; ++_i) \
        __builtin_amdgcn_global_load_lds((const unsigned*)((const char*)(gbase) + (voff)[_i]), (PG8_LAS unsigned*)(lds + (bufoff) + ldsw + _i * 8192), 16, 0, 0); } while (0)
#define PG8_LDA(dst, b, h) do { _Pragma("unroll") for (int m = 0; m < 4; ++m) _Pragma("unroll") for (int k = 0; k < 2; ++k) dst[m][k] = *(const PG8_LAS bf16x8*)(lds + PG8_SA(b, h) + aoff + m * 2048 + k * 1024); } while (0)
#define PG8_LDB(dst, b, h) do { _Pragma("unroll") for (int n = 0; n < 2; ++n) _Pragma("unroll") for (int k = 0; k < 2; ++k) dst[n][k] = *(const PG8_LAS bf16x8*)(lds + PG8_SB(b, h) + boff + n * 2048 + k * 1024); } while (0)
#define PG8_MMA(ai, bj, At, Bt) do { __builtin_amdgcn_s_setprio(1); _Pragma("unroll") for (int m = 0; m < 4; ++m) _Pragma("unroll") for (int n = 0; n < 2; ++n) _Pragma("unroll") for (int k = 0; k < 2; ++k) \
        acc[ai][bj][m][n] = __builtin_amdgcn_mfma_f32_16x16x32_bf16(Bt[n][k], At[m][k], acc[ai][bj][m][n], 0, 0, 0); __builtin_amdgcn_s_setprio(0); } while (0)
#define PG8_WAIT_V(n) asm volatile("s_waitcnt vmcnt(" #n ")" ::: "memory")
#define PG8_WAIT_L(n) asm volatile("s_waitcnt lgkmcnt(" #n ")" ::: "memory")
#define PG8_BAR __builtin_amdgcn_s_barrier()
#define PG8_SCHED __builtin_amdgcn_sched_barrier(0)
    Unit cur, nxt; int ui = 0;
    if (!S.next(0, cur)) return;
    f32x4 acc[2][2][4][2];
#pragma unroll
    for (int a = 0; a < 2; ++a)
#pragma unroll
        for (int b = 0; b < 2; ++b)
#pragma unroll
            for (int m = 0; m < 4; ++m)
#pragma unroll
                for (int n = 0; n < 2; ++n) acc[a][b][m][n] = (f32x4){0.f, 0.f, 0.f, 0.f};
    bf16x8 At[4][2], B0[2][2], B1[2][2];
    const char* cA = (const char*)g.A + (size_t)cur.pm * tstepA; const char* cB = (const char*)g.Bt + (size_t)cur.pn * tstep;
    S.a_ready(cur);
    if constexpr (SP2) {
        PG8_STAGE(PG8_SB(0, 0), cB, voffB); PG8_STAGE(PG8_SB(0, 1), cB + hstep, voffB); PG8_STAGE(PG8_SA(0, 0), cA, voffA); PG8_STAGE(PG8_SA(0, 1), cA + hstepA, voffA);
        if (wr == 1) PG8_BAR;
        PG8_WAIT_V(2); PG8_BAR;
        PG8_STAGE(PG8_SB(1, 0), cB + kstep, voffB); PG8_STAGE(PG8_SA(1, 0), cA + kstep, voffA); PG8_STAGE(PG8_SB(1, 1), cB + hstep + kstep, voffB);
        PG8_WAIT_V(6); PG8_BAR;
    } else {
        PG8_STAGE(PG8_SB(0, 0), cB, voffB); PG8_STAGE(PG8_SA(0, 0), cA, voffA); PG8_STAGE(PG8_SB(0, 1), cB + hstep, voffB); PG8_STAGE(PG8_SA(0, 1), cA + hstepA, voffA);
        if (wr == 1) PG8_BAR;
        PG8_WAIT_V(4); PG8_BAR;
        PG8_STAGE(PG8_SB(1, 0), cB + kstep, voffB); PG8_STAGE(PG8_SA(1, 0), cA + kstep, voffA); PG8_STAGE(PG8_SB(1, 1), cB + hstep + kstep, voffB);
        PG8_WAIT_V(6); PG8_BAR;
    }
    for (;;) {
        const bool has_next = S.next(ui + 1, nxt);
        const char* nA = has_next ? (const char*)g.A + (size_t)nxt.pm * tstepA : cA; const char* nB = has_next ? (const char*)g.Bt + (size_t)nxt.pn * tstep : cB;
        for (int t = 0; t < nt; t += 2) {
            const bool last = (t == nt - 2);
            const char* a1 = cA + (size_t)(t + 1) * kstep;
            const char* a2 = last ? nA : cA + (size_t)(t + 2) * kstep; const char* b2 = last ? nB : cB + (size_t)(t + 2) * kstep;
            const char* a3 = a2 + kstep; const char* b3 = b2 + kstep;
            if (last && has_next) S.a_ready(nxt);
            if constexpr (SP2) {
            PG8_LDB(B0, 0, 0); PG8_LDB(B1, 0, 1); PG8_SCHED; PG8_LDA(At, 0, 0); PG8_STAGE(PG8_SA(1, 1), a1 + hstepA, voffA);
            PG8_WAIT_V(8); PG8_WAIT_L(0); PG8_BAR; PG8_MMA(0, 0, At, B0); PG8_MMA(0, 1, At, B1); PG8_BAR; PG8_SCHED;
            PG8_LDA(At, 0, 1); PG8_STAGE(PG8_SB(0, 0), b2, voffB); PG8_STAGE(PG8_SB(0, 1), b2 + hstep, voffB); PG8_STAGE(PG8_SA(0, 0), a2, voffA);
            PG8_WAIT_V(8); PG8_WAIT_L(0); PG8_BAR; PG8_MMA(1, 0, At, B0); PG8_MMA(1, 1, At, B1); PG8_BAR; PG8_SCHED;
            PG8_LDB(B0, 1, 0); PG8_LDB(B1, 1, 1); PG8_SCHED; PG8_LDA(At, 1, 0); PG8_STAGE(PG8_SA(0, 1), a2 + hstepA, voffA);
            PG8_WAIT_V(8); PG8_WAIT_L(0); PG8_BAR; PG8_MMA(0, 0, At, B0); PG8_MMA(0, 1, At, B1); PG8_BAR; PG8_SCHED;
            PG8_LDA(At, 1, 1); PG8_STAGE(PG8_SB(1, 0), b3, voffB); PG8_STAGE(PG8_SB(1, 1), b3 + hstep, voffB); PG8_STAGE(PG8_SA(1, 0), a3, voffA);
            PG8_WAIT_V(8); PG8_WAIT_L(0); PG8_BAR; PG8_MMA(1, 0, At, B0); PG8_MMA(1, 1, At, B1); PG8_BAR; PG8_SCHED;
            } else {
            PG8_LDB(B0, 0, 0); PG8_SCHED; PG8_LDA(At, 0, 0); PG8_STAGE(PG8_SA(1, 1), a1 + hstepA, voffA);
            PG8_WAIT_L(8); PG8_BAR; PG8_WAIT_L(0); PG8_MMA(0, 0, At, B0); PG8_BAR; PG8_SCHED;
            PG8_LDB(B1, 0, 1); PG8_STAGE(PG8_SB(0, 0), b2, voffB);
            PG8_BAR; PG8_WAIT_L(0); PG8_MMA(0, 1, At, B1); PG8_BAR;
            PG8_LDA(At, 0, 1); PG8_STAGE(PG8_SA(0, 0), a2, voffA);
            PG8_BAR; PG8_WAIT_L(0); PG8_MMA(1, 0, At, B0); PG8_BAR; PG8_SCHED;
            PG8_STAGE(PG8_SB(0, 1), b2 + hstep, voffB);
            PG8_WAIT_V(6); PG8_BAR; PG8_MMA(1, 1, At, B1); PG8_BAR;
            PG8_LDB(B0, 1, 0); PG8_SCHED; PG8_LDA(At, 1, 0); PG8_STAGE(PG8_SA(0, 1), a2 + hstepA, voffA);
            PG8_WAIT_L(8); PG8_BAR; PG8_WAIT_L(0); PG8_MMA(0, 0, At, B0); PG8_BAR; PG8_SCHED;
            PG8_LDB(B1, 1, 1); PG8_STAGE(PG8_SB(1, 0), b3, voffB);
            PG8_BAR; PG8_WAIT_L(0); PG8_MMA(0, 1, At, B1); PG8_BAR;
            PG8_LDA(At, 1, 1); PG8_STAGE(PG8_SA(1, 0), a3, voffA);
            PG8_BAR; PG8_WAIT_L(0); PG8_MMA(1, 0, At, B0); PG8_BAR; PG8_SCHED;
            PG8_STAGE(PG8_SB(1, 1), b3 + hstep, voffB);
            PG8_WAIT_V(6); PG8_BAR; PG8_MMA(1, 1, At, B1); PG8_BAR;
            }
        }
        if constexpr (ALIGN_EPI) { if (wr == 0) PG8_BAR; }
        if constexpr (!Epi::AFTER_DRAIN) { E(acc, cur, wr, wc, fr, fq); S.done(cur); }
        if (!has_next) break;
#pragma unroll
        for (int a = 0; a < 2; ++a)
#pragma unroll
            for (int b = 0; b < 2; ++b)
#pragma unroll
                for (int m = 0; m < 4; ++m)
#pragma unroll
                    for (int n = 0; n < 2; ++n) acc[a][b][m][n] = (f32x4){0.f, 0.f, 0.f, 0.f};
        cur = nxt; cA = nA; cB = nB; ++ui;
        if constexpr (ALIGN_EPI) { if (wr == 1) PG8_BAR; }
    }
    PG8_WAIT_V(0);
    if constexpr (!ALIGN_EPI) { if (wr == 0) PG8_BAR; }
    PG8_BAR;
    if constexpr (Epi::AFTER_DRAIN) { E.fused(acc, cur, wr, wc, fr, fq, lds, wid, lane); S.done(cur); }
#undef PG8_SA
#undef PG8_SB
#undef PG8_STAGE
#undef PG8_LDA
#undef PG8_LDB
#undef PG8_MMA
#undef PG8_WAIT_V
#undef PG8_WAIT_L
#undef PG8_BAR
#undef PG8_SCHED
}
}

using pg8::bf16_t; using pg8::bf16x8; using pg8::f32x4; using pg8::u32x4; using pg8::Unit;
typedef unsigned u32x2 __attribute__((ext_vector_type(2)));
#ifndef NPART
#define NPART 2
#endif
constexpr int TH = 65536 / NPART;
constexpr int NBP = TH / 4096;
constexpr int SEQ = 4096, DM = 1024, NIN = 6144, LDP = 5120, DFF = 2816, NUP = 5632, DMIX = 2048;
constexpr int LSTR = 136;
constexpr float EPS = 1e-5f;
constexpr int PC_Z = 0, PC_SB = 1024, PC_X = 2048, PC_P = 4096;
constexpr int LDS_BYTES = 152 * 1024;
constexpr size_t WT_IN_B = (size_t)NIN * DM * 2, WT_OUT_B = (size_t)DM * DMIX * 2, WT_UP_B = (size_t)NUP * DM * 2, WT_DN_B = (size_t)DM * DFF * 2;
constexpr size_t WL_B = WT_IN_B + WT_OUT_B + WT_UP_B + WT_DN_B;
constexpr size_t OFF_ROWSS = 2 * WL_B;
constexpr size_t OFF_CHDEC = OFF_ROWSS + (size_t)NPART * 5 * TH * 16 * 4;
constexpr size_t OFF_PROJ = OFF_CHDEC + (size_t)NBP * 32 * 16 * 2 * 4;
constexpr size_t OFF_DT = OFF_PROJ + (size_t)TH * LDP * 2;
constexpr size_t OFF_ST = OFF_DT + (size_t)TH * 32 * 4;
constexpr size_t OFF_HB = OFF_ST + (size_t)NBP * 32 * 16 * 2 * 8192 * 2;
constexpr size_t WS_END = OFF_HB + (size_t)TH * DM * 2;
constexpr size_t OFF_BAR = WS_END;
constexpr size_t OFF_EDGER = OFF_BAR + 16384;
constexpr size_t OFF_EDGEP = OFF_EDGER + (size_t)(TH / 256) * 2 * NUP * 4;
constexpr size_t OFF_WDT = OFF_EDGEP + (size_t)(TH / 256) * 2 * NUP * 4;
constexpr size_t OFF_XEDGER = OFF_WDT + (size_t)2 * 32 * DM * 2;
constexpr size_t OFF_XEDGEP = OFF_XEDGER + (size_t)(TH / 256) * 2 * 2048 * 4;
constexpr size_t OFF_DTCS = OFF_XEDGEP + (size_t)(TH / 256) * 2 * 2048 * 4;
constexpr size_t WS_NEED = OFF_DTCS + (size_t)NBP * 128 * 2048 * 4;
constexpr size_t OFF_ACT = OFF_PROJ;
static_assert((size_t)TH * DFF * 2 <= (size_t)TH * LDP * 2 && (size_t)TH * DM * 2 <= (size_t)NBP * 32 * 16 * 2 * 8192 * 2, "overlay sizes");
static_assert(OFF_HB % 256 == 0 && OFF_PROJ % 256 == 0 && OFF_ST % 256 == 0 && TH % 4096 == 0, "align");

struct Params {
    const float* in[19];
    float* out;
    unsigned char* ws;
    int ph_lo, ph_hi;
};
enum { I_X = 0, I_WIN, I_CXW, I_CXB, I_DTBF, I_DTBB, I_ALF, I_ALB, I_DSK, I_SNW, I_SCW, I_WOUT, I_N1, I_N2, I_WUP, I_FCW, I_FCB, I_WDN, I_FNW };

typedef __bf16 bf16x2_t __attribute__((ext_vector_type(2)));
typedef float f32x2_t __attribute__((ext_vector_type(2)));
__device__ __forceinline__ unsigned pk2(float lo, float hi) { const f32x2_t v = {lo, hi}; const bf16x2_t b = __builtin_convertvector(v, bf16x2_t); return __builtin_bit_cast(unsigned, b); }
__device__ __forceinline__ float bflo(unsigned w) { return __uint_as_float(w << 16); }
__device__ __forceinline__ float bfhi(unsigned w) { return __uint_as_float(w & 0xffff0000u); }
__device__ __forceinline__ float bf2f(bf16_t b) { return __uint_as_float(((unsigned)b) << 16); }
__device__ __forceinline__ float silu_f(float v) { return v * __builtin_amdgcn_rcpf(1.0f + __expf(-v)); }
__device__ __forceinline__ float softplus_f(float v) { return v > 20.0f ? v : log1pf(__expf(v)); }
__device__ __forceinline__ void unpack8(const u32x4 w, float (&f)[8]) { f[0] = bflo(w.x); f[1] = bfhi(w.x); f[2] = bflo(w.y); f[3] = bfhi(w.y); f[4] = bflo(w.z); f[5] = bfhi(w.z); f[6] = bflo(w.w); f[7] = bfhi(w.w); }
__device__ __forceinline__ u32x4 pack8(const float (&f)[8]) { u32x4 w; w.x = pk2(f[0], f[1]); w.y = pk2(f[2], f[3]); w.z = pk2(f[4], f[5]); w.w = pk2(f[6], f[7]); return w; }

__device__ __forceinline__ float row_rs(const float* rowss, int row) {
    const f32x4 a = *(const f32x4*)(rowss + (size_t)row * 16), b = *(const f32x4*)(rowss + (size_t)row * 16 + 4), c = *(const f32x4*)(rowss + (size_t)row * 16 + 8), d = *(const f32x4*)(rowss + (size_t)row * 16 + 12);
    const float s = (((a[0] + a[1]) + (a[2] + a[3])) + ((b[0] + b[1]) + (b[2] + b[3]))) + (((c[0] + c[1]) + (c[2] + c[3])) + ((d[0] + d[1]) + (d[2] + d[3])));
    return rsqrtf(s * (1.0f / 1024.0f) + EPS);
}
__device__ __forceinline__ void panel_rs(const float* rowss, int pm, int& cached_pm, float* rs_lds) {
    if (pm != cached_pm) {
        cached_pm = pm;
        int tid_ = threadIdx.x; asm volatile("" : "+v"(tid_));
        __syncthreads();
        if (tid_ < 256) rs_lds[tid_] = row_rs(rowss, pm * 256 + tid_);
        __syncthreads();
    }
}
struct EpiUp {
    static constexpr bool PERM = true, AFTER_DRAIN = false;
    bf16_t* U; const float* rowss; float* rs_lds; mutable int cached_pm;
    __device__ __forceinline__ void operator()(const f32x4 (&acc)[2][2][4][2], const Unit& u, int wr, int wc, int fr, int fq) const {
        const int row0 = u.pm * 256 + wr * 64 + fr;
        panel_rs(rowss, u.pm, cached_pm, rs_lds);
#pragma unroll
        for (int ai = 0; ai < 2; ++ai)
#pragma unroll
            for (int m = 0; m < 4; ++m) {
                const int row = row0 + ai * 128 + m * 16;
                const float rs = rs_lds[row & 255];
#pragma unroll
                for (int bj = 0; bj < 2; ++bj) { const f32x4 v0 = acc[ai][bj][m][0] * rs, v1 = acc[ai][bj][m][1] * rs; u32x4 w; w.x = pk2(v0[0], v0[1]); w.y = pk2(v0[2], v0[3]); w.z = pk2(v1[0], v1[1]); w.w = pk2(v1[2], v1[3]);
                    *(u32x4*)(U + (size_t)row * NUP + u.pn * 256 + bj * 128 + wc * 32 + 8 * fq) = w; }
            }
    }
};
struct EpiRes {
    static constexpr bool PERM = true, AFTER_DRAIN = false;
    bf16_t* HB; float* rowss_next;
    __device__ __forceinline__ void operator()(const f32x4 (&acc)[2][2][4][2], const Unit& u, int wr, int wc, int fr, int fq) const {
        const int row0 = u.pm * 256 + wr * 64 + fr, col0 = u.pn * 256 + wc * 32 + 8 * fq;
#pragma unroll
        for (int ai = 0; ai < 2; ++ai)
#pragma unroll
            for (int m = 0; m < 4; ++m) {
                const int row = row0 + ai * 128 + m * 16; float ss = 0.f;
#pragma unroll
                for (int bj = 0; bj < 2; ++bj) { const size_t off = (size_t)row * DM + col0 + bj * 128;
                    const u32x4 hb = *(const u32x4*)(HB + off);
                    f32x4 o0 = acc[ai][bj][m][0], o1 = acc[ai][bj][m][1];
                    o0[0] += bflo(hb.x); o0[1] += bfhi(hb.x); o0[2] += bflo(hb.y); o0[3] += bfhi(hb.y); o1[0] += bflo(hb.z); o1[1] += bfhi(hb.z); o1[2] += bflo(hb.w); o1[3] += bfhi(hb.w);
                    u32x4 w; w.x = pk2(o0[0], o0[1]); w.y = pk2(o0[2], o0[3]); w.z = pk2(o1[0], o1[1]); w.w = pk2(o1[2], o1[3]); *(u32x4*)(HB + off) = w;
                    ss += ((o0[0] * o0[0] + o0[1] * o0[1]) + (o0[2] * o0[2] + o0[3] * o0[3])) + ((o1[0] * o1[0] + o1[1] * o1[1]) + (o1[2] * o1[2] + o1[3] * o1[3])); }
                ss += __shfl_xor(ss, 16); ss += __shfl_xor(ss, 32);
                if (fq == 0) rowss_next[(size_t)row * 16 + u.pn * 4 + wc] = ss;
            }
    }
};


__device__ __forceinline__ float dpp_shr1(float old, float src) { return __builtin_bit_cast(float, __builtin_amdgcn_update_dpp(__builtin_bit_cast(int, old), __builtin_bit_cast(int, src), 0x111, 0xf, 0xf, false)); }
__device__ __forceinline__ float dpp_shl1(float old, float src) { return __builtin_bit_cast(float, __builtin_amdgcn_update_dpp(__builtin_bit_cast(int, old), __builtin_bit_cast(int, src), 0x101, 0xf, 0xf, false)); }
__device__ __forceinline__ float dpp_ror1(float src) { return __builtin_bit_cast(float, __builtin_amdgcn_update_dpp(0, __builtin_bit_cast(int, src), 0x121, 0xf, 0xf, false)); }
__device__ __forceinline__ float dpp_rol1(float src) { return __builtin_bit_cast(float, __builtin_amdgcn_update_dpp(0, __builtin_bit_cast(int, src), 0x12F, 0xf, 0xf, false)); }
struct EpiIn {
    static constexpr bool PERM = true, AFTER_DRAIN = false;
    bf16_t* P; const float* rowss; float* rs_lds; float* xch; const float* cxw; const float* cxb; float* XEDGER; float* XEDGEP; mutable int cached_pm;
    __device__ __forceinline__ void operator()(const f32x4 (&acc_)[2][2][4][2], const Unit& u, int wr, int wc, int fr_, int fq_) const {
        f32x4 (&acc)[2][2][4][2] = const_cast<f32x4 (&)[2][2][4][2]>(acc_);
        int fr = fr_, fq = fq_; asm volatile("" : "+v"(fr), "+v"(fq));
        const int row0 = u.pm * 256 + wr * 64 + fr; const int pn = u.pn;
        panel_rs(rowss, u.pm, cached_pm, rs_lds);
        if (pn >= 4 && pn < 12) {
#pragma unroll
            for (int ai = 0; ai < 2; ++ai)
#pragma unroll
                for (int m = 0; m < 4; ++m) { const float rs = rs_lds[ai * 128 + wr * 64 + m * 16 + fr];
#pragma unroll
                    for (int bj = 0; bj < 2; ++bj)
#pragma unroll
                        for (int n = 0; n < 2; ++n) acc[ai][bj][m][n] *= rs; }
#pragma unroll
            for (int ai = 0; ai < 2; ++ai) { const int seg = 2 * ai + wr;
                if (fr == 0) {
#pragma unroll
                    for (int bj = 0; bj < 2; ++bj)
#pragma unroll
                        for (int n = 0; n < 2; ++n) *(f32x4*)(xch + (((seg * 2 + 0) * 4 + wc) * 4 + fq) * 16 + bj * 8 + n * 4) = acc[ai][bj][0][n]; }
                if (fr == 15) {
#pragma unroll
                    for (int bj = 0; bj < 2; ++bj)
#pragma unroll
                        for (int n = 0; n < 2; ++n) *(f32x4*)(xch + (((seg * 2 + 1) * 4 + wc) * 4 + fq) * 16 + bj * 8 + n * 4) = acc[ai][bj][3][n]; } }
            __syncthreads();
            auto body = [&](auto BJ_, auto AI_) {
                constexpr int bj = decltype(BJ_)::value, ai = decltype(AI_)::value;
                const int ch = (pn - 4) * 256 + bj * 128 + wc * 32 + 8 * fq, seg = 2 * ai + wr;
                f32x4 w0[2], w1[2], w2[2], bb[2];
#pragma unroll
                for (int n = 0; n < 2; ++n) { w0[n] = *(const f32x4*)(cxw + ch + 4 * n); w1[n] = *(const f32x4*)(cxw + 2048 + ch + 4 * n); w2[n] = *(const f32x4*)(cxw + 4096 + ch + 4 * n); bb[n] = *(const f32x4*)(cxb + ch + 4 * n); }
#pragma unroll
                for (int m = 0; m < 4; ++m) {
                    f32x4 pr[2], pe[2], ne[2];
#pragma unroll
                    for (int n = 0; n < 2; ++n) { pe[n] = (f32x4){0.f, 0.f, 0.f, 0.f}; ne[n] = pe[n];
                        if (m == 0 && seg > 0) pe[n] = *(const f32x4*)(xch + ((((seg - 1) * 2 + 1) * 4 + wc) * 4 + fq) * 16 + bj * 8 + n * 4);
                        if (m == 3 && seg < 3) ne[n] = *(const f32x4*)(xch + ((((seg + 1) * 2 + 0) * 4 + wc) * 4 + fq) * 16 + bj * 8 + n * 4); }
#pragma unroll
                    for (int n = 0; n < 2; ++n)
#pragma unroll
                        for (int j = 0; j < 4; ++j) {
                            const float cur = acc[ai][bj][m][n][j];
                            const float ov = (m > 0) ? dpp_ror1(acc[ai][bj][m > 0 ? m - 1 : 0][n][j]) : pe[n][j];
                            const float nv = (m < 3) ? dpp_rol1(acc[ai][bj][m < 3 ? m + 1 : 3][n][j]) : ne[n][j];
                            const float prev = dpp_shr1(ov, cur), next = dpp_shl1(nv, cur);
                            pr[n][j] = w0[n][j] * prev + w1[n][j] * cur + w2[n][j] * next + bb[n][j]; }
                    const int row = u.pm * 256 + ai * 128 + wr * 64 + m * 16 + fr;
                    u32x4 w; w.x = pk2(silu_f(pr[0][0]), silu_f(pr[0][1])); w.y = pk2(silu_f(pr[0][2]), silu_f(pr[0][3])); w.z = pk2(silu_f(pr[1][0]), silu_f(pr[1][1])); w.w = pk2(silu_f(pr[1][2]), silu_f(pr[1][3]));
                    *(u32x4*)(P + (size_t)row * LDP + PC_X + ch) = w;
                    if ((m == 0 && seg == 0 && fr == 0) || (m == 3 && seg == 3 && fr == 15)) {
                        const size_t eb = ((size_t)u.pm * 2 + (m == 0 ? 0 : 1)) * 2048 + ch;
                        *(f32x4*)(XEDGER + eb) = acc[ai][bj][m][0]; *(f32x4*)(XEDGER + eb + 4) = acc[ai][bj][m][1];
                        *(f32x4*)(XEDGEP + eb) = pr[0];             *(f32x4*)(XEDGEP + eb + 4) = pr[1]; }
                }
                __builtin_amdgcn_sched_barrier(0);
            };
            body(std::integral_constant<int, 0>{}, std::integral_constant<int, 0>{}); body(std::integral_constant<int, 0>{}, std::integral_constant<int, 1>{});
            body(std::integral_constant<int, 1>{}, std::integral_constant<int, 0>{}); body(std::integral_constant<int, 1>{}, std::integral_constant<int, 1>{});
            return;
        }
#pragma unroll
        for (int ai = 0; ai < 2; ++ai)
#pragma unroll
            for (int m = 0; m < 4; ++m) {
                const int row = row0 + ai * 128 + m * 16;
                const float rs = rs_lds[row & 255];
                if (pn < 16) {
                    const int cbase = (pn < 4 ? PC_Z + pn * 256 : PC_SB + (pn - 12) * 256);
#pragma unroll
                    for (int bj = 0; bj < 2; ++bj) { const f32x4 v0 = acc[ai][bj][m][0] * rs, v1 = acc[ai][bj][m][1] * rs; u32x4 w; w.x = pk2(v0[0], v0[1]); w.y = pk2(v0[2], v0[3]); w.z = pk2(v1[0], v1[1]); w.w = pk2(v1[2], v1[3]);
                        *(u32x4*)(P + (size_t)row * LDP + cbase + bj * 128 + wc * 32 + 8 * fq) = w; }
                } else {
                    const float rs2 = rs * rs; const f32x4 v0 = acc[ai][0][m][0] * acc[ai][1][m][0] * rs2, v1 = acc[ai][0][m][1] * acc[ai][1][m][1] * rs2;
                    u32x4 w; w.x = pk2(v0[0], v0[1]); w.y = pk2(v0[2], v0[3]); w.z = pk2(v1[0], v1[1]); w.w = pk2(v1[2], v1[3]);
                    *(u32x4*)(P + (size_t)row * LDP + PC_P + (pn - 16) * 128 + wc * 32 + 8 * fq) = w;
                }
            }
    }
};
struct EpiAct {
    static constexpr bool PERM = true, AFTER_DRAIN = false;
    bf16_t* ACT; const float* rowss; float* rs_lds; float* xch; const float* cw; const float* cb; float* EDGER; float* EDGEP; mutable int cached_pm;
    __device__ __forceinline__ void operator()(const f32x4 (&acc_)[2][2][4][2], const Unit& u, int wr, int wc, int fr_, int fq_) const {
        int fr = fr_, fq = fq_; asm volatile("" : "+v"(fr), "+v"(fq));
        f32x4 (&acc)[2][2][4][2] = const_cast<f32x4 (&)[2][2][4][2]>(acc_);
        panel_rs(rowss, u.pm, cached_pm, rs_lds);
#pragma unroll
        for (int ai = 0; ai < 2; ++ai)
#pragma unroll
            for (int m = 0; m < 4; ++m) { const float rs = rs_lds[ai * 128 + wr * 64 + m * 16 + fr];
#pragma unroll
                for (int bj = 0; bj < 2; ++bj)
#pragma unroll
                    for (int n = 0; n < 2; ++n) acc[ai][bj][m][n] *= rs; }
#pragma unroll
        for (int ai = 0; ai < 2; ++ai) { const int seg = 2 * ai + wr;
            if (fr == 0) {
#pragma unroll
                for (int bj = 0; bj < 2; ++bj)
#pragma unroll
                    for (int n = 0; n < 2; ++n) *(f32x4*)(xch + (((seg * 2 + 0) * 4 + wc) * 4 + fq) * 16 + bj * 8 + n * 4) = acc[ai][bj][0][n]; }
            if (fr == 15) {
#pragma unroll
                for (int bj = 0; bj < 2; ++bj)
#pragma unroll
                    for (int n = 0; n < 2; ++n) *(f32x4*)(xch + (((seg * 2 + 1) * 4 + wc) * 4 + fq) * 16 + bj * 8 + n * 4) = acc[ai][bj][3][n]; } }
        const int f0 = u.pn * 128 + wc * 32 + 8 * fq;
        f32x4 w0v[8];
        { const int f = f0; w0v[0] = *(const f32x4*)(cw + f); w0v[1] = *(const f32x4*)(cw + NUP + f); w0v[2] = *(const f32x4*)(cw + 2 * NUP + f); w0v[3] = *(const f32x4*)(cb + f);
          w0v[4] = *(const f32x4*)(cw + DFF + f); w0v[5] = *(const f32x4*)(cw + NUP + DFF + f); w0v[6] = *(const f32x4*)(cw + 2 * NUP + DFF + f); w0v[7] = *(const f32x4*)(cb + DFF + f); }
        __syncthreads();
        auto body = [&](auto N_, auto AI_, const f32x4 (&wv)[8]) {
            constexpr int n = decltype(N_)::value, ai = decltype(AI_)::value;
            const int f = f0 + 4 * n, seg = 2 * ai + wr;
            const f32x4 wg0 = wv[0], wg1 = wv[1], wg2 = wv[2], bg = wv[3], wu0 = wv[4], wu1 = wv[5], wu2 = wv[6], bu = wv[7];
            f32x4 peg = (f32x4){0.f, 0.f, 0.f, 0.f}, peu = peg, neg = peg, neu = peg;
            if (seg > 0) { peg = *(const f32x4*)(xch + ((((seg - 1) * 2 + 1) * 4 + wc) * 4 + fq) * 16 + n * 4); peu = *(const f32x4*)(xch + ((((seg - 1) * 2 + 1) * 4 + wc) * 4 + fq) * 16 + 8 + n * 4); }
            if (seg < 3) { neg = *(const f32x4*)(xch + ((((seg + 1) * 2 + 0) * 4 + wc) * 4 + fq) * 16 + n * 4); neu = *(const f32x4*)(xch + ((((seg + 1) * 2 + 0) * 4 + wc) * 4 + fq) * 16 + 8 + n * 4); }
#pragma unroll
            for (int m = 0; m < 4; ++m) {
                const f32x4 sgm = acc[ai][0][m][n], sum_ = acc[ai][1][m][n];
                f32x4 pg, pu;
#pragma unroll
                for (int j = 0; j < 4; ++j) {
                    const float og = (m > 0) ? dpp_ror1(acc[ai][0][m > 0 ? m - 1 : 0][n][j]) : peg[j], ou = (m > 0) ? dpp_ror1(acc[ai][1][m > 0 ? m - 1 : 0][n][j]) : peu[j];
                    const float ng = (m < 3) ? dpp_rol1(acc[ai][0][m < 3 ? m + 1 : 3][n][j]) : neg[j], nu = (m < 3) ? dpp_rol1(acc[ai][1][m < 3 ? m + 1 : 3][n][j]) : neu[j];
                    const float gprev = dpp_shr1(og, sgm[j]), uprev = dpp_shr1(ou, sum_[j]);
                    const float gnext = dpp_shl1(ng, sgm[j]), unext = dpp_shl1(nu, sum_[j]);
                    pg[j] = wg0[j] * gprev + wg1[j] * sgm[j] + wg2[j] * gnext + bg[j];
                    pu[j] = wu0[j] * uprev + wu1[j] * sum_[j] + wu2[j] * unext + bu[j];
                }
                const int row = u.pm * 256 + ai * 128 + wr * 64 + m * 16 + fr;
                u32x2 w; w.x = pk2(silu_f(pg[0]) * pu[0], silu_f(pg[1]) * pu[1]); w.y = pk2(silu_f(pg[2]) * pu[2], silu_f(pg[3]) * pu[3]);
                *(u32x2*)(ACT + (size_t)row * DFF + f) = w;
                if ((m == 0 && seg == 0 && fr == 0) || (m == 3 && seg == 3 && fr == 15)) {
                    const size_t eb = ((size_t)u.pm * 2 + (m == 0 ? 0 : 1)) * NUP;
                    *(f32x4*)(EDGER + eb + f) = sgm; *(f32x4*)(EDGER + eb + DFF + f) = sum_;
                    *(f32x4*)(EDGEP + eb + f) = pg;  *(f32x4*)(EDGEP + eb + DFF + f) = pu; }
            }
        };
        body(std::integral_constant<int, 0>{}, std::integral_constant<int, 0>{}, w0v);
        f32x4 w1v[8];
        { const int f = f0 + 4; w1v[0] = *(const f32x4*)(cw + f); w1v[1] = *(const f32x4*)(cw + NUP + f); w1v[2] = *(const f32x4*)(cw + 2 * NUP + f); w1v[3] = *(const f32x4*)(cb + f);
          w1v[4] = *(const f32x4*)(cw + DFF + f); w1v[5] = *(const f32x4*)(cw + NUP + DFF + f); w1v[6] = *(const f32x4*)(cw + 2 * NUP + DFF + f); w1v[7] = *(const f32x4*)(cb + DFF + f); }
        __builtin_amdgcn_sched_barrier(0);
        body(std::integral_constant<int, 0>{}, std::integral_constant<int, 1>{}, w0v);
        __builtin_amdgcn_sched_barrier(0);
        body(std::integral_constant<int, 1>{}, std::integral_constant<int, 0>{}, w1v);
        __builtin_amdgcn_sched_barrier(0);
        body(std::integral_constant<int, 1>{}, std::integral_constant<int, 1>{}, w1v);
    }
};

__device__ __forceinline__ int src_in(int j) {
    if (j < 3072) return j;
    if (j < 4096) return j + 32;
    { const int t = (j - 4096) >> 8, r = (j - 4096) & 255; return r < 128 ? 4128 + t * 128 + r : 5152 + t * 128 + (r - 128); }
}
__device__ __forceinline__ void convert_weight(const float* W, int ldw, const float* scale, bf16_t* Wt, int K, int N, int kind, float* tile, int blk, int nblk) {
    int tid_ = threadIdx.x; asm volatile("" : "+v"(tid_));
    const int tid = tid_, nkt = K / 64, ntile = (N / 256) * nkt;
    for (int t = blk; t < ntile; t += nblk) {
        const int j0 = (t / nkt) * 256, k0 = (t % nkt) * 64;
        float v[32];
#pragma unroll
        for (int i = 0; i < 32; ++i) { const int kk = (tid >> 8) + 2 * i, jj = tid & 255; const int jx = j0 + jj; const int sj = kind == 1 ? src_in(jx) : (kind == 2 ? (((jx & 255) < 128) ? (jx >> 8) * 128 + (jx & 127) : DFF + (jx >> 8) * 128 + (jx & 127)) : jx);
            v[i] = W[(size_t)(k0 + kk) * ldw + (sj >= 0 ? sj : 0)]; if (sj < 0) v[i] = 0.f; }
        __syncthreads();
#pragma unroll
        for (int i = 0; i < 32; ++i) { const int kk = (tid >> 8) + 2 * i, jj = tid & 255; tile[kk * 257 + jj] = v[i]; }
        __syncthreads();
        const int kk = 2 * (tid & 31); const float s0 = scale ? scale[k0 + kk] : 1.0f, s1 = scale ? scale[k0 + kk + 1] : 1.0f;
#pragma unroll
        for (int i = 0; i < 16; ++i) { const int jj = (tid >> 5) + 16 * i;
            *(unsigned*)(Wt + (size_t)(j0 + jj) * K + k0 + kk) = pk2(tile[kk * 257 + jj] * s0, tile[(kk + 1) * 257 + jj] * s1); }
    }
}
__device__ __forceinline__ void phase_weights(const Params& p, float* tile) {
    const int G = gridDim.x; int cum = 0;
#define WBLK ((int)((blockIdx.x + (unsigned)G - (unsigned)(cum % G)) % (unsigned)G))
    for (int l = 0; l < 2; ++l) {
        unsigned char* wb = p.ws + (size_t)l * WL_B;
        convert_weight(p.in[I_WIN] + (size_t)l * DM * 6176, 6176, p.in[I_N1] + l * DM, (bf16_t*)wb, DM, NIN, 1, tile, WBLK, G); cum += (NIN / 256) * (DM / 64);
        convert_weight(p.in[I_WOUT] + (size_t)l * DMIX * DM, DM, nullptr, (bf16_t*)(wb + WT_IN_B), DMIX, DM, 0, tile, WBLK, G); cum += (DM / 256) * (DMIX / 64);
        convert_weight(p.in[I_WUP] + (size_t)l * DM * NUP, NUP, p.in[I_N2] + l * DM, (bf16_t*)(wb + WT_IN_B + WT_OUT_B), DM, NUP, 2, tile, WBLK, G); cum += (NUP / 256) * (DM / 64);
        convert_weight(p.in[I_WDN] + (size_t)l * DFF * DM, DM, nullptr, (bf16_t*)(wb + WT_IN_B + WT_OUT_B + WT_UP_B), DFF, DM, 0, tile, WBLK, G); cum += (DM / 256) * (DFF / 64);
    }
#undef WBLK
    {
        bf16_t* WDT = (bf16_t*)(p.ws + OFF_WDT); int tid_ = threadIdx.x; asm volatile("" : "+v"(tid_));
        for (int idx = blockIdx.x * 512 + tid_; idx < 2 * 32 * DM; idx += gridDim.x * 512) { const int l = idx >> 15, j = (idx >> 10) & 31, k = idx & 1023;
            const float v = p.in[I_WIN][((size_t)l * DM + k) * 6176 + 3072 + j] * p.in[I_N1][l * DM + k]; const unsigned w = pk2(v, v); WDT[idx] = (bf16_t)(w & 0xffffu); }
    }
}
__device__ __forceinline__ void phase_prep(const Params& p, int hf) {
    int tid_ = threadIdx.x; asm volatile("" : "+v"(tid_));
    const int tid = tid_, wid = tid >> 6, lane = tid & 63;
    float* rowss = (float*)(p.ws + OFF_ROWSS) + (size_t)hf * 5 * TH * 16;
    bf16_t* HB = (bf16_t*)(p.ws + OFF_HB);
    const float* x = p.in[I_X] + (size_t)hf * TH * DM;
#pragma unroll 4
    for (int row = blockIdx.x * 8 + wid; row < TH; row += gridDim.x * 8) {
        float ss = 0.f;
#pragma unroll
        for (int i = 0; i < 2; ++i) { const int c = i * 512 + lane * 8;
            const f32x4 v = *(const f32x4*)(x + (size_t)row * DM + c), v2 = *(const f32x4*)(x + (size_t)row * DM + c + 4);
            ss += ((v[0] * v[0] + v[1] * v[1]) + (v[2] * v[2] + v[3] * v[3])) + ((v2[0] * v2[0] + v2[1] * v2[1]) + (v2[2] * v2[2] + v2[3] * v2[3]));
            u32x4 w; w.x = pk2(v[0], v[1]); w.y = pk2(v[2], v[3]); w.z = pk2(v2[0], v2[1]); w.w = pk2(v2[2], v2[3]); *(u32x4*)(HB + (size_t)row * DM + c) = w; }
#pragma unroll
        for (int o = 32; o >= 1; o >>= 1) ss += __shfl_xor(ss, o);
        if (lane < 16) rowss[(size_t)row * 16 + lane] = lane == 0 ? ss : 0.f;
    }
}
__device__ __forceinline__ void phase_final(const Params& p, int hf) {
    int tid_ = threadIdx.x; asm volatile("" : "+v"(tid_));
    const int tid = tid_, wid = tid >> 6, lane = tid & 63;
    const float* rowss = (const float*)(p.ws + OFF_ROWSS) + ((size_t)hf * 5 + 4) * TH * 16;
    float* h = p.out + (size_t)hf * TH * DM; const float* w = p.in[I_FNW]; const bf16_t* HB = (const bf16_t*)(p.ws + OFF_HB);
#pragma unroll 4
    for (int row = blockIdx.x * 8 + wid; row < TH; row += gridDim.x * 8) {
        const float rs = row_rs(rowss, row);
#pragma unroll
        for (int i = 0; i < 2; ++i) { const int c = i * 512 + lane * 8; const u32x4 hb = *(const u32x4*)(HB + (size_t)row * DM + c); const f32x4 g = *(const f32x4*)(w + c), g2 = *(const f32x4*)(w + c + 4);
            f32x4 v, v2; v[0] = bflo(hb.x); v[1] = bfhi(hb.x); v[2] = bflo(hb.y); v[3] = bfhi(hb.y); v2[0] = bflo(hb.z); v2[1] = bfhi(hb.z); v2[2] = bflo(hb.w); v2[3] = bfhi(hb.w);
            *(f32x4*)(h + (size_t)row * DM + c) = v * rs * g; *(f32x4*)(h + (size_t)row * DM + c + 4) = v2 * rs * g2; }
    }
}
__device__ __forceinline__ void phase_edgefix(const Params& p, int l) {
    const float* EDGER = (const float*)(p.ws + OFF_EDGER); const float* EDGEP = (const float*)(p.ws + OFF_EDGEP); bf16_t* ACT = (bf16_t*)(p.ws + OFF_ACT);
    const float* cw = p.in[I_FCW] + (size_t)l * 3 * NUP;
    int tid_ = threadIdx.x; asm volatile("" : "+v"(tid_));
    for (int idx = blockIdx.x * 512 + tid_; idx < (TH / 256) * 2 * DFF; idx += gridDim.x * 512) {
        const int f = idx % DFF, pe = idx / DFF, e = pe & 1, pm = pe >> 1, t = 256 * pm + (e ? 255 : 0);
        const bool has = e ? (((t + 1) % SEQ) != 0) : ((t % SEQ) != 0);
        float ng = 0.f, nu = 0.f;
        if (has) { const size_t nb = ((size_t)(pm + (e ? 1 : -1)) * 2 + (e ? 0 : 1)) * NUP; ng = EDGER[nb + f]; nu = EDGER[nb + DFF + f]; }
        const int wk = e ? 2 : 0; const size_t eb = ((size_t)pm * 2 + e) * NUP;
        const float pg = EDGEP[eb + f] + cw[wk * NUP + f] * ng, pu = EDGEP[eb + DFF + f] + cw[wk * NUP + DFF + f] * nu;
        const float o = silu_f(pg) * pu; const unsigned w = pk2(o, o); ACT[(size_t)t * DFF + f] = (bf16_t)(w & 0xffffu);
    }
}
__device__ __forceinline__ void edgefix_panel(const Params& p, int l, int pm) {
    const float* EDGER = (const float*)(p.ws + OFF_EDGER); const float* EDGEP = (const float*)(p.ws + OFF_EDGEP); bf16_t* ACT = (bf16_t*)(p.ws + OFF_ACT);
    const float* cw = p.in[I_FCW] + (size_t)l * 3 * NUP;
    int tid_ = threadIdx.x; asm volatile("" : "+v"(tid_));
    for (int task = tid_; task < 2 * (DFF / 8); task += 512) {
        const int e = task >= DFF / 8 ? 1 : 0, f = (task - e * (DFF / 8)) * 8, t = 256 * pm + (e ? 255 : 0);
        const bool has = e ? (((t + 1) % SEQ) != 0) : ((t % SEQ) != 0);
        const size_t eb = ((size_t)pm * 2 + e) * NUP;
        f32x4 pg0 = *(const f32x4*)(EDGEP + eb + f), pg1 = *(const f32x4*)(EDGEP + eb + f + 4), pu0 = *(const f32x4*)(EDGEP + eb + DFF + f), pu1 = *(const f32x4*)(EDGEP + eb + DFF + f + 4);
        if (has) { const size_t nb = ((size_t)(pm + (e ? 1 : -1)) * 2 + (e ? 0 : 1)) * NUP; const int wk = e ? 2 : 0;
            pg0 += *(const f32x4*)(cw + wk * NUP + f) * *(const f32x4*)(EDGER + nb + f);             pg1 += *(const f32x4*)(cw + wk * NUP + f + 4) * *(const f32x4*)(EDGER + nb + f + 4);
            pu0 += *(const f32x4*)(cw + wk * NUP + DFF + f) * *(const f32x4*)(EDGER + nb + DFF + f); pu1 += *(const f32x4*)(cw + wk * NUP + DFF + f + 4) * *(const f32x4*)(EDGER + nb + DFF + f + 4); }
        float o[8];
#pragma unroll
        for (int j = 0; j < 4; ++j) { o[j] = silu_f(pg0[j]) * pu0[j]; o[4 + j] = silu_f(pg1[j]) * pu1[j]; }
        *(u32x4*)(ACT + (size_t)t * DFF + f) = pack8(o);
    }
}
__device__ __forceinline__ void phase_dt(const Params& p, int l, const float* rowss) {
    int tid_ = threadIdx.x; asm volatile("" : "+v"(tid_));
    const int wid = tid_ >> 6, lane = tid_ & 63, fr = lane & 15, fq = lane >> 4;
    const bf16_t* HB = (const bf16_t*)(p.ws + OFF_HB); const bf16_t* WDT = (const bf16_t*)(p.ws + OFF_WDT) + (size_t)l * 32 * DM; float* DT = (float*)(p.ws + OFF_DT);
    for (int tb = blockIdx.x; tb < TH / 128; tb += gridDim.x) {
        const int tok = tb * 128 + wid * 16 + fr;
        f32x4 a0 = (f32x4){0.f, 0.f, 0.f, 0.f}, a1 = a0;
#pragma unroll 1
        for (int k0 = 0; k0 < 32; k0 += 8) {
            bf16x8 hf[8], w0[8], w1[8];
#pragma unroll
            for (int i = 0; i < 8; ++i) { const int ko = 32 * (k0 + i) + 8 * fq;
                hf[i] = *(const bf16x8*)(HB + (size_t)tok * DM + ko); w0[i] = *(const bf16x8*)(WDT + (size_t)fr * DM + ko); w1[i] = *(const bf16x8*)(WDT + (size_t)(16 + fr) * DM + ko); }
#pragma unroll
            for (int i = 0; i < 8; ++i) { a0 = __builtin_amdgcn_mfma_f32_16x16x32_bf16(w0[i], hf[i], a0, 0, 0, 0); a1 = __builtin_amdgcn_mfma_f32_16x16x32_bf16(w1[i], hf[i], a1, 0, 0, 0); }
        }
        const float rs = row_rs(rowss, tok);
        *(f32x4*)(DT + (size_t)tok * 32 + 4 * fq) = a0 * rs; *(f32x4*)(DT + (size_t)tok * 32 + 16 + 4 * fq) = a1 * rs;
    }
}
__device__ __forceinline__ void phase_xedgefix(const Params& p, int l) {
    const float* XEDGER = (const float*)(p.ws + OFF_XEDGER); const float* XEDGEP = (const float*)(p.ws + OFF_XEDGEP); bf16_t* P = (bf16_t*)(p.ws + OFF_PROJ);
    const float* cxw = p.in[I_CXW] + (size_t)l * 3 * 2048;
    int tid_ = threadIdx.x; asm volatile("" : "+v"(tid_));
    for (int idx = blockIdx.x * 512 + tid_; idx < (TH / 256) * 2 * 2048; idx += gridDim.x * 512) {
        const int ch = idx & 2047, pe = idx >> 11, e = pe & 1, pm = pe >> 1, t = 256 * pm + (e ? 255 : 0);
        const bool has = e ? (((t + 1) % SEQ) != 0) : ((t % SEQ) != 0);
        float nb = 0.f;
        if (has) nb = XEDGER[((size_t)(pm + (e ? 1 : -1)) * 2 + (e ? 0 : 1)) * 2048 + ch];
        const float pre = XEDGEP[((size_t)pm * 2 + e) * 2048 + ch] + cxw[(e ? 2 : 0) * 2048 + ch] * nb;
        const float o = silu_f(pre); const unsigned w = pk2(o, o); P[(size_t)t * LDP + PC_X + ch] = (bf16_t)(w & 0xffffu);
    }
}
__device__ __forceinline__ void phase_shortconv(const Params& p, int l) {
    bf16_t* P = (bf16_t*)(p.ws + OFF_PROJ);
    const float* cw = p.in[I_SCW] + (size_t)l * 3 * 1024;
    int tid_ = threadIdx.x; asm volatile("" : "+v"(tid_));
    const int j0 = (tid_ & 127) * 8, sub = tid_ >> 7;
    float w[3][8];
#pragma unroll
    for (int k = 0; k < 3; ++k) { const f32x4 a0 = *(const f32x4*)(cw + k * 1024 + j0), a1 = *(const f32x4*)(cw + k * 1024 + j0 + 4);
#pragma unroll
        for (int j = 0; j < 4; ++j) { w[k][j] = a0[j]; w[k][4 + j] = a1[j]; } }
    for (int tb = blockIdx.x; tb < TH / 32; tb += gridDim.x) {
        const int t0 = tb * 32 + sub * 8, pos0 = t0 % SEQ;
        u32x4 rp[10], rb[8];
#pragma unroll
        for (int r = 0; r < 10; ++r) { const int pos = pos0 - 1 + r; const bool ok = pos >= 0 && pos < SEQ;
            rp[r] = *(const u32x4*)(P + (size_t)(ok ? t0 - 1 + r : t0) * LDP + PC_P + j0);
            if (!ok) rp[r] = (u32x4){0u, 0u, 0u, 0u}; }
#pragma unroll
        for (int r = 0; r < 8; ++r) rb[r] = *(const u32x4*)(P + (size_t)(t0 + r) * LDP + PC_SB + j0);
#pragma unroll
        for (int r = 0; r < 8; ++r) { float p0[8], p1[8], p2[8], sb[8], o[8]; unpack8(rp[r], p0); unpack8(rp[r + 1], p1); unpack8(rp[r + 2], p2); unpack8(rb[r], sb);
#pragma unroll
            for (int j = 0; j < 8; ++j) o[j] = sb[j] * (w[0][j] * p0[j] + w[1][j] * p1[j] + w[2][j] * p2[j]);
            *(u32x4*)(P + (size_t)(t0 + r) * LDP + PC_SB + j0) = pack8(o); }
    }
}

__device__ __forceinline__ int chperm(int t, int i) { return 32 * (t >> 1) + 8 * (i >> 2) + 4 * (t & 1) + (i & 3); }
__device__ __forceinline__ void ssd_dt_load(const float* DT, int t0, int g, int wid, int lane, float& r0, float& r1) {
    const int dir = wid >> 2, hh = wid & 3, h = 4 * g + hh;
    r0 = DT[(size_t)(t0 + lane) * 32 + dir * 16 + h]; r1 = DT[(size_t)(t0 + 64 + lane) * 32 + dir * 16 + h];
}
__device__ __forceinline__ float ssd_dt_scan(const Params& p, int l, float r0, float r1, int g, float* sm_dt, float* sm_cs, int wid, int lane) {
    const int dir = wid >> 2, hh = wid & 3, h = 4 * g + hh;
    const float bias = p.in[dir ? I_DTBB : I_DTBF][l * 16 + h]; const float A = -__expf(p.in[dir ? I_ALB : I_ALF][l * 16 + h]);
    const float d0 = softplus_f(r0 + bias), d1 = softplus_f(r1 + bias);
    const float a0 = A * d0, a1 = A * d1;
    float s0 = a0, s1 = a1;
#pragma unroll
    for (int o = 1; o < 64; o <<= 1) { const float u0 = __shfl_up(s0, o), u1 = __shfl_up(s1, o); if (lane >= o) { s0 += u0; s1 += u1; } }
    const float tot0 = __shfl(s0, 63); s1 += tot0; const float total = __shfl(s1, 63);
    float c0 = s0, c1 = s1;
    if (dir) { c0 = total - s0 + a0; c1 = total - s1 + a1; }
    const int b = (dir * 4 + hh) * 128;
    sm_dt[b + lane] = d0; sm_dt[b + 64 + lane] = d1; sm_cs[b + lane] = c0; sm_cs[b + 64 + lane] = c1;
    return total;
}
template <int NCH> struct ConvTr {
    static constexpr int NPAIR = NCH / 2, NT = NPAIR * 16 / 512;
    unsigned xr[NT][8];
    __device__ __forceinline__ void load(const bf16_t* P, int t0, int pos0, int col0, int tid) {
#pragma unroll
        for (int it = 0; it < NT; ++it) { const int task = tid + it * 512, cp = task % NPAIR, to = task / NPAIR, ch = 2 * cp;
#pragma unroll
            for (int r = 0; r < 8; ++r) xr[it][r] = *(const unsigned*)(P + (size_t)(t0 + 8 * to + r) * LDP + col0 + ch); }
    }
    __device__ __forceinline__ void compute(const float*, const float*, int, bf16_t* dst, int tid) const {
#pragma unroll
        for (int it = 0; it < NT; ++it) { const int task = tid + it * 512, cp = task % NPAIR, to = task / NPAIR, ch = 2 * cp;
            u32x4 lo, hi;
            lo.x = (xr[it][0] & 0xffffu) | (xr[it][1] << 16); lo.y = (xr[it][2] & 0xffffu) | (xr[it][3] << 16); lo.z = (xr[it][4] & 0xffffu) | (xr[it][5] << 16); lo.w = (xr[it][6] & 0xffffu) | (xr[it][7] << 16);
            hi.x = (xr[it][0] >> 16) | (xr[it][1] & 0xffff0000u); hi.y = (xr[it][2] >> 16) | (xr[it][3] & 0xffff0000u); hi.z = (xr[it][4] >> 16) | (xr[it][5] & 0xffff0000u); hi.w = (xr[it][6] >> 16) | (xr[it][7] & 0xffff0000u);
            *(u32x4*)(dst + (size_t)ch * LSTR + 8 * to) = lo;
            *(u32x4*)(dst + (size_t)(ch + 1) * LSTR + 8 * to) = hi; }
    }
};
template <int NCH> struct ConvNat {
    static constexpr int NG = NCH / 8, NT = NG * 128 / 512;
    u32x4 xr[NT];
    __device__ __forceinline__ void load(const bf16_t* P, int t0, int pos0, int col0, int tid) {
#pragma unroll
        for (int it = 0; it < NT; ++it) { const int task = tid + it * 512, cg8 = task % NG, l = task / NG; xr[it] = *(const u32x4*)(P + (size_t)(t0 + l) * LDP + col0 + 8 * cg8); }
    }
    __device__ __forceinline__ void compute(const float*, const float*, int, bf16_t* dst, int tid) const {
#pragma unroll
        for (int it = 0; it < NT; ++it) { const int task = tid + it * 512, cg8 = task % NG, l = task / NG; *(u32x4*)(dst + (size_t)l * LSTR + 8 * cg8) = xr[it]; }
    }
};

__device__ __forceinline__ void phase_ssd_states(const Params& p, int l, unsigned char* smem) {
    int tid_ = threadIdx.x; asm volatile("" : "+v"(tid_));
    const int tid = tid_, wid = tid >> 6, lane = tid & 63, fr = lane & 15, fq = lane >> 4;
    const bf16_t* P = (const bf16_t*)(p.ws + OFF_PROJ); const float* DT = (const float*)(p.ws + OFF_DT);
    bf16_t* ST = (bf16_t*)(p.ws + OFF_ST); float* CHDEC = (float*)(p.ws + OFF_CHDEC);
    const float* cw = p.in[I_CXW] + (size_t)l * 3 * 2048; const float* cb = p.in[I_CXB] + (size_t)l * 2048;
    bf16_t* XT = (bf16_t*)smem;
    bf16_t* BT = (bf16_t*)(smem + 256 * LSTR * 2);
    float* sm_dt = (float*)(smem + 384 * LSTR * 2);
    float* sm_cs = sm_dt + 1024;
    float* sm_w = sm_cs + 1024;
    {
        const float* XEDGER = (const float*)(p.ws + OFF_XEDGER); const float* XEDGEP = (const float*)(p.ws + OFF_XEDGEP); bf16_t* Pw = (bf16_t*)(p.ws + OFF_PROJ);
        const float* cxw = p.in[I_CXW] + (size_t)l * 3 * 2048;
        for (int item = blockIdx.x; item < NBP * 128; item += gridDim.x) {
            const int g = item & 3, c = (item >> 2) & 31, b = item >> 7, e = c & 1, pm = b * 16 + (c >> 1), t = b * SEQ + c * 128 + (e ? 127 : 0);
            const int ch = tid < 256 ? 256 * g + tid : (tid < 384 ? 1024 + 128 * g + (tid - 256) : 1536 + 128 * g + (tid - 384));
            const bool has = e ? (c != 31) : (c != 0);
            float nb = 0.f;
            if (has) nb = XEDGER[((size_t)(pm + (e ? 1 : -1)) * 2 + (e ? 0 : 1)) * 2048 + ch];
            const float pre = XEDGEP[((size_t)pm * 2 + e) * 2048 + ch] + cxw[(e ? 2 : 0) * 2048 + ch] * nb;
            const float o = silu_f(pre); const unsigned w = pk2(o, o); Pw[(size_t)t * LDP + PC_X + ch] = (bf16_t)(w & 0xffffu);
        }
        asm volatile("s_waitcnt vmcnt(0)" ::: "memory"); __syncthreads();
    }
    for (int item = blockIdx.x; item < NBP * 128; item += gridDim.x) {
        const int g = item & 3, c = (item >> 2) & 31, b = item >> 7;
        const int t0 = b * SEQ + c * 128, pos0 = c * 128;
        __syncthreads();
        float r0, r1; ssd_dt_load(DT, t0, g, wid, lane, r0, r1);
        ConvTr<256> cx; ConvTr<128> cbt;
        cx.load(P, t0, pos0, PC_X + 256 * g, tid); cbt.load(P, t0, pos0, PC_X + 1024 + 128 * g, tid);
        const float total = ssd_dt_scan(p, l, r0, r1, g, sm_dt, sm_cs, wid, lane);
        cx.compute(cw, cb, 256 * g, XT, tid); cbt.compute(cw, cb, 1024 + 128 * g, BT, tid);
        const int dir = wid >> 2, hh = wid & 3, h = 4 * g + hh, sb = (dir * 4 + hh) * 128;
        {
            sm_w[sb + lane] = sm_dt[sb + lane] * __expf(total - sm_cs[sb + lane]);
            sm_w[sb + 64 + lane] = sm_dt[sb + 64 + lane] * __expf(total - sm_cs[sb + 64 + lane]);
            if (lane == 0) CHDEC[((b * 32 + c) * 16 + h) * 2 + dir] = __expf(total);
        }
        __syncthreads();
        *(f32x4*)((float*)(p.ws + OFF_DTCS) + (size_t)item * 2048 + tid * 4) = *(const f32x4*)(sm_dt + tid * 4);
        f32x4 acc[4][8];
#pragma unroll
        for (int i = 0; i < 4; ++i)
#pragma unroll
            for (int j = 0; j < 8; ++j) acc[i][j] = (f32x4){0.f, 0.f, 0.f, 0.f};
#pragma unroll 1
        for (int ks = 0; ks < 4; ++ks) {
            const f32x4 w0 = *(const f32x4*)(sm_w + sb + 32 * ks + 8 * fq), w1 = *(const f32x4*)(sm_w + sb + 32 * ks + 8 * fq + 4);
            bf16x8 xf[4];
#pragma unroll
            for (int pi = 0; pi < 4; ++pi) { const u32x4 raw = *(const u32x4*)(XT + (size_t)(64 * hh + chperm(pi, fr)) * LSTR + 32 * ks + 8 * fq); float f[8]; unpack8(raw, f);
                f[0] *= w0[0]; f[1] *= w0[1]; f[2] *= w0[2]; f[3] *= w0[3]; f[4] *= w1[0]; f[5] *= w1[1]; f[6] *= w1[2]; f[7] *= w1[3];
                const u32x4 pk = pack8(f); xf[pi] = __builtin_bit_cast(bf16x8, pk); }
#pragma unroll
            for (int ni = 0; ni < 8; ++ni) { const bf16x8 bf = *(const bf16x8*)(BT + (size_t)chperm(ni, fr) * LSTR + 32 * ks + 8 * fq);
#pragma unroll
                for (int pi = 0; pi < 4; ++pi) acc[pi][ni] = __builtin_amdgcn_mfma_f32_16x16x32_bf16(bf, xf[pi], acc[pi][ni], 0, 0, 0); }
        }
        bf16_t* S = ST + ((size_t)((b * 32 + c) * 16 + h) * 2 + dir) * 8192;
#pragma unroll
        for (int pi = 0; pi < 4; ++pi)
#pragma unroll
            for (int q = 0; q < 4; ++q) { u32x4 w; w.x = pk2(acc[pi][2 * q][0], acc[pi][2 * q][1]); w.y = pk2(acc[pi][2 * q][2], acc[pi][2 * q][3]); w.z = pk2(acc[pi][2 * q + 1][0], acc[pi][2 * q + 1][1]); w.w = pk2(acc[pi][2 * q + 1][2], acc[pi][2 * q + 1][3]);
                *(u32x4*)(S + ((q * 4 + pi) * 16 + fr) * 32 + 8 * fq) = w; }
    }
}
__device__ __forceinline__ void phase_ssd_scan(const Params& p) {
    bf16_t* ST = (bf16_t*)(p.ws + OFF_ST); const float* CHDEC = (const float*)(p.ws + OFF_CHDEC);
    const int ntask = NBP * 16 * 2 * 1024;
    int tid_ = threadIdx.x; asm volatile("" : "+v"(tid_));
    for (int task = blockIdx.x * 512 + tid_; task < ntask; task += gridDim.x * 512) {
        const int e = task & 1023, dir = (task >> 10) & 1, h = (task >> 11) & 15, b = task >> 15;
        const int c0 = dir ? 31 : 0, cstep = dir ? -1 : 1;
        const size_t idx0 = (size_t)((b * 32 + c0) * 16 + h) * 2 + dir; const long istep = (long)cstep * 32;
        float run[8];
#pragma unroll
        for (int j = 0; j < 8; ++j) run[j] = 0.f;
#pragma unroll 1
        for (int i0 = 0; i0 < 32; i0 += 16) {
            u32x4 v[16]; float d[16];
#pragma unroll
            for (int i = 0; i < 16; ++i) { const size_t idx = idx0 + (long)(i0 + i) * istep; v[i] = *(const u32x4*)(ST + idx * 8192 + e * 8); d[i] = CHDEC[idx]; }
#pragma unroll
            for (int i = 0; i < 16; ++i) { const size_t idx = idx0 + (long)(i0 + i) * istep; float sv[8]; unpack8(v[i], sv);
                *(u32x4*)(ST + idx * 8192 + e * 8) = pack8(run);
#pragma unroll
                for (int j = 0; j < 8; ++j) run[j] = run[j] * d[i] + sv[j]; }
        }
    }
}
__device__ __forceinline__ void phase_ssd_out(const Params& p, int l, unsigned char* smem) {
    bf16_t* P = (bf16_t*)(p.ws + OFF_PROJ); const float* DT = (const float*)(p.ws + OFF_DT);
    const bf16_t* ST = (const bf16_t*)(p.ws + OFF_ST);
    const float* cw = p.in[I_CXW] + (size_t)l * 3 * 2048; const float* cb = p.in[I_CXB] + (size_t)l * 2048;
    const float* dsk = p.in[I_DSK] + l * 16; const float* nw = p.in[I_SNW] + l * 1024;
    bf16_t* XT = (bf16_t*)smem;
    bf16_t* CN = (bf16_t*)(smem + 256 * LSTR * 2);
    bf16_t* BN = (bf16_t*)(smem + 384 * LSTR * 2);
    float* sm_dt = (float*)(smem + 512 * LSTR * 2);
    float* sm_cs = sm_dt + 1024;
    float* sm_ss = sm_cs + 1024;
    for (int item = blockIdx.x; item < NBP * 128; item += gridDim.x) {
        int tid_ = threadIdx.x; asm volatile("" : "+v"(tid_));
        const int tid = tid_, wid = tid >> 6, lane = tid & 63, fr = lane & 15, fq = lane >> 4, hh = wid >> 1, lh = wid & 1;
        const int g = item & 3, c = (item >> 2) & 31, b = item >> 7;
        const int t0 = b * SEQ + c * 128, pos0 = c * 128, h = 4 * g + hh;
        __syncthreads();
        const bf16_t* Hf = ST + ((size_t)((b * 32 + c) * 16 + h) * 2 + 0) * 8192;
        bf16x8 hv[4][4];
        {
            const f32x4 dtcs = *(const f32x4*)((const float*)(p.ws + OFF_DTCS) + (size_t)item * 2048 + tid * 4);
            ConvNat<128> cbn, ccn; ConvTr<256> cx;
            cbn.load(P, t0, pos0, PC_X + 1024 + 128 * g, tid); ccn.load(P, t0, pos0, PC_X + 1536 + 128 * g, tid); cx.load(P, t0, pos0, PC_X + 256 * g, tid);
            __builtin_amdgcn_sched_barrier(0);
            *(f32x4*)(sm_dt + tid * 4) = dtcs;
            cbn.compute(cw, cb, 1024 + 128 * g, BN, tid);
            ccn.compute(cw, cb, 1536 + 128 * g, CN, tid);
            cx.compute(cw, cb, 256 * g, XT, tid);
        }
#pragma unroll
        for (int ks = 0; ks < 4; ++ks)
#pragma unroll
            for (int pt = 0; pt < 4; ++pt) hv[ks][pt] = *(const bf16x8*)(Hf + ((ks * 4 + pt) * 16 + fr) * 32 + 8 * fq);
        __syncthreads();
        {
            f32x4 cbacc[8];
#pragma unroll
            for (int st = 0; st < 8; ++st) cbacc[st] = (f32x4){0.f, 0.f, 0.f, 0.f};
#pragma unroll
            for (int ks = 0; ks < 4; ++ks) {
                const bf16x8 cf = *(const bf16x8*)(CN + (size_t)(16 * wid + fr) * LSTR + 32 * ks + 8 * fq);
#pragma unroll
                for (int st = 0; st < 8; ++st) { const bf16x8 bf = *(const bf16x8*)(BN + (size_t)(16 * st + fr) * LSTR + 32 * ks + 8 * fq);
                    cbacc[st] = __builtin_amdgcn_mfma_f32_16x16x32_bf16(bf, cf, cbacc[st], 0, 0, 0); }
            }
            __syncthreads();
#pragma unroll
            for (int st = 0; st < 8; ++st) { u32x2 w; w.x = pk2(cbacc[st][0], cbacc[st][1]); w.y = pk2(cbacc[st][2], cbacc[st][3]);
                *(u32x2*)(BN + (size_t)(16 * wid + fr) * LSTR + 16 * st + 4 * fq) = w; }
        }
        __syncthreads();
        const float* dtf = sm_dt + hh * 128; const float* dtb = sm_dt + (4 + hh) * 128; const float* acs = sm_cs + hh * 128; const float* rcs = sm_cs + (4 + hh) * 128;
        f32x4 acc[4][4];
#pragma unroll
        for (int dir = 0; dir < 2; ++dir) {
            const float* csd = dir ? rcs : acs;
            f32x4 acc2[4][4];
#pragma unroll
            for (int i = 0; i < 4; ++i)
#pragma unroll
                for (int j = 0; j < 4; ++j) acc2[i][j] = (f32x4){0.f, 0.f, 0.f, 0.f};
#pragma unroll
            for (int ks = 0; ks < 4; ++ks) {
                bf16x8 a[4];
#pragma unroll
                for (int lt = 0; lt < 4; ++lt) a[lt] = *(const bf16x8*)(CN + (size_t)(64 * lh + 16 * lt + fr) * LSTR + 32 * ks + 8 * fq);
#pragma unroll
                for (int lt = 0; lt < 4; ++lt)
#pragma unroll
                    for (int pt = 0; pt < 4; ++pt) acc2[lt][pt] = __builtin_amdgcn_mfma_f32_16x16x32_bf16(hv[ks][pt], a[lt], acc2[lt][pt], 0, 0, 0);
                if (dir == 0) {
#pragma unroll
                    for (int pt = 0; pt < 4; ++pt) hv[ks][pt] = *(const bf16x8*)(Hf + 8192 + ((ks * 4 + pt) * 16 + fr) * 32 + 8 * fq); }
                __builtin_amdgcn_sched_barrier(0);
            }
#pragma unroll
            for (int lt = 0; lt < 4; ++lt) { const float ev = __expf(csd[64 * lh + 16 * lt + fr]);
#pragma unroll
                for (int pt = 0; pt < 4; ++pt) acc[lt][pt] = dir ? acc[lt][pt] + acc2[lt][pt] * ev : acc2[lt][pt] * ev; }
        }
        u32x2 zr[4][4];
#pragma unroll
        for (int lt = 0; lt < 4; ++lt)
#pragma unroll
            for (int q = 0; q < 2; ++q) { const u32x4 zz = *(const u32x4*)(P + (size_t)(t0 + 64 * lh + 16 * lt + fr) * LDP + PC_Z + 256 * g + 64 * hh + 32 * q + 8 * fq);
                zr[lt][2 * q].x = zz.x; zr[lt][2 * q].y = zz.y; zr[lt][2 * q + 1].x = zz.z; zr[lt][2 * q + 1].y = zz.w; }
        const float dskip = dsk[h];
#pragma unroll 1
        for (int ks = 0; ks < 4; ++ks) {
            const int s0 = 32 * ks + 8 * fq;
            float as_[8], rs_[8], df_[8], db_[8];
            { const f32x4 t0_ = *(const f32x4*)(acs + s0), t1_ = *(const f32x4*)(acs + s0 + 4), u0_ = *(const f32x4*)(rcs + s0), u1_ = *(const f32x4*)(rcs + s0 + 4);
              const f32x4 v0_ = *(const f32x4*)(dtf + s0), v1_ = *(const f32x4*)(dtf + s0 + 4), x0_ = *(const f32x4*)(dtb + s0), x1_ = *(const f32x4*)(dtb + s0 + 4);
#pragma unroll
              for (int j = 0; j < 4; ++j) { as_[j] = t0_[j]; as_[4 + j] = t1_[j]; rs_[j] = u0_[j]; rs_[4 + j] = u1_[j]; df_[j] = v0_[j]; df_[4 + j] = v1_[j]; db_[j] = x0_[j]; db_[4 + j] = x1_[j]; } }
            bf16x8 bx[4];
#pragma unroll
            for (int pt = 0; pt < 4; ++pt) bx[pt] = *(const bf16x8*)(XT + (size_t)(64 * hh + chperm(pt, fr)) * LSTR + s0);
#pragma unroll
            for (int lt = 0; lt < 4; ++lt) {
                const int lrow = 64 * lh + 16 * lt + fr;
                const float al = acs[lrow], rl = rcs[lrow], dd = dtf[lrow] + dtb[lrow];
                float cbv[8]; unpack8(*(const u32x4*)(BN + (size_t)lrow * LSTR + s0), cbv);
#pragma unroll
                for (int j = 0; j < 8; ++j) { const int s = s0 + j; const bool fw = s < lrow;
                    const float d = fw ? al - as_[j] : rl - rs_[j]; float v = __expf(d) * (fw ? df_[j] : db_[j]); v = (s == lrow) ? dd : v; cbv[j] = cbv[j] * v + ((s == lrow) ? dskip : 0.f); }
                const u32x4 pk = pack8(cbv); const bf16x8 gfr = __builtin_bit_cast(bf16x8, pk);
#pragma unroll
                for (int pt = 0; pt < 4; ++pt) acc[lt][pt] = __builtin_amdgcn_mfma_f32_16x16x32_bf16(bx[pt], gfr, acc[lt][pt], 0, 0, 0);
                __builtin_amdgcn_sched_barrier(0);
            }
        }
#pragma unroll
        for (int lt = 0; lt < 4; ++lt) { float sq = 0.f;
#pragma unroll
            for (int pt = 0; pt < 4; ++pt) { const float z0 = bflo(zr[lt][pt].x), z1 = bfhi(zr[lt][pt].x), z2 = bflo(zr[lt][pt].y), z3 = bfhi(zr[lt][pt].y);
                f32x4 y = acc[lt][pt]; y[0] *= silu_f(z0); y[1] *= silu_f(z1); y[2] *= silu_f(z2); y[3] *= silu_f(z3); acc[lt][pt] = y;
                sq += (y[0] * y[0] + y[1] * y[1]) + (y[2] * y[2] + y[3] * y[3]); }
            sq += __shfl_xor(sq, 16); sq += __shfl_xor(sq, 32);
            if (fq == 0) sm_ss[(64 * lh + 16 * lt + fr) * 4 + hh] = sq; }
        __syncthreads();
        f32x4 nwv[4];
#pragma unroll
        for (int pt = 0; pt < 4; ++pt) nwv[pt] = *(const f32x4*)(nw + 256 * g + 64 * hh + 32 * (pt >> 1) + 8 * fq + 4 * (pt & 1));
#pragma unroll
        for (int lt = 0; lt < 4; ++lt) { const int lrow = 64 * lh + 16 * lt + fr; const f32x4 sv = *(const f32x4*)(sm_ss + lrow * 4);
            const float rs = rsqrtf(((sv[0] + sv[1]) + (sv[2] + sv[3])) * (1.0f / 256.0f) + EPS);
#pragma unroll
            for (int q = 0; q < 2; ++q) { const f32x4 y0 = acc[lt][2 * q] * rs * nwv[2 * q], y1 = acc[lt][2 * q + 1] * rs * nwv[2 * q + 1]; u32x4 w; w.x = pk2(y0[0], y0[1]); w.y = pk2(y0[2], y0[3]); w.z = pk2(y1[0], y1[1]); w.w = pk2(y1[2], y1[3]);
                *(u32x4*)(P + (size_t)(t0 + lrow) * LDP + PC_Z + 256 * g + 64 * hh + 32 * q + 8 * fq) = w; } }
    }
}

#define XB_TMO      128
#define XB_XCNT(j)  (256  + 64 * (j))
#define XB_XSUB(j)  (1280 + 64 * (j))
#define XB_XGEN(j)  (2304 + 64 * (j))
#define XB_TOP      3328
#define XB_TOPGEN   3392
#define XCD_BAR_WORDS 3456
#define XB_SPIN_CAP (1u << 20)
__device__ __forceinline__ unsigned xb_ld(unsigned* p)              { return __hip_atomic_load(p, __ATOMIC_RELAXED, __HIP_MEMORY_SCOPE_AGENT); }
__device__ __forceinline__ unsigned xb_add(unsigned* p, unsigned v) { return __hip_atomic_fetch_add(p, v, __ATOMIC_RELAXED, __HIP_MEMORY_SCOPE_AGENT); }
__device__ __forceinline__ unsigned xb_xcc_id() { return (unsigned)__builtin_amdgcn_s_getreg((3 << 11) | 20) & 0xFu; }
#define XB_SPIN(cond, bar) do { unsigned _sp = 0; while (cond) { __builtin_amdgcn_s_sleep(1); \
    if ((++_sp & 255u) == 0u) { if (xb_ld(&(bar)[XB_TMO])) break; if (_sp > XB_SPIN_CAP) { atomicAdd(&(bar)[XB_TMO], 1u); break; } } } } while (0)
struct XcdBarrier { unsigned* bar; unsigned x; volatile PG8_LAS unsigned* st; };
__device__ __forceinline__ XcdBarrier xcd_barrier_post(unsigned* bar, volatile PG8_LAS unsigned* st) {
    XcdBarrier b; b.bar = bar; b.x = xb_xcc_id(); b.st = st;
    if (threadIdx.x == 0) (void)xb_add(&bar[XB_XCNT(b.x)], 1u);
    return b;
}
__device__ __forceinline__ void xcd_barrier_complete(unsigned* bar, unsigned x, unsigned& nloc, unsigned& nx) {
    const unsigned G = gridDim.x * gridDim.y * gridDim.z;
    unsigned sum, cnt, mine, sp = 0u;
    for (;;) {
        sum = 0u; cnt = 0u; mine = 0u;
#pragma unroll
        for (unsigned j = 0; j < 16; ++j) { const unsigned c = xb_ld(&bar[XB_XCNT(j)]); sum += c; cnt += (c > 0u) ? 1u : 0u; mine = (j == x) ? c : mine; }
        if (sum == G) break;
        __builtin_amdgcn_s_sleep(1);
        if ((++sp & 255u) == 0u) { if (xb_ld(&bar[XB_TMO])) break; if (sp > XB_SPIN_CAP) { atomicAdd(&bar[XB_TMO], 1u); break; } }
    }
    nloc = mine > 0u ? mine : 1u; nx = cnt > 0u ? cnt : 1u;
}
__device__ __forceinline__ void xcd_barrier(const XcdBarrier& b) {
    asm volatile("s_waitcnt vmcnt(0)" ::: "memory");
    __syncthreads();
    if (threadIdx.x == 0) {
        unsigned* bar = b.bar;
        __builtin_amdgcn_s_waitcnt(0);
        unsigned nloc = b.st[0], nx = b.st[1];
        if (nloc == 0u) { xcd_barrier_complete(bar, b.x, nloc, nx); b.st[0] = nloc; b.st[1] = nx; }
        const unsigned old = xb_add(&bar[XB_XSUB(b.x)], 1u);
        const unsigned gen = old / nloc;
        if (old + 1u == (gen + 1u) * nloc) {
            __builtin_amdgcn_fence(__ATOMIC_RELEASE, "agent");
            asm volatile("s_waitcnt vmcnt(0)" ::: "memory");
            const unsigned og = xb_add(&bar[XB_TOP], 1u);
            const unsigned tg = og / nx;
            if (og + 1u == (tg + 1u) * nx) xb_add(&bar[XB_TOPGEN], 1u);
            else XB_SPIN(xb_ld(&bar[XB_TOPGEN]) == tg, bar);
            __builtin_amdgcn_fence(__ATOMIC_ACQUIRE, "agent");
            xb_add(&bar[XB_XGEN(b.x)], 1u);
            asm volatile("s_waitcnt vmcnt(0)" ::: "memory");
        } else {
            XB_SPIN(xb_ld(&bar[XB_XGEN(b.x)]) == gen, bar);
            __builtin_amdgcn_fence(__ATOMIC_ACQUIRE, "agent");
            asm volatile("s_waitcnt vmcnt(0)" ::: "memory");
        }
    }
    __syncthreads();
}

constexpr int PH_PER_HALF = 16, N_PHASES = NPART * PH_PER_HALF;
__global__ void __launch_bounds__(512, 2) mega(Params p0) {
    extern __shared__ __attribute__((aligned(16))) unsigned char smem[];
    cg::grid_group grid = cg::this_grid();
    volatile PG8_LAS unsigned* xst = (volatile PG8_LAS unsigned*)((PG8_LAS unsigned char*)smem + (LDS_BYTES - 16));
    if (threadIdx.x == 0) { xst[0] = 0u; xst[1] = 0u; }
    __syncthreads();
    const XcdBarrier xb = xcd_barrier_post((unsigned*)(p0.ws + OFF_BAR), xst);
    for (int ph = p0.ph_lo; ph < p0.ph_hi; ++ph) {
        const int hf = ph / PH_PER_HALF, lp = ph % PH_PER_HALF;
        if (hf >= 1 && lp == 0) continue;
        Params p = p0; asm volatile("" : "+s"(p.ws), "+s"(p.out));
        unsigned char* ws = p.ws;
        float* rowss = (float*)(ws + OFF_ROWSS) + (size_t)hf * 5 * TH * 16;
        bf16_t* HB = (bf16_t*)(ws + OFF_HB);
        if (lp == 0) {
#ifdef REP0
            for (int rep = 0; rep < 2; ++rep) {
#endif
            if (hf == 0) phase_weights(p, (float*)smem);
            phase_prep(p, hf);
#ifdef REP0
            }
#endif
        } else if (lp == 15) {
            phase_final(p, hf);
            if (hf + 1 < NPART) phase_prep(p, hf + 1);
        } else {
            const int l = (lp - 1) / 7, k = (lp - 1) % 7;
#ifdef REPK
            for (int rep = 0; rep < ((REPK) ? 2 : 1); ++rep) {
#endif
            unsigned char* wb = ws + (size_t)l * WL_B;
            float* hout = p.out + (size_t)hf * TH * DM;
            if (k == 0) {
                pg8::Gemm g{HB, (const bf16_t*)wb, TH, NIN, DM}; pg8::StaticOrder S; S.init(TH, NIN, gridDim.x, blockIdx.x);
                EpiIn E{(bf16_t*)(ws + OFF_PROJ), rowss + (size_t)(2 * l) * TH * 16, (float*)(smem + 131072), (float*)(smem + 132096), p.in[I_CXW] + (size_t)l * 3 * 2048, p.in[I_CXB] + (size_t)l * 2048,
                        (float*)(ws + OFF_XEDGER), (float*)(ws + OFF_XEDGEP), -1};
                phase_dt(p, l, rowss + (size_t)(2 * l) * TH * 16);
                pg8::gemm_phase<EpiIn, pg8::StaticOrder, true, true>((PG8_LAS unsigned char*)smem, g, S, E);
            } else if (k == 1) {
#ifndef NO_STATES
                phase_ssd_states(p, l, smem);
#endif
            } else if (k == 2) {
                phase_ssd_scan(p);
            } else if (k == 3) {
#ifndef NO_OUT
                phase_ssd_out(p, l, smem);
#endif
                phase_shortconv(p, l);
            } else if (k == 4) {
                pg8::Gemm g{(const bf16_t*)(ws + OFF_PROJ), (const bf16_t*)(wb + WT_IN_B), TH, DM, DMIX, LDP}; pg8::StaticOrder S; S.init(TH, DM, gridDim.x, blockIdx.x);
                EpiRes E{HB, rowss + (size_t)(2 * l + 1) * TH * 16};
                pg8::gemm_phase<EpiRes, pg8::StaticOrder, true, true>((PG8_LAS unsigned char*)smem, g, S, E);
#ifdef REP4
                if (l == 0) pg8::gemm_phase<EpiRes, pg8::StaticOrder, true, true>((PG8_LAS unsigned char*)smem, g, S, E);
#endif
            } else if (k == 5) {
                pg8::Gemm g{HB, (const bf16_t*)(wb + WT_IN_B + WT_OUT_B), TH, NUP, DM}; pg8::StaticOrder S; S.init(TH, NUP, gridDim.x, blockIdx.x);
                EpiAct E{(bf16_t*)(ws + OFF_ACT), rowss + (size_t)(2 * l + 1) * TH * 16, (float*)(smem + 131072), (float*)(smem + 132096), p.in[I_FCW] + (size_t)l * 3 * NUP, p.in[I_FCB] + (size_t)l * NUP,
                         (float*)(ws + OFF_EDGER), (float*)(ws + OFF_EDGEP), -1};
                pg8::gemm_phase<EpiAct, pg8::StaticOrder, true, true>((PG8_LAS unsigned char*)smem, g, S, E);
            } else {
                pg8::Gemm g{(const bf16_t*)(ws + OFF_ACT), (const bf16_t*)(wb + WT_IN_B + WT_OUT_B + WT_UP_B), TH, DM, DFF}; pg8::StaticOrder S; S.init(TH, DM, gridDim.x, blockIdx.x);
                {
                    pg8::Unit uu; int last_pm = -1;
                    for (int i = 0; S.next(i, uu); ++i) if (uu.pm != last_pm) { last_pm = uu.pm; edgefix_panel(p, l, uu.pm); }
                    asm volatile("s_waitcnt vmcnt(0)" ::: "memory"); __syncthreads();
                }
                EpiRes E{HB, rowss + (size_t)(2 * l + 2) * TH * 16};
                pg8::gemm_phase<EpiRes, pg8::StaticOrder, true, true>((PG8_LAS unsigned char*)smem, g, S, E);
            }
#ifdef REPK
            }
#endif
        }
        if (ph + 1 < p0.ph_hi) { if (ph == 0) grid.sync(); else xcd_barrier(xb); }
    }
}


#ifndef MULTI_LAUNCH
#define MULTI_LAUNCH 0
#endif
extern "C" void kernel_launch(void* const* d_in, const int* in_sizes, int n_in, void* d_out, int out_size, void* d_ws, size_t ws_size, hipStream_t stream) {
    static int grid = 0;
    if (grid == 0) {
        if (n_in != 19 || ws_size < WS_NEED) { fprintf(stderr, "kernel_launch: unexpected n_in %d / ws_size %zu (need %zu)\n", n_in, ws_size, (size_t)WS_NEED); grid = -1; return; }
        int dev = 0, cus = 0, per_cu = 0;
        hipGetDevice(&dev); hipDeviceGetAttribute(&cus, hipDeviceAttributeMultiprocessorCount, dev);
        if (hipFuncSetAttribute((const void*)mega, hipFuncAttributeMaxDynamicSharedMemorySize, LDS_BYTES) != hipSuccess) { fprintf(stderr, "kernel_launch: hipFuncSetAttribute failed\n"); grid = -1; return; }
        if (hipOccupancyMaxActiveBlocksPerMultiprocessor(&per_cu, (const void*)mega, 512, LDS_BYTES) != hipSuccess || per_cu < 1) { fprintf(stderr, "kernel_launch: occupancy query says %d\n", per_cu); per_cu = 1; }
        (void)hipGetLastError();
        grid = cus * 1;
        fprintf(stderr, "kernel_launch: grid %d (cus %d, per_cu %d), ws %zu\n", grid, cus, per_cu, ws_size);
    }
    if (grid < 0) return;
#ifdef DBG_MEMSET
    (void)hipMemsetAsync(d_ws, 0, WS_END, stream); (void)hipMemsetAsync(d_out, 0, (size_t)out_size * 4, stream);
#endif
    (void)hipMemsetAsync((unsigned char*)d_ws + OFF_BAR, 0, 16384, stream);
    Params p{};
    for (int i = 0; i < 19; ++i) p.in[i] = (const float*)d_in[i];
    p.out = (float*)d_out; p.ws = (unsigned char*)d_ws;
#if MULTI_LAUNCH
    for (int ph = 0; ph < N_PHASES; ++ph) { p.ph_lo = ph; p.ph_hi = ph + 1; hipLaunchKernelGGL(mega, dim3(grid), dim3(512), LDS_BYTES, stream, p); }
#else
    p.ph_lo = 0; p.ph_hi = N_PHASES;
    void* args[] = {&p};
    hipError_t e = hipLaunchCooperativeKernel((const void*)mega, dim3(grid), dim3(512), args, LDS_BYTES, stream);
    if (e != hipSuccess) fprintf(stderr, "cooperative launch failed: %s (grid %d)\n", hipGetErrorString(e), grid);
#endif
}
```
